# Optimizing an MI355X kernel written in HIP

```python
import jax, jax.numpy as jnp
from jax import lax
import numpy as np

D_MODEL = 1024
BATCH = 8
SEQ = 8192
DEPTH = 2

CHUNK = 64
CONV_W = 4
EPS = 1e-6
F32 = jnp.float32

GDN_HEADS = 4
GDN_DK = 128
GDN_DV = 128
GDN_W = GDN_HEADS * GDN_DV
SSD_HEADS = 16
SSD_P = 64
SSD_N = 128
SSD_GROUPS = 2
SSD_W = SSD_HEADS * SSD_P
RET_HEADS = 4
RET_DK = 128
RET_DV = 128
RET_W = RET_HEADS * RET_DV
ROPE_BASE = 10000.0

MIX_W = GDN_W + SSD_W + RET_W

GDN_SIZES = [GDN_HEADS * GDN_DK, GDN_HEADS * GDN_DK, GDN_W, GDN_W, GDN_HEADS, GDN_HEADS]
SSD_SIZES = [SSD_W, SSD_GROUPS * SSD_N, SSD_GROUPS * SSD_N, SSD_W, SSD_HEADS]
RET_SIZES = [RET_HEADS * RET_DK, RET_HEADS * RET_DK, RET_W, RET_W]
IN_SIZES = GDN_SIZES + SSD_SIZES + RET_SIZES
N_IN = sum(IN_SIZES)
GDN_CONV_CH = 2 * GDN_HEADS * GDN_DK + GDN_W
SSD_CONV_CH = SSD_W + 2 * SSD_GROUPS * SSD_N

kernel_name = "hybrid_gdn_ssd_retention_parallel_groups"


def rmsnorm(x, w):
    xf = x.astype(F32)
    return xf * lax.rsqrt(jnp.mean(xf * xf, axis=-1, keepdims=True) + EPS) * w.astype(F32)


def split_cols(t, sizes):
    out, start = [], 0
    for s in sizes:
        out.append(t[..., start:start + s])
        start += s
    return out


def causal_conv(x, w):
    k = w.shape[0]
    seq = x.shape[1]
    xp = jnp.pad(x, ((0, 0), (k - 1, 0), (0, 0)))
    return sum(xp[:, i:i + seq] * w[i].astype(F32) for i in range(k))


def to_chunks(t):
    b, l = t.shape[:2]
    return jnp.moveaxis(t.reshape(b, l // CHUNK, CHUNK, *t.shape[2:]), 1, 0)


def from_chunks(t):
    n, b, c = t.shape[:3]
    return jnp.moveaxis(t, 0, 1).reshape(b, n * c, *t.shape[3:])


def l2norm(t):
    return t * lax.rsqrt(jnp.sum(t * t, axis=-1, keepdims=True) + EPS)


def rotary(t, pos):
    half = t.shape[-1] // 2
    inv = ROPE_BASE ** (-jnp.arange(half, dtype=F32) / half)
    ang = pos.astype(F32)[:, None] * inv[None, :]
    cos = jnp.cos(ang)[None, :, None, :]
    sin = jnp.sin(ang)[None, :, None, :]
    t1, t2 = t[..., :half], t[..., half:]
    return jnp.concatenate([t1 * cos - t2 * sin, t1 * sin + t2 * cos], axis=-1)


def gated_deltanet(q, k, v, b_raw, a_raw, A_log, dt_bias):
    bsz = q.shape[0]
    q = l2norm(q) * (GDN_DK ** -0.5)
    k = l2norm(k)
    beta = jax.nn.sigmoid(b_raw)
    g = -jnp.exp(A_log.astype(F32)) * jax.nn.softplus(a_raw + dt_bias.astype(F32))
    causal = jnp.tril(jnp.ones((CHUNK, CHUNK), bool))
    strict = jnp.tril(jnp.ones((CHUNK, CHUNK), F32), -1)
    eye = jnp.eye(CHUNK, dtype=F32)

    def step(S, inp):
        qi, ki, vi, bi, gi = inp
        gcum = jnp.cumsum(gi, axis=1)
        gh = jnp.swapaxes(gcum, 1, 2)
        diff = gh[..., :, None] - gh[..., None, :]
        decay = jnp.exp(jnp.where(causal, diff, -jnp.inf))
        kb = ki * bi[..., None]
        a_low = jnp.einsum('bihd,bjhd->bhij', kb, ki) * decay * strict
        rhs = jnp.concatenate([vi * bi[..., None], kb * jnp.exp(gcum)[..., None]], axis=-1)
        rhs = jnp.swapaxes(rhs, 1, 2)
        sol = lax.linalg.triangular_solve(a_low + eye, rhs, left_side=True, lower=True)
        u, w = sol[..., :GDN_DV], sol[..., GDN_DV:]
        v_new = u - jnp.einsum('bhcd,bhdv->bhcv', w, S)
        attn = jnp.einsum('bihd,bjhd->bhij', qi, ki) * decay
        o = (jnp.einsum('bihd,bhdv->bihv', qi * jnp.exp(gcum)[..., None], S)
             + jnp.einsum('bhij,bhjv->bihv', attn, v_new))
        glast = gcum[:, -1]
        kdec = ki * jnp.exp(glast[:, None, :] - gcum)[..., None]
        S = S * jnp.exp(glast)[:, :, None, None] + jnp.einsum('bjhd,bhjv->bhdv', kdec, v_new)
        return S, o

    s0 = jnp.zeros((bsz, GDN_HEADS, GDN_DK, GDN_DV), F32)
    _, o = lax.scan(step, s0, (to_chunks(q), to_chunks(k), to_chunks(v), to_chunks(beta), to_chunks(g)))
    return from_chunks(o)


def ssd(x, Bm, Cm, dt_raw, A_log, dt_bias, D):
    bsz, seq = x.shape[:2]
    hg = SSD_HEADS // SSD_GROUPS
    dt = jax.nn.softplus(dt_raw + dt_bias.astype(F32))
    a = (dt * -jnp.exp(A_log.astype(F32))).reshape(bsz, seq, SSD_GROUPS, hg)
    xdt = (x * dt[..., None]).reshape(bsz, seq, SSD_GROUPS, hg, SSD_P)
    causal = jnp.tril(jnp.ones((CHUNK, CHUNK), bool))

    def step(hs, inp):
        xi, bi, ci, ai = inp
        acum = jnp.cumsum(ai, axis=1)
        diff = acum[:, :, None] - acum[:, None]
        lmat = jnp.exp(jnp.where(causal[None, :, :, None, None], diff, -jnp.inf))
        cb = jnp.einsum('bign,bjgn->bijg', ci, bi)
        y = jnp.einsum('bijg,bijgh,bjghp->bighp', cb, lmat, xi)
        y = y + jnp.einsum('bign,bghpn->bighp', ci, hs) * jnp.exp(acum)[..., None]
        alast = acum[:, -1]
        wdec = jnp.exp(alast[:, None] - acum)
        hs = hs * jnp.exp(alast)[..., None, None] + jnp.einsum('bjgn,bjgh,bjghp->bghpn', bi, wdec, xi)
        return hs, y

    h0 = jnp.zeros((bsz, SSD_GROUPS, hg, SSD_P, SSD_N), F32)
    _, y = lax.scan(step, h0, (to_chunks(xdt), to_chunks(Bm), to_chunks(Cm), to_chunks(a)))
    y = from_chunks(y).reshape(bsz, seq, SSD_HEADS, SSD_P)
    return y + x * D.astype(F32)[:, None]


def retention(q, k, v):
    bsz = q.shape[0]
    lg = jnp.log(1.0 - 2.0 ** (-5.0 - jnp.arange(RET_HEADS, dtype=F32)))
    idx = jnp.arange(CHUNK, dtype=F32)
    rel = idx[:, None] - idx[None, :]
    dmat = jnp.where(rel[None] >= 0, jnp.exp(jnp.maximum(rel, 0.0)[None] * lg[:, None, None]), 0.0)
    qdec = jnp.exp((idx[:, None] + 1.0) * lg[None, :])
    kdec = jnp.exp((CHUNK - 1.0 - idx)[:, None] * lg[None, :])
    cdec = jnp.exp(CHUNK * lg)
    k = k * (RET_DK ** -0.5)

    def step(R, inp):
        qi, ki, vi = inp
        s = jnp.einsum('bihd,bjhd->bhij', qi, ki) * dmat
        o = (jnp.einsum('bhij,bjhv->bihv', s, vi)
             + jnp.einsum('bihd,bhdv->bihv', qi, R) * qdec[None, :, :, None])
        R = R * cdec[None, :, None, None] + jnp.einsum('bjhd,bjhv->bhdv', ki * kdec[None, :, :, None], vi)
        return R, o

    r0 = jnp.zeros((bsz, RET_HEADS, RET_DK, RET_DV), F32)
    _, o = lax.scan(step, r0, (to_chunks(q), to_chunks(k), to_chunks(v)))
    return from_chunks(o)


def hybrid_layer(x, pre_norm, post_norm, w_in, gdn_conv, gdn_A_log, gdn_dt_bias, gdn_norm,
                 ssd_conv, ssd_conv_b, ssd_A_log, ssd_dt_bias, ssd_D, ssd_norm, ret_norm, w_out, pos):
    bsz, seq, _ = x.shape
    h = rmsnorm(x, pre_norm)
    proj = jnp.einsum('bld,de->ble', h, w_in.astype(F32))
    (gq, gk, gv, gz, gb, ga, sx, sB, sC, sz, sdt, rq, rk, rv, rg) = split_cols(proj, IN_SIZES)

    qkv = jax.nn.silu(causal_conv(jnp.concatenate([gq, gk, gv], axis=-1), gdn_conv))
    gq, gk, gv = split_cols(qkv, [GDN_HEADS * GDN_DK, GDN_HEADS * GDN_DK, GDN_W])
    o_a = gated_deltanet(gq.reshape(bsz, seq, GDN_HEADS, GDN_DK), gk.reshape(bsz, seq, GDN_HEADS, GDN_DK),
                         gv.reshape(bsz, seq, GDN_HEADS, GDN_DV), gb, ga, gdn_A_log, gdn_dt_bias)
    o_a = rmsnorm(o_a, gdn_norm) * jax.nn.silu(gz.reshape(bsz, seq, GDN_HEADS, GDN_DV))

    xbc = jax.nn.silu(causal_conv(jnp.concatenate([sx, sB, sC], axis=-1), ssd_conv) + ssd_conv_b.astype(F32))
    sx, sB, sC = split_cols(xbc, [SSD_W, SSD_GROUPS * SSD_N, SSD_GROUPS * SSD_N])
    y_b = ssd(sx.reshape(bsz, seq, SSD_HEADS, SSD_P), sB.reshape(bsz, seq, SSD_GROUPS, SSD_N),
              sC.reshape(bsz, seq, SSD_GROUPS, SSD_N), sdt, ssd_A_log, ssd_dt_bias, ssd_D)
    y_b = y_b * jax.nn.silu(sz.reshape(bsz, seq, SSD_HEADS, SSD_P))
    o_b = rmsnorm(y_b.reshape(bsz, seq, SSD_GROUPS, SSD_W // SSD_GROUPS),
                  ssd_norm.reshape(SSD_GROUPS, SSD_W // SSD_GROUPS))

    q_c = rotary(rq.reshape(bsz, seq, RET_HEADS, RET_DK), pos)
    k_c = rotary(rk.reshape(bsz, seq, RET_HEADS, RET_DK), pos)
    o_c = retention(q_c, k_c, rv.reshape(bsz, seq, RET_HEADS, RET_DV))
    o_c = rmsnorm(o_c, ret_norm) * jax.nn.silu(rg.reshape(bsz, seq, RET_HEADS, RET_DV))

    mixed = jnp.concatenate([o_a.reshape(bsz, seq, GDN_W), o_b.reshape(bsz, seq, SSD_W),
                             o_c.reshape(bsz, seq, RET_W)], axis=-1)
    out = jnp.einsum('ble,ed->bld', mixed, w_out.astype(F32))
    return x + rmsnorm(out, post_norm).astype(x.dtype)


def setup_inputs(seed: int = 0) -> dict:
    key = jax.random.key(seed)
    ks = jax.random.split(key, 16)
    nrm = jax.random.normal

    def inv_softplus_dt(k, shape):
        dt = jnp.exp(jax.random.uniform(k, shape, F32, np.log(1e-3), np.log(1e-1)))
        return dt + jnp.log(-jnp.expm1(-dt))

    return {
        "x": nrm(ks[0], (BATCH, SEQ, D_MODEL), F32),
        "pre_norm": 1.0 + 0.05 * nrm(ks[1], (DEPTH, D_MODEL), F32),
        "post_norm": 1.0 + 0.05 * nrm(ks[2], (DEPTH, D_MODEL), F32),
        "w_in": nrm(ks[3], (DEPTH, D_MODEL, N_IN), F32) * D_MODEL ** -0.5,
        "gdn_conv": nrm(ks[4], (DEPTH, CONV_W, GDN_CONV_CH), F32) * CONV_W ** -0.5,
        "gdn_A_log": jnp.log(jax.random.uniform(ks[5], (DEPTH, GDN_HEADS), F32, 1.0, 16.0)),
        "gdn_dt_bias": inv_softplus_dt(ks[6], (DEPTH, GDN_HEADS)),
        "gdn_norm": 1.0 + 0.05 * nrm(ks[7], (DEPTH, GDN_DV), F32),
        "ssd_conv": nrm(ks[8], (DEPTH, CONV_W, SSD_CONV_CH), F32) * CONV_W ** -0.5,
        "ssd_conv_b": 0.02 * nrm(ks[9], (DEPTH, SSD_CONV_CH), F32),
        "ssd_A_log": jnp.log(jax.random.uniform(ks[10], (DEPTH, SSD_HEADS), F32, 1.0, 16.0)),
        "ssd_dt_bias": inv_softplus_dt(ks[11], (DEPTH, SSD_HEADS)),
        "ssd_D": 1.0 + 0.1 * nrm(ks[12], (DEPTH, SSD_HEADS), F32),
        "ssd_norm": 1.0 + 0.05 * nrm(ks[13], (DEPTH, SSD_W), F32),
        "ret_norm": 1.0 + 0.05 * nrm(ks[14], (DEPTH, RET_DV), F32),
        "w_out": nrm(ks[15], (DEPTH, MIX_W, D_MODEL), F32) * MIX_W ** -0.5,
    }


def reference(x, pre_norm, post_norm, w_in, gdn_conv, gdn_A_log, gdn_dt_bias, gdn_norm,
              ssd_conv, ssd_conv_b, ssd_A_log, ssd_dt_bias, ssd_D, ssd_norm, ret_norm, w_out):
    pos = jnp.arange(x.shape[1], dtype=jnp.int32)
    for l in range(DEPTH):
        x = hybrid_layer(x, pre_norm[l], post_norm[l], w_in[l], gdn_conv[l], gdn_A_log[l], gdn_dt_bias[l],
                         gdn_norm[l], ssd_conv[l], ssd_conv_b[l], ssd_A_log[l], ssd_dt_bias[l], ssd_D[l],
                         ssd_norm[l], ret_norm[l], w_out[l], pos)
    return x
```

```cpp
#include <hip/hip_runtime.h>
#include <hip/hip_cooperative_groups.h>
#include <cstdio>
namespace cg = cooperative_groups;

#define LAS __attribute__((address_space(3)))
#define DI __device__ __forceinline__
typedef unsigned short bf16_t;
typedef short bf16x8 __attribute__((ext_vector_type(8)));
typedef float f32x4 __attribute__((ext_vector_type(4)));
typedef unsigned u32x4 __attribute__((ext_vector_type(4)));
typedef unsigned u32x2 __attribute__((ext_vector_type(2)));

constexpr int T_TOK = 65536, DM = 1024, NCHUNK = 128, NB = 8;
constexpr int NP = 6656;
constexpr int NPW = 6912;
constexpr int NIN = 6680;
constexpr int C_GZ = 0, C_SZ = 512, C_RG = 1536, C_GQ = 2048, C_GK = 2560, C_GV = 3072, C_SX = 3584, C_SB = 4608, C_SC = 4864,
              C_RQ = 5120, C_RK = 5632, C_RV = 6144;
constexpr float EPS = 1e-6f;
__device__ __forceinline__ size_t pidx(size_t row, int col) { return ((row >> 8) * 26 + (size_t)(col >> 8)) * 65536 + (row & 255) * 256 + (size_t)(col & 255); }
constexpr size_t WS_PROJ = 0;
constexpr size_t WS_H = (size_t)T_TOK * NP * 2;
constexpr size_t WS_WBUF = WS_H;
constexpr size_t WS_GCUM = WS_H + (size_t)T_TOK * 512 * 2;
constexpr size_t WS_DT = WS_GCUM + (size_t)T_TOK * 4 * 4;
constexpr size_t WS_ACUM = WS_DT + (size_t)T_TOK * 16 * 4;
constexpr size_t WS_ATG = WS_ACUM + (size_t)T_TOK * 16 * 4;
static_assert(WS_ATG + (size_t)4096 * 8192 <= WS_H + (size_t)T_TOK * DM * 2, "attention tiles must fit in the h buffer");
constexpr size_t WS_WIN = WS_H + (size_t)T_TOK * DM * 2;
constexpr size_t WS_WOUT = WS_WIN + (size_t)2 * NPW * DM * 2;
constexpr size_t WS_SMALL = WS_WOUT + (size_t)2 * 1024 * 2048 * 2;
constexpr size_t WS_HALO = WS_SMALL + (size_t)T_TOK * 32 * 4;
constexpr size_t WS_END = WS_HALO + (size_t)1024 * 3 * 3072 * 2;
constexpr size_t WS_BAR = WS_END;
constexpr size_t WS_TOTAL = WS_END + 16384;
constexpr int LDS_BAR_OFF = 160768;
constexpr int LDS_BYTES = 160768 + 16;

struct P {
    const float* x; const float* pre_norm; const float* post_norm; const float* w_in; const float* gdn_conv; const float* gdn_A_log;
    const float* gdn_dt_bias; const float* gdn_norm; const float* ssd_conv; const float* ssd_conv_b; const float* ssd_A_log;
    const float* ssd_dt_bias; const float* ssd_D; const float* ssd_norm; const float* ret_norm; const float* w_out;
    float* out; unsigned char* ws; int ph_lo, ph_hi;
};

DI int opaque_tid() { int t = threadIdx.x; asm volatile("" : "+v"(t)); return t; }
typedef float f32x2 __attribute__((ext_vector_type(2)));
typedef __bf16 bf16x2_t __attribute__((ext_vector_type(2)));
DI unsigned pk_bf16(float lo, float hi) { const f32x2 v = {lo, hi}; const bf16x2_t b = __builtin_convertvector(v, bf16x2_t); return __builtin_bit_cast(unsigned, b); }
DI float bf_lo(unsigned w) { return __uint_as_float(w << 16); }
DI float bf_hi(unsigned w) { return __uint_as_float(w & 0xffff0000u); }
DI float siluf(float v) { return v * __builtin_amdgcn_rcpf(1.0f + __expf(-v)); }
DI void unpack8(const u32x4 w, f32x2 (&o)[4]) { o[0] = (f32x2){bf_lo(w.x), bf_hi(w.x)}; o[1] = (f32x2){bf_lo(w.y), bf_hi(w.y)}; o[2] = (f32x2){bf_lo(w.z), bf_hi(w.z)}; o[3] = (f32x2){bf_lo(w.w), bf_hi(w.w)}; }
DI f32x2 silu2(f32x2 v) { const f32x2 e = (f32x2){__expf(-v[0]), __expf(-v[1])}; const f32x2 d = e + 1.0f; const f32x2 rr = (f32x2){__builtin_amdgcn_rcpf(d[0]), __builtin_amdgcn_rcpf(d[1])}; return v * rr; }
DI float softplusf(float v) { return v > 20.f ? v : log1pf(__expf(v)); }
DI float wave_scan_incl(float v, int lane) {
#pragma unroll
    for (int o = 1; o < 64; o <<= 1) { float t = __shfl_up(v, o); if (lane >= o) v += t; }
    return v;
}

#define XB_TMO      128
#define XB_XCNT(j)  (256  + 64 * (j))
#define XB_XSUB(j)  (1280 + 64 * (j))
#define XB_XGEN(j)  (2304 + 64 * (j))
#define XB_TOP      3328
#define XB_TOPGEN   3392
#define XCD_BAR_WORDS 3456
#define XB_SPIN_CAP (1u << 18)

__device__ __forceinline__ unsigned xb_ld(unsigned* p)              { return __hip_atomic_load(p, __ATOMIC_RELAXED, __HIP_MEMORY_SCOPE_AGENT); }
__device__ __forceinline__ unsigned xb_add(unsigned* p, unsigned v) { return __hip_atomic_fetch_add(p, v, __ATOMIC_RELAXED, __HIP_MEMORY_SCOPE_AGENT); }
__device__ __forceinline__ unsigned xb_xcc_id() { return (unsigned)__builtin_amdgcn_s_getreg((3 << 11) | 20) & 0xFu; }
#define XB_SPIN(cond, bar) do { unsigned _sp = 0; while (cond) { __builtin_amdgcn_s_sleep(1); \
    if ((++_sp & 255u) == 0u) { if (xb_ld(&(bar)[XB_TMO])) break; if (_sp > XB_SPIN_CAP) { atomicAdd(&(bar)[XB_TMO], 1u); break; } } } } while (0)

struct XcdBarrier {
    unsigned* bar; unsigned x;
    volatile LAS unsigned* st;
};

__device__ __forceinline__ XcdBarrier xcd_barrier_post(unsigned* bar, volatile LAS unsigned* st) {
    XcdBarrier b; b.bar = bar; b.x = xb_xcc_id(); b.st = st;
    if (threadIdx.x == 0) (void)xb_add(&bar[XB_XCNT(b.x)], 1u);
    return b;
}
__device__ __forceinline__ void xcd_barrier_complete(unsigned* bar, unsigned x, unsigned& nloc, unsigned& nx) {
    const unsigned G = gridDim.x * gridDim.y * gridDim.z;
    unsigned sum, cnt, mine, sp = 0u;
    for (;;) {
        sum = 0u; cnt = 0u; mine = 0u;
#pragma unroll
        for (unsigned j = 0; j < 16; ++j) { const unsigned c = xb_ld(&bar[XB_XCNT(j)]); sum += c; cnt += (c > 0u) ? 1u : 0u; mine = (j == x) ? c : mine; }
        if (sum == G) break;
        __builtin_amdgcn_s_sleep(1);
        if ((++sp & 255u) == 0u) { if (xb_ld(&bar[XB_TMO])) break; if (sp > XB_SPIN_CAP) { atomicAdd(&bar[XB_TMO], 1u); break; } }
    }
    nloc = mine > 0u ? mine : 1u; nx = cnt > 0u ? cnt : 1u;
}

__device__ __forceinline__ void xcd_barrier(const XcdBarrier& b) {
    asm volatile("s_waitcnt vmcnt(0)" ::: "memory");
    __syncthreads();
    if (threadIdx.x == 0) {
        unsigned* bar = b.bar;
        __builtin_amdgcn_s_waitcnt(0);
        unsigned nloc = b.st[0], nx = b.st[1];
        if (nloc == 0u) { xcd_barrier_complete(bar, b.x, nloc, nx); b.st[0] = nloc; b.st[1] = nx; }
        const unsigned old = xb_add(&bar[XB_XSUB(b.x)], 1u);
        const unsigned gen = old / nloc;
        if (old + 1u == (gen + 1u) * nloc) {
            __builtin_amdgcn_fence(__ATOMIC_RELEASE, "agent");
            asm volatile("s_waitcnt vmcnt(0)" ::: "memory");
            const unsigned og = xb_add(&bar[XB_TOP], 1u);
            const unsigned tg = og / nx;
            if (og + 1u == (tg + 1u) * nx) xb_add(&bar[XB_TOPGEN], 1u);
            else XB_SPIN(xb_ld(&bar[XB_TOPGEN]) == tg, bar);
            __builtin_amdgcn_fence(__ATOMIC_ACQUIRE, "agent");
            xb_add(&bar[XB_XGEN(b.x)], 1u);
            asm volatile("s_waitcnt vmcnt(0)" ::: "memory");
        } else {
            XB_SPIN(xb_ld(&bar[XB_XGEN(b.x)]) == gen, bar);
            __builtin_amdgcn_fence(__ATOMIC_ACQUIRE, "agent");
            asm volatile("s_waitcnt vmcnt(0)" ::: "memory");
        }
    }
    __syncthreads();
}


namespace pg8 {
constexpr int BM = 256, BK = 64, HALF = 128, HTB = HALF * BK * 2, NXCD = 8, WGM = 4;
DI int lds_byte(int r, int c) { const int st = (r >> 4) * 2 + (c >> 5), rr = r & 15, cc = c & 31, ob = rr * 64 + cc * 2; return st * 1024 + (ob ^ (((ob >> 9) & 1) << 5)); }
DI void stage_rc(int b, int& R, int& C) { const int st = b / 1024, sb = b % 1024, swz = sb ^ (((sb >> 9) & 1) << 5); R = (st >> 1) * 16 + swz / 64; C = (st & 1) * 32 + (swz % 64) / 2; }
DI int perm32(int rho) { const int n = rho >> 4, i = rho & 15; return 8 * (i >> 2) + 4 * n + (i & 3); }
struct Unit { int pm, pn; };
struct Gemm { const bf16_t* A; const bf16_t* Bt; int M, N, K, lda, atiled; };
struct StaticOrder {
    int nM, nN, nwg, G, c;
    DI void init(int M, int N, int G_, int c_) { nM = M / BM; nN = N / BM; nwg = nM * nN; G = G_; c = c_; }
    DI bool next(int i, Unit& u) const {
        const long L = (long)i * G + c; if (L >= nwg) return false;
        int wgid = (int)L; { const int q = nwg / NXCD, r = nwg % NXCD, xcd = wgid % NXCD, off = wgid / NXCD; wgid = (xcd < r ? xcd * (q + 1) : r * (q + 1) + (xcd - r) * q) + off; }
        const int nig = WGM * nN, gid = wgid / nig, fm = gid * WGM, gsz = (nM - fm) < WGM ? (nM - fm) : WGM;
        u.pm = fm + ((wgid % nig) % gsz); u.pn = (wgid % nig) / gsz; return true;
    }
};

template <class Epi>
DI void gemm_phase(LAS unsigned char* lds, const Gemm g, const StaticOrder& S, const Epi& E) {
    const int tid = opaque_tid(), wid = __builtin_amdgcn_readfirstlane(tid >> 6), lane = tid & 63, wr = wid >> 2, wc = wid & 3, fr = lane & 15, fq = lane >> 4;
    const int K = g.K, nt = K / BK, lda = g.lda;
    unsigned voffA[2], voffB[2];
#pragma unroll
    for (int i = 0; i < 2; ++i) { int R, C; stage_rc(tid * 16 + i * 8192, R, C); const int Rb = Epi::PERM ? ((R & ~31) + perm32(R & 31)) : R;
        voffA[i] = (unsigned)(R * lda + C) * 2u; voffB[i] = (unsigned)(Rb * K + C) * 2u; }
    const size_t kstep = (size_t)(BK * 2);
    const size_t hA = (size_t)HALF * lda * 2, hB = (size_t)HALF * K * 2;
    const size_t tA = g.atiled ? (size_t)26 * 131072 : 2 * hA, tB = 2 * hB;
    const int atiled = g.atiled;
#define PG8_AKOFF(t) (atiled ? ((size_t)((t) >> 2) * 131072 + (size_t)((t) & 3) * 128) : (size_t)(t) * kstep)
    const unsigned ldsw = (unsigned)wid * 1024u;
    const int aoff = lds_byte(wr * 64 + fr, fq * 8), boff = lds_byte(wc * 32 + fr, fq * 8);
#define PG8_SA(b, h) (((b) * 2 + (h)) * HTB)
#define PG8_SB(b, h) ((4 + (b) * 2 + (h)) * HTB)
#define PG8_STAGE(bufoff, gbase, voff) do { _Pragma("unroll") for (int _i = 0; _i < 2; ++_i) \
        __builtin_amdgcn_global_load_lds((const unsigned*)((const char*)(gbase) + (voff)[_i]), (LAS unsigned*)(lds + (bufoff) + ldsw + _i * 8192), 16, 0, 0); } while (0)
#define PG8_LDA(dst, b, h) do { _Pragma("unroll") for (int m = 0; m < 4; ++m) _Pragma("unroll") for (int k = 0; k < 2; ++k) dst[m][k] = *(const LAS bf16x8*)(lds + PG8_SA(b, h) + aoff + m * 2048 + k * 1024); } while (0)
#define PG8_LDB(dst, b, h) do { _Pragma("unroll") for (int n = 0; n < 2; ++n) _Pragma("unroll") for (int k = 0; k < 2; ++k) dst[n][k] = *(const LAS bf16x8*)(lds + PG8_SB(b, h) + boff + n * 2048 + k * 1024); } while (0)
#define PG8_MMA(ai, bj, At, Bt) do { __builtin_amdgcn_s_setprio(1); _Pragma("unroll") for (int m = 0; m < 4; ++m) _Pragma("unroll") for (int n = 0; n < 2; ++n) _Pragma("unroll") for (int k = 0; k < 2; ++k) \
        acc[ai][bj][m][n] = __builtin_amdgcn_mfma_f32_16x16x32_bf16(Bt[n][k], At[m][k], acc[ai][bj][m][n], 0, 0, 0); __builtin_amdgcn_s_setprio(0); } while (0)
#define PG8_WAIT_V(n) asm volatile("s_waitcnt vmcnt(" #n ")" ::: "memory")
#define PG8_WAIT_L(n) asm volatile("s_waitcnt lgkmcnt(" #n ")" ::: "memory")
#define PG8_BAR __builtin_amdgcn_s_barrier()
#define PG8_SCHED __builtin_amdgcn_sched_barrier(0)
    Unit cur, nxt; int ui = 0;
    if (!S.next(0, cur)) return;
    f32x4 acc[2][2][4][2];
#pragma unroll
    for (int a = 0; a < 2; ++a)
#pragma unroll
        for (int b = 0; b < 2; ++b)
#pragma unroll
            for (int m = 0; m < 4; ++m)
#pragma unroll
                for (int n = 0; n < 2; ++n) acc[a][b][m][n] = (f32x4){0.f, 0.f, 0.f, 0.f};
    bf16x8 At[4][2], B0[2][2], B1[2][2];
    const char* cA = (const char*)g.A + (size_t)cur.pm * tA; const char* cB = (const char*)g.Bt + (size_t)cur.pn * tB;
    PG8_STAGE(PG8_SB(0, 0), cB, voffB); PG8_STAGE(PG8_SB(0, 1), cB + hB, voffB); PG8_STAGE(PG8_SA(0, 0), cA, voffA); PG8_STAGE(PG8_SA(0, 1), cA + hA, voffA);
    if (wr == 1) PG8_BAR;
    PG8_WAIT_V(2); PG8_BAR;
    PG8_STAGE(PG8_SB(1, 0), cB + kstep, voffB); PG8_STAGE(PG8_SA(1, 0), cA + kstep, voffA); PG8_STAGE(PG8_SB(1, 1), cB + hB + kstep, voffB);
    PG8_WAIT_V(6); PG8_BAR;
    for (;;) {
        const bool has_next = S.next(ui + 1, nxt);
        const char* nA = has_next ? (const char*)g.A + (size_t)nxt.pm * tA : cA; const char* nB = has_next ? (const char*)g.Bt + (size_t)nxt.pn * tB : cB;
        for (int t = 0; t < nt; t += 2) {
            const bool last = (t == nt - 2);
            const char* a1 = cA + PG8_AKOFF(t + 1);
            const char* a2 = last ? nA : cA + PG8_AKOFF(t + 2); const char* b2 = last ? nB : cB + (size_t)(t + 2) * kstep;
            const char* a3 = a2 + kstep; const char* b3 = b2 + kstep;
            PG8_LDB(B0, 0, 0); PG8_LDB(B1, 0, 1); PG8_SCHED; PG8_LDA(At, 0, 0); PG8_STAGE(PG8_SA(1, 1), a1 + hA, voffA);
            PG8_WAIT_V(8); PG8_WAIT_L(0); PG8_BAR; PG8_MMA(0, 0, At, B0); PG8_MMA(0, 1, At, B1); PG8_BAR; PG8_SCHED;
            PG8_LDA(At, 0, 1); PG8_STAGE(PG8_SB(0, 0), b2, voffB); PG8_STAGE(PG8_SB(0, 1), b2 + hB, voffB); PG8_STAGE(PG8_SA(0, 0), a2, voffA);
            PG8_WAIT_V(8); PG8_WAIT_L(0); PG8_BAR; PG8_MMA(1, 0, At, B0); PG8_MMA(1, 1, At, B1); PG8_BAR; PG8_SCHED;
            PG8_LDB(B0, 1, 0); PG8_LDB(B1, 1, 1); PG8_SCHED; PG8_LDA(At, 1, 0); PG8_STAGE(PG8_SA(0, 1), a2 + hA, voffA);
            PG8_WAIT_V(8); PG8_WAIT_L(0); PG8_BAR; PG8_MMA(0, 0, At, B0); PG8_MMA(0, 1, At, B1); PG8_BAR; PG8_SCHED;
            PG8_LDA(At, 1, 1); PG8_STAGE(PG8_SB(1, 0), b3, voffB); PG8_STAGE(PG8_SB(1, 1), b3 + hB, voffB); PG8_STAGE(PG8_SA(1, 0), a3, voffA);
            PG8_WAIT_V(8); PG8_WAIT_L(0); PG8_BAR; PG8_MMA(1, 0, At, B0); PG8_MMA(1, 1, At, B1); PG8_BAR; PG8_SCHED;
        }
        if (wr == 0) PG8_BAR;
        E(acc, cur, wr, wc, fr, fq);
        if (!has_next) break;
#pragma unroll
        for (int a = 0; a < 2; ++a)
#pragma unroll
            for (int b = 0; b < 2; ++b)
#pragma unroll
                for (int m = 0; m < 4; ++m)
#pragma unroll
                    for (int n = 0; n < 2; ++n) acc[a][b][m][n] = (f32x4){0.f, 0.f, 0.f, 0.f};
        cur = nxt; cA = nA; cB = nB; ++ui;
        if (wr == 1) PG8_BAR;
    }
    PG8_WAIT_V(0);
    PG8_BAR;
#undef PG8_SA
#undef PG8_AKOFF
#undef PG8_SB
#undef PG8_STAGE
#undef PG8_LDA
#undef PG8_LDB
#undef PG8_MMA
#undef PG8_WAIT_V
#undef PG8_WAIT_L
#undef PG8_BAR
#undef PG8_SCHED
}
}

struct EpiProj {
    static constexpr bool PERM = true;
    bf16_t* proj; float* small; bf16_t* halo;
    DI void operator()(const f32x4 (&acc)[2][2][4][2], const pg8::Unit& u, int wr, int wc, int fr, int fq) const {
        const int row0 = u.pm * 256 + wr * 64 + fr;
        if (u.pn < 26) {
            const int col0 = u.pn * 256 + wc * 32 + 8 * fq;
            const bool conv = (u.pn >= 8 && u.pn < 20);
#pragma unroll
            for (int ai = 0; ai < 2; ++ai)
#pragma unroll
                for (int m = 0; m < 4; ++m) {
                    const int row = row0 + ai * 128 + m * 16;
                    bf16_t* rowp = proj + pidx((size_t)row, col0);
#pragma unroll
                    for (int bj = 0; bj < 2; ++bj) {
                        const f32x4 v0 = acc[ai][bj][m][0], v1 = acc[ai][bj][m][1];
                        u32x4 w; w.x = pk_bf16(v0[0], v0[1]); w.y = pk_bf16(v0[2], v0[3]); w.z = pk_bf16(v1[0], v1[1]); w.w = pk_bf16(v1[2], v1[3]);
                        *(u32x4*)(rowp + bj * 128) = w;
                        if (m == 3 && conv && fr >= 13)
                            *(u32x4*)(halo + ((size_t)(row >> 6) * 3 + (fr - 13)) * 3072 + (col0 + bj * 128 - 2048)) = w;
                    }
                }
        } else if (wc == 0) {
#pragma unroll
            for (int ai = 0; ai < 2; ++ai)
#pragma unroll
                for (int m = 0; m < 4; ++m) {
                    const int row = row0 + ai * 128 + m * 16;
                    float* pp = small + (size_t)row * 32 + 8 * fq;
                    *(f32x4*)pp = acc[ai][0][m][0]; *(f32x4*)(pp + 4) = acc[ai][0][m][1];
                }
        }
    }
};
struct EpiOut {
    static constexpr bool PERM = true;
    bf16_t* O;
    DI void operator()(const f32x4 (&acc)[2][2][4][2], const pg8::Unit& u, int wr, int wc, int fr, int fq) const {
        const int row0 = u.pm * 256 + wr * 64 + fr, col0 = u.pn * 256 + wc * 32 + 8 * fq;
#pragma unroll
        for (int ai = 0; ai < 2; ++ai)
#pragma unroll
            for (int m = 0; m < 4; ++m) {
                bf16_t* rowp = O + pidx((size_t)(row0 + ai * 128 + m * 16), 2048 + col0);
#pragma unroll
                for (int bj = 0; bj < 2; ++bj) {
                    const f32x4 v0 = acc[ai][bj][m][0], v1 = acc[ai][bj][m][1];
                    u32x4 w; w.x = pk_bf16(v0[0], v0[1]); w.y = pk_bf16(v0[2], v0[3]); w.z = pk_bf16(v1[0], v1[1]); w.w = pk_bf16(v1[2], v1[3]);
                    *(u32x4*)(rowp + bj * 128) = w;
                }
            }
    }
};

template <int KSTEPS>
DI f32x4 mma_tile(f32x4 acc, const LAS bf16_t* A, int lda, const LAS bf16_t* B, int ldb, int r, int q) {
#pragma unroll
    for (int k = 0; k < KSTEPS; ++k) {
        const bf16x8 a = *(const LAS bf16x8*)(A + r * lda + k * 32 + q * 8);
        const bf16x8 b = *(const LAS bf16x8*)(B + r * ldb + k * 32 + q * 8);
        acc = __builtin_amdgcn_mfma_f32_16x16x32_bf16(a, b, acc, 0, 0, 0);
    }
    return acc;
}

template <int KS> DI void ldfrag(bf16x8 (&f)[KS], const LAS bf16_t* base, int ld, int r, int q) {
#pragma unroll
    for (int k = 0; k < KS; ++k) f[k] = *(const LAS bf16x8*)(base + r * ld + k * 32 + q * 8);
}
template <int KS> DI f32x4 mmafrag(f32x4 acc, const bf16x8 (&a)[KS], const bf16x8 (&b)[KS]) {
#pragma unroll
    for (int k = 0; k < KS; ++k) acc = __builtin_amdgcn_mfma_f32_16x16x32_bf16(a[k], b[k], acc, 0, 0, 0);
    return acc;
}

DI int orig_col(int n) {
    if (n < 512) return 1536 + n;
    if (n < 1536) return 3592 + (n - 512);
    if (n < 2048) return 6168 + (n - 1536);
    if (n < 3584) return n - 2048;
    if (n < 5120) return 2056 + (n - 3584);
    if (n < 6656) return 4632 + (n - 5120);
    if (n < 6664) return 2048 + (n - 6656);
    if (n < 6680) return 4616 + (n - 6664);
    return -1;
}
__device__ void phase_convert(const P& p) {
    bf16_t* WinT = (bf16_t*)(p.ws + WS_WIN); bf16_t* WoutT = (bf16_t*)(p.ws + WS_WOUT);
    const size_t gsz = (size_t)gridDim.x * blockDim.x, g0 = (size_t)blockIdx.x * blockDim.x + opaque_tid();
    const size_t n1 = (size_t)2 * 128 * NPW;
    for (size_t i = g0; i < n1; i += gsz) {
        const int n = (int)(i % NPW); const int k8 = (int)((i / NPW) % 128); const int l = (int)(i / ((size_t)NPW * 128));
        const int oc = orig_col(n);
        float v[8];
#pragma unroll
        for (int e = 0; e < 8; ++e) v[e] = oc >= 0 ? p.w_in[((size_t)l * 1024 + k8 * 8 + e) * NIN + oc] : 0.f;
        u32x4 w; w.x = pk_bf16(v[0], v[1]); w.y = pk_bf16(v[2], v[3]); w.z = pk_bf16(v[4], v[5]); w.w = pk_bf16(v[6], v[7]);
        *(u32x4*)(WinT + ((size_t)l * NPW + n) * 1024 + k8 * 8) = w;
    }
    const size_t n2 = (size_t)2 * 256 * 1024;
    for (size_t i = g0; i < n2; i += gsz) {
        const int n = (int)(i % 1024); const int k8 = (int)((i / 1024) % 256); const int l = (int)(i / (1024 * 256));
        float v[8];
#pragma unroll
        for (int e = 0; e < 8; ++e) v[e] = p.w_out[((size_t)l * 2048 + k8 * 8 + e) * 1024 + n];
        u32x4 w; w.x = pk_bf16(v[0], v[1]); w.y = pk_bf16(v[2], v[3]); w.z = pk_bf16(v[4], v[5]); w.w = pk_bf16(v[6], v[7]);
        *(u32x4*)(WoutT + ((size_t)l * 1024 + n) * 2048 + k8 * 8) = w;
    }
}
__device__ void phase_rows(const float* xin, const bf16_t* o, int ldo, const float* post, float* xout, const float* pre, bf16_t* h) {
    const int tid_ = opaque_tid(); const int lane = tid_ & 63, wv = tid_ >> 6;
    const int stride = gridDim.x * 8;
    f32x4 xn[4]; u32x2 on[4];
#define R_LOAD(rr) do { _Pragma("unroll") for (int j = 0; j < 4; ++j) { xn[j] = __builtin_nontemporal_load((const f32x4*)(xin + (size_t)(rr) * DM + j * 256 + lane * 4)); \
        if (o) on[j] = __builtin_nontemporal_load((const u32x2*)(o + pidx((size_t)(rr), 2048 + j * 256 + lane * 4))); } } while (0)
    int row = blockIdx.x * 8 + wv;
#pragma unroll
    for (int j = 0; j < 4; ++j) on[j] = (u32x2){0u, 0u};
    if (row < T_TOK) R_LOAD(row);
    for (; row < T_TOK; row += stride) {
        f32x4 xv[4]; u32x2 ow[4];
#pragma unroll
        for (int j = 0; j < 4; ++j) { xv[j] = xn[j]; ow[j] = on[j]; }
        if (row + stride < T_TOK) R_LOAD(row + stride);
        if (o) {
            f32x4 ov[4]; float ss = 0.f;
#pragma unroll
            for (int j = 0; j < 4; ++j) { ov[j] = (f32x4){bf_lo(ow[j].x), bf_hi(ow[j].x), bf_lo(ow[j].y), bf_hi(ow[j].y)}; ss += ov[j][0] * ov[j][0] + ov[j][1] * ov[j][1] + ov[j][2] * ov[j][2] + ov[j][3] * ov[j][3]; }
#pragma unroll
            for (int s = 1; s < 64; s <<= 1) ss += __shfl_xor(ss, s);
            const float rs = rsqrtf(ss * (1.0f / DM) + EPS);
#pragma unroll
            for (int j = 0; j < 4; ++j) { const f32x4 pw = *(const f32x4*)(post + j * 256 + lane * 4); xv[j] += ov[j] * rs * pw;
                *(f32x4*)(xout + (size_t)row * DM + j * 256 + lane * 4) = xv[j]; }
        }
        if (pre) {
            float ss = 0.f;
#pragma unroll
            for (int j = 0; j < 4; ++j) ss += xv[j][0] * xv[j][0] + xv[j][1] * xv[j][1] + xv[j][2] * xv[j][2] + xv[j][3] * xv[j][3];
#pragma unroll
            for (int s = 1; s < 64; s <<= 1) ss += __shfl_xor(ss, s);
            const float rs = rsqrtf(ss * (1.0f / DM) + EPS);
#pragma unroll
            for (int j = 0; j < 4; ++j) { const f32x4 pw = *(const f32x4*)(pre + j * 256 + lane * 4); const f32x4 hv = xv[j] * rs * pw;
                u32x2 w; w.x = pk_bf16(hv[0], hv[1]); w.y = pk_bf16(hv[2], hv[3]); *(u32x2*)(h + (size_t)row * DM + j * 256 + lane * 4) = w; }
        }
    }
#undef R_LOAD
}

__device__ void phaseB_gdn(LAS unsigned char* lds, const P& p, int layer, int chunkg, int h) {
    const int tid = opaque_tid(), lane = tid & 63, wid = tid >> 6, r = lane & 15, q = lane >> 4;
    const int c = chunkg & 127;
    const size_t t0 = (size_t)chunkg * 64;
    bf16_t* proj = (bf16_t*)(p.ws + WS_PROJ); const bf16_t* halo = (const bf16_t*)(p.ws + WS_HALO);
    const float* small = (const float*)(p.ws + WS_SMALL);
    LAS bf16_t* kb = (LAS bf16_t*)lds;
    LAS float* rhs = (LAS float*)(lds + 17408);
    LAS float* Am = (LAS float*)(lds + 17408 + 65536);
    LAS float* gS = (LAS float*)(lds + 17408 + 65536 + 16384);
    const float* cw = p.gdn_conv + (size_t)layer * 4 * 1536;
    LAS float* cwS = (LAS float*)(lds + 17408 + 65536 + 16384 + 512);
    float braw = 0.f, araw = 0.f;
    if (wid == 0) { braw = small[(t0 + lane) * 32 + h]; araw = small[(t0 + lane) * 32 + 4 + h]; }
    float wl[3];
#pragma unroll
    for (int k = 0; k < 3; ++k) { const int rem = tid; wl[k] = cw[(rem >> 7) * 1536 + k * 512 + h * 128 + (rem & 127)]; }
    u32x4 xr[3][2][4];
#pragma unroll
    for (int s = 0; s < 3; ++s)
#pragma unroll
        for (int pass = 0; pass < 2; ++pass) {
            const int tok = pass * 32 + (tid >> 4), seg = tid & 15, col = C_GQ + s * 512 + h * 128 + seg * 8;
#pragma unroll
            for (int d = 0; d < 4; ++d) {
                const int tt = tok - 3 + d;
                u32x4 v = (u32x4){0u, 0u, 0u, 0u};
                if (tt >= 0) v = *(const u32x4*)(proj + pidx(t0 + tt, col));
                else if (c > 0) v = *(const u32x4*)(halo + ((size_t)(chunkg - 1) * 3 + (tt + 3)) * 3072 + (col - 2048));
                xr[s][pass][d] = v;
            }
        }
#pragma unroll
    for (int k = 0; k < 3; ++k) cwS[k * 512 + tid] = wl[k];
    if (wid == 0) {
        const float beta = 1.0f / (1.0f + __expf(-braw));
        const float g = -__expf(p.gdn_A_log[layer * 4 + h]) * softplusf(araw + p.gdn_dt_bias[layer * 4 + h]);
        const float gc = wave_scan_incl(g, lane);
        gS[lane] = gc; gS[64 + lane] = beta;
        ((float*)(p.ws + WS_GCUM))[(t0 + lane) * 4 + h] = gc;
    }
    __syncthreads();
    u32x4 qpk[2];
#pragma unroll
    for (int s = 0; s < 3; ++s) {
#pragma unroll
        for (int pass = 0; pass < 2; ++pass) {
            const int tok = pass * 32 + (tid >> 4), seg = tid & 15;
            f32x2 v2[4];
#pragma unroll
            for (int k = 0; k < 4; ++k) v2[k] = (f32x2){0.f, 0.f};
#pragma unroll
            for (int d = 0; d < 4; ++d) {
                f32x2 x2[4]; unpack8(xr[s][pass][d], x2);
                const f32x4 w0 = *(const LAS f32x4*)(cwS + s * 512 + d * 128 + seg * 8), w1 = *(const LAS f32x4*)(cwS + s * 512 + d * 128 + seg * 8 + 4);
                v2[0] = __builtin_elementwise_fma((f32x2){w0[0], w0[1]}, x2[0], v2[0]); v2[1] = __builtin_elementwise_fma((f32x2){w0[2], w0[3]}, x2[1], v2[1]);
                v2[2] = __builtin_elementwise_fma((f32x2){w1[0], w1[1]}, x2[2], v2[2]); v2[3] = __builtin_elementwise_fma((f32x2){w1[2], w1[3]}, x2[3], v2[3]);
            }
            f32x2 ss2 = (f32x2){0.f, 0.f};
#pragma unroll
            for (int k = 0; k < 4; ++k) { v2[k] = silu2(v2[k]); ss2 = __builtin_elementwise_fma(v2[k], v2[k], ss2); }
            float ss = ss2[0] + ss2[1];
            if (s < 2) {
                ss += __shfl_xor(ss, 1); ss += __shfl_xor(ss, 2); ss += __shfl_xor(ss, 4); ss += __shfl_xor(ss, 8);
                const float rn = rsqrtf(ss + EPS) * (s == 0 ? 0.08838834764831845f : 1.0f);
#pragma unroll
                for (int k = 0; k < 4; ++k) v2[k] *= rn;
            }
            const float val[8] = {v2[0][0], v2[0][1], v2[1][0], v2[1][1], v2[2][0], v2[2][1], v2[3][0], v2[3][1]};
            if (s == 0) {
                u32x4 w; w.x = pk_bf16(val[0], val[1]); w.y = pk_bf16(val[2], val[3]); w.z = pk_bf16(val[4], val[5]); w.w = pk_bf16(val[6], val[7]);
                qpk[pass] = w;
                *(LAS u32x4*)((LAS bf16_t*)(lds + 106496) + tok * 136 + seg * 8) = w;
            } else if (s == 1) {
                u32x4 w; w.x = pk_bf16(val[0], val[1]); w.y = pk_bf16(val[2], val[3]); w.z = pk_bf16(val[4], val[5]); w.w = pk_bf16(val[6], val[7]);
                *(LAS u32x4*)(kb + tok * 136 + seg * 8) = w;
                const float f = gS[64 + tok] * __expf(gS[tok]);
                *(LAS f32x4*)(rhs + tok * 256 + 128 + seg * 8) = (f32x4){f * val[0], f * val[1], f * val[2], f * val[3]};
                *(LAS f32x4*)(rhs + tok * 256 + 128 + seg * 8 + 4) = (f32x4){f * val[4], f * val[5], f * val[6], f * val[7]};
            } else {
                const float f = gS[64 + tok];
                *(LAS f32x4*)(rhs + tok * 256 + seg * 8) = (f32x4){f * val[0], f * val[1], f * val[2], f * val[3]};
                *(LAS f32x4*)(rhs + tok * 256 + seg * 8 + 4) = (f32x4){f * val[4], f * val[5], f * val[6], f * val[7]};
            }
        }
    }
    __syncthreads();
#pragma unroll
    for (int pass = 0; pass < 2; ++pass) {
        const int item = pass * 512 + tid, tok = item >> 4, seg = item & 15;
        *(u32x4*)(proj + pidx(t0 + tok, C_GQ + h * 128 + seg * 8)) = qpk[pass];
    }
#pragma unroll
    for (int tt = 0; tt < 2; ++tt) {
        const int id = wid * 2 + tt, mt = id >> 2, nt = id & 3;
        f32x4 acc = (f32x4){0.f, 0.f, 0.f, 0.f};
        acc = mma_tile<4>(acc, kb + mt * 16 * 136, 136, kb + nt * 16 * 136, 136, r, q);
        const int j = nt * 16 + r; const float gj = gS[j];
        f32x4 av;
#pragma unroll
        for (int jj = 0; jj < 4; ++jj) {
            const int i = mt * 16 + q * 4 + jj;
            av[jj] = (j < i) ? -(gS[64 + i] * acc[jj] * __expf(gS[i] - gj)) : 0.f;
        }
        *(LAS f32x4*)(Am + j * 64 + mt * 16 + q * 4) = av;
        {
            f32x4 at = (f32x4){0.f, 0.f, 0.f, 0.f};
            at = mma_tile<4>(at, kb + mt * 16 * 136, 136, (const LAS bf16_t*)(lds + 106496) + nt * 16 * 136, 136, r, q);
            const int i2 = nt * 16 + r; const float gi = gS[i2];
            float f[4];
#pragma unroll
            for (int jj = 0; jj < 4; ++jj) { const int jt = mt * 16 + q * 4 + jj; f[jj] = (jt <= i2) ? at[jj] * __expf(gi - gS[jt]) : 0.f; }
            u32x2 w; w.x = pk_bf16(f[0], f[1]); w.y = pk_bf16(f[2], f[3]);
            *(u32x2*)((bf16_t*)(p.ws + WS_ATG) + ((size_t)chunkg * 4 + h) * 4096 + i2 * 64 + mt * 16 + q * 4) = w;
        }
    }
    __syncthreads();
    if (tid < 256) {
        float xs[64];
        int zoff; asm volatile("v_mov_b32 %0, 0" : "=v"(zoff));
        const LAS float* Az = Am + zoff;
        {
            f32x2 x2[32];
#pragma unroll
            for (int k = 0; k < 32; ++k) x2[k] = (f32x2){rhs[(2 * k) * 256 + tid], rhs[(2 * k + 1) * 256 + tid]};
            f32x4 an[16], ac[16];
#pragma unroll
            for (int k = 0; k < 16; ++k) an[k] = *(const LAS f32x4*)(Az + 4 * k);
#pragma unroll
            for (int j = 0; j < 63; ++j) {
#pragma unroll
                for (int k = 0; k < 16; ++k) ac[k] = an[k];
                if (j + 1 < 63) {
#pragma unroll
                    for (int k = (j + 2) / 4; k < 16; ++k) an[k] = *(const LAS f32x4*)(Az + (j + 1) * 64 + 4 * k);
                }
                __builtin_amdgcn_sched_barrier(0);
                const float xj = x2[j >> 1][j & 1];
                const f32x2 xj2 = (f32x2){xj, xj};
#pragma unroll
                for (int k = (j + 1) >> 1; k < 32; ++k) {
                    const f32x2 a2 = (k & 1) ? (f32x2){ac[k >> 1][2], ac[k >> 1][3]} : (f32x2){ac[k >> 1][0], ac[k >> 1][1]};
                    x2[k] = __builtin_elementwise_fma(a2, xj2, x2[k]);
                }
                __builtin_amdgcn_sched_barrier(0);
            }
#pragma unroll
            for (int k = 0; k < 32; ++k) { xs[2 * k] = x2[k][0]; xs[2 * k + 1] = x2[k][1]; }
        }
        if (tid < 128) {
            const int e = tid >> 6, dvl = tid & 63;
            bf16_t* dst = proj + pidx(t0 + dvl, C_GV + h * 128 + e * 64);
#pragma unroll
            for (int k = 0; k < 8; ++k) {
                u32x4 w; w.x = pk_bf16(xs[8 * k], xs[8 * k + 1]); w.y = pk_bf16(xs[8 * k + 2], xs[8 * k + 3]); w.z = pk_bf16(xs[8 * k + 4], xs[8 * k + 5]); w.w = pk_bf16(xs[8 * k + 6], xs[8 * k + 7]);
                *(u32x4*)(dst + 8 * k) = w;
            }
        } else {
            bf16_t* wb = (bf16_t*)(p.ws + WS_WBUF) + t0 * 512 + h * 128 + (tid - 128);
#pragma unroll
            for (int i = 0; i < 64; ++i) wb[(size_t)i * 512] = (bf16_t)(pk_bf16(xs[i], 0.f) & 0xffffu);
        }
    }
#pragma unroll
    for (int pass = 0; pass < 2; ++pass) {
        const int item = pass * 512 + tid, tok = item >> 4, seg = item & 15;
        *(u32x4*)(proj + pidx(t0 + tok, C_GK + h * 128 + seg * 8)) = *(const LAS u32x4*)(kb + tok * 136 + seg * 8);
    }
    __syncthreads();
}
__device__ void phaseB_ssd(const P& p, int layer, int chunkg) {
    const int tid = opaque_tid(), lane = tid & 63, wid = tid >> 6;
    const int c = chunkg & 127;
    const size_t t0 = (size_t)chunkg * 64;
    bf16_t* proj = (bf16_t*)(p.ws + WS_PROJ); const bf16_t* halo = (const bf16_t*)(p.ws + WS_HALO);
    const float* small = (const float*)(p.ws + WS_SMALL);
#pragma unroll
    for (int k = 0; k < 2; ++k) {
        const int hd = wid * 2 + k;
        const float dt = softplusf(small[(t0 + lane) * 32 + 8 + hd] + p.ssd_dt_bias[layer * 16 + hd]);
        const float a = -__expf(p.ssd_A_log[layer * 16 + hd]) * dt;
        const float ac = wave_scan_incl(a, lane);
        { ((float*)(p.ws + WS_DT))[(t0 + lane) * 16 + hd] = dt;
        ((float*)(p.ws + WS_ACUM))[(t0 + lane) * 16 + hd] = ac; }
    }
    const int seg = tid % 192, half = tid / 192;
    const int col = C_SX + seg * 8, ch = seg * 8;
    const bool act = tid < 384;
    u32x4 win[3];
    win[0] = win[1] = win[2] = (u32x4){0u, 0u, 0u, 0u};
    u32x4 rows[32];
    f32x2 wg2[4][4], bias2[4];
    if (act) {
        if (half == 1) {
#pragma unroll
            for (int d = 0; d < 3; ++d) win[d] = *(const u32x4*)(proj + pidx(t0 + 29 + d, col));
        } else if (c > 0) {
#pragma unroll
            for (int d = 0; d < 3; ++d) win[d] = *(const u32x4*)(halo + ((size_t)(chunkg - 1) * 3 + d) * 3072 + (col - 2048));
        }
#pragma unroll
        for (int k = 0; k < 32; ++k) rows[k] = *(const u32x4*)(proj + pidx(t0 + half * 32 + k, col));
        const float* cw = p.ssd_conv + (size_t)layer * 4 * 1536; const float* cb = p.ssd_conv_b + (size_t)layer * 1536;
#pragma unroll
        for (int d = 0; d < 4; ++d) {
            const f32x4 a = *(const f32x4*)(cw + d * 1536 + ch), bq = *(const f32x4*)(cw + d * 1536 + ch + 4);
            wg2[d][0] = (f32x2){a[0], a[1]}; wg2[d][1] = (f32x2){a[2], a[3]}; wg2[d][2] = (f32x2){bq[0], bq[1]}; wg2[d][3] = (f32x2){bq[2], bq[3]};
        }
        { const f32x4 a = *(const f32x4*)(cb + ch), bq = *(const f32x4*)(cb + ch + 4);
          bias2[0] = (f32x2){a[0], a[1]}; bias2[1] = (f32x2){a[2], a[3]}; bias2[2] = (f32x2){bq[0], bq[1]}; bias2[3] = (f32x2){bq[2], bq[3]}; }
    }
    __syncthreads();
    if (act) {
        f32x2 w0[4], w1[4], w2[4];
        unpack8(win[0], w0); unpack8(win[1], w1); unpack8(win[2], w2);
#pragma unroll
        for (int k = 0; k < 32; ++k) {
            f32x2 x3[4]; unpack8(rows[k], x3);
            f32x2 v2[4];
#pragma unroll
            for (int e = 0; e < 4; ++e) {
                f32x2 a = __builtin_elementwise_fma(wg2[0][e], w0[e], bias2[e]);
                a = __builtin_elementwise_fma(wg2[1][e], w1[e], a);
                a = __builtin_elementwise_fma(wg2[2][e], w2[e], a);
                a = __builtin_elementwise_fma(wg2[3][e], x3[e], a);
                v2[e] = silu2(a);
                w0[e] = w1[e]; w1[e] = w2[e]; w2[e] = x3[e];
            }
            u32x4 w; w.x = pk_bf16(v2[0][0], v2[0][1]); w.y = pk_bf16(v2[1][0], v2[1][1]); w.z = pk_bf16(v2[2][0], v2[2][1]); w.w = pk_bf16(v2[3][0], v2[3][1]);
            *(u32x4*)(proj + pidx(t0 + half * 32 + k, col)) = w;
        }
    }
}
__device__ void phaseB_ret(const P& p, int chunkg) {
    const int tid = opaque_tid();
    const int c = chunkg & 127;
    const size_t t0 = (size_t)chunkg * 64;
    bf16_t* proj = (bf16_t*)(p.ws + WS_PROJ);
    const int tok = tid >> 3, pg = tid & 7;
    const float pos = (float)(c * 64 + tok);
    float cs[8], sn[8];
#pragma unroll
    for (int e = 0; e < 8; ++e) {
        const float inv = exp2f(-(float)(pg * 8 + e) * (13.287712379549449f / 64.0f));
        const float ang = pos * inv;
        const float n = rintf(ang * 0.15915494309189535f);
        float rr = fmaf(-n, 6.28125f, ang); rr = fmaf(-n, 0.0019353071795864769f, rr);
        cs[e] = __cosf(rr); sn[e] = __sinf(rr);
    }
    u32x4 ra[4][2], rb[4][2];
#pragma unroll
    for (int hh = 0; hh < 4; ++hh)
#pragma unroll
        for (int s = 0; s < 2; ++s) {
            const bf16_t* base = proj + pidx(t0 + tok, (s == 0 ? C_RQ : C_RK) + hh * 128 + pg * 8);
            ra[hh][s] = *(const u32x4*)base; rb[hh][s] = *(const u32x4*)(base + 64);
        }
#pragma unroll
    for (int hh = 0; hh < 4; ++hh)
#pragma unroll
        for (int s = 0; s < 2; ++s) {
            bf16_t* base = proj + pidx(t0 + tok, (s == 0 ? C_RQ : C_RK) + hh * 128 + pg * 8);
            const float sc = s == 0 ? 1.0f : 0.08838834764831845f;
            const u32x4 a = ra[hh][s], b = rb[hh][s];
            const float t1[8] = {bf_lo(a.x), bf_hi(a.x), bf_lo(a.y), bf_hi(a.y), bf_lo(a.z), bf_hi(a.z), bf_lo(a.w), bf_hi(a.w)};
            const float t2[8] = {bf_lo(b.x), bf_hi(b.x), bf_lo(b.y), bf_hi(b.y), bf_lo(b.z), bf_hi(b.z), bf_lo(b.w), bf_hi(b.w)};
            float o1[8], o2[8];
#pragma unroll
            for (int e = 0; e < 8; ++e) { o1[e] = (t1[e] * cs[e] - t2[e] * sn[e]) * sc; o2[e] = (t1[e] * sn[e] + t2[e] * cs[e]) * sc; }
            u32x4 w1, w2;
            w1.x = pk_bf16(o1[0], o1[1]); w1.y = pk_bf16(o1[2], o1[3]); w1.z = pk_bf16(o1[4], o1[5]); w1.w = pk_bf16(o1[6], o1[7]);
            w2.x = pk_bf16(o2[0], o2[1]); w2.y = pk_bf16(o2[2], o2[3]); w2.z = pk_bf16(o2[4], o2[5]); w2.w = pk_bf16(o2[6], o2[7]);
            { *(u32x4*)base = w1; *(u32x4*)(base + 64) = w2; }
        }
}

constexpr int L_QS = 0, L_KS = 17408, L_WS = 34816, L_ST = 52224, L_VT = 69632, L_VST = 78848, L_AT = 88064, L_UT = 97280, L_CUM = 106496, L_DT = 106752;
constexpr int L_ALT = 107008;
constexpr int D_KS = L_ALT - L_KS, D_ST = L_ALT + 17408 - L_ST, D_VT = L_ALT + 34816 - L_VT, D_VST = L_ALT + 44032 - L_VST, D_CUM = L_ALT + 53248 - L_CUM;
typedef short s16x4 __attribute__((ext_vector_type(4)));
DI bf16x8 ldfrag_tr(const LAS bf16_t* X, int ld, int k0, int m0, int r, int q) {
    const LAS bf16_t* a = X + (k0 + q * 8 + (r >> 2)) * ld + m0 + 4 * (r & 3);
    const s16x4 lo = __builtin_amdgcn_ds_read_tr16_b64_v4i16((LAS s16x4*)a);
    const s16x4 hi = __builtin_amdgcn_ds_read_tr16_b64_v4i16((LAS s16x4*)(a + 4 * ld));
    return __builtin_shufflevector(lo, hi, 0, 1, 2, 3, 4, 5, 6, 7);
}
template <int KIND>
__device__ void phaseC_item(LAS unsigned char* lds, const P& p, int layer, int sub) {
    const int tid = opaque_tid(), lane = tid & 63, wid = __builtin_amdgcn_readfirstlane(tid >> 6), r = lane & 15, q = lane >> 4;
    bf16_t* proj = (bf16_t*)(p.ws + WS_PROJ);
    int b, qcol, kcol, vcol, hidx; float Dval = 0.f, lg = 0.f;
    if (KIND == 0) { b = sub >> 3; const int h = (sub >> 1) & 3, e = sub & 1; hidx = h; qcol = C_GQ + h * 128; kcol = C_GK + h * 128; vcol = C_GV + h * 128 + e * 64; }
    else if (KIND == 1) { b = sub >> 4; const int hd = sub & 15, grp = hd >> 3; hidx = hd; qcol = C_SC + grp * 128; kcol = C_SB + grp * 128; vcol = C_SX + hd * 64; Dval = p.ssd_D[layer * 16 + hd]; }
    else { b = sub >> 3; const int h = (sub >> 1) & 3, e = sub & 1; hidx = h; qcol = C_RQ + h * 128; kcol = C_RK + h * 128; vcol = C_RV + h * 128 + e * 64; lg = logf(1.0f - exp2f(-5.0f - (float)h)); }
    LAS bf16_t* Qs = (LAS bf16_t*)(lds + L_QS); LAS bf16_t* Ws = (LAS bf16_t*)(lds + L_WS);
    LAS bf16_t* AT = (LAS bf16_t*)(lds + L_AT); LAS bf16_t* UT = (LAS bf16_t*)(lds + L_UT);
    const bf16_t* Wbuf = (const bf16_t*)(p.ws + WS_WBUF);
    const float* gate = KIND == 0 ? (const float*)(p.ws + WS_GCUM) : (const float*)(p.ws + WS_ACUM);
    const float* gdt = (const float*)(p.ws + WS_DT);
    const int gstride = KIND == 0 ? 4 : 16;
    for (int i = tid; i < 17408 / 16; i += 512) *(LAS u32x4*)(lds + L_ST + i * 16) = (u32x4){0u, 0u, 0u, 0u};
    f32x4 Sacc[4];
#pragma unroll
    for (int n = 0; n < 4; ++n) Sacc[n] = (f32x4){0.f, 0.f, 0.f, 0.f};
    u32x4 pq[2], pk[2], pw[2], pv; float pcum = 0.f, pcl = 0.f, pdt = 1.f, pcum2 = 0.f, pdt2 = 1.f;
    const int mt = wid >> 1, nt0 = (wid & 1) * 2;
    u32x4 pat = (u32x4){0u, 0u, 0u, 0u};
    u32x2 pz0 = (u32x2){0u, 0u}, pz1 = pz0, cz0 = pz0, cz1 = pz0;
    const int zcol = C_SZ + (vcol - C_SX);
    const int mytok = tid & 63, vtok = tid >> 3, vseg = tid & 7;
#define PREFETCH(cc) do { const size_t t0_ = ((size_t)b * NCHUNK + (cc)) * 64; \
        _Pragma("unroll") for (int it = 0; it < 2; ++it) { const int pp = tid + 512 * it; \
            pq[it] = *(const u32x4*)(proj + pidx(t0_ + (pp >> 4), qcol + (pp & 15) * 8)); \
            pk[it] = *(const u32x4*)(proj + pidx(t0_ + (pp >> 4), kcol + (pp & 15) * 8)); \
            if (KIND == 0) pw[it] = *(const u32x4*)(Wbuf + (t0_ + (pp >> 4)) * 512 + hidx * 128 + (pp & 15) * 8); } \
        pv = *(const u32x4*)(proj + pidx(t0_ + vtok, vcol + vseg * 8)); \
        if (KIND != 2) { pcum = gate[(t0_ + mytok) * gstride + hidx]; pcl = gate[(t0_ + 63) * gstride + hidx]; } \
        else { pcum = (float)(mytok + 1) * lg; pcl = 64.0f * lg; } \
        if (KIND == 1) { pdt = gdt[(t0_ + mytok) * 16 + hidx]; pdt2 = gdt[(t0_ + vtok) * 16 + hidx]; pcum2 = gate[(t0_ + vtok) * gstride + hidx]; } \
        if (KIND == 2) pcum2 = (float)(vtok + 1) * lg; \
        if (KIND == 0) pat = *(const u32x4*)((const bf16_t*)(p.ws + WS_ATG) + ((((size_t)b * NCHUNK + (cc)) * 4 + hidx) * 4096) + tid * 8); \
        if (KIND == 1) { pz0 = *(const u32x2*)(proj + pidx(t0_ + nt0 * 16 + r, zcol + mt * 16 + q * 4)); pz1 = *(const u32x2*)(proj + pidx(t0_ + (nt0 + 1) * 16 + r, zcol + mt * 16 + q * 4)); } } while (0)
    PREFETCH(0);
    u32x2 ow0 = (u32x2){0u, 0u}, ow1 = ow0;
    for (int c = 0; c < NCHUNK; ++c) {
        const size_t t0 = ((size_t)b * NCHUNK + c) * 64;
        const int par = c & 1;
        LAS bf16_t* Ks = (LAS bf16_t*)(lds + L_KS + par * D_KS); LAS bf16_t* ST = (LAS bf16_t*)(lds + L_ST + par * D_ST); LAS bf16_t* STn = (LAS bf16_t*)(lds + L_ST + (par ^ 1) * D_ST);
        LAS bf16_t* VT = (LAS bf16_t*)(lds + L_VT + par * D_VT);
        LAS bf16_t* VST = (LAS bf16_t*)(lds + L_VST + par * D_VST);
        LAS float* cumS = (LAS float*)(lds + L_CUM + par * D_CUM); LAS float* dtS = cumS + 64;
#pragma unroll
        for (int it = 0; it < 2; ++it) {
            const int pp = tid + 512 * it;
            *(LAS u32x4*)(Qs + (pp >> 4) * 136 + (pp & 15) * 8) = pq[it];
            *(LAS u32x4*)(Ks + (pp >> 4) * 136 + (pp & 15) * 8) = pk[it];
            if (KIND == 0) *(LAS u32x4*)(Ws + (pp >> 4) * 136 + (pp & 15) * 8) = pw[it];
        }
        if (KIND == 0) {
            *(LAS u32x4*)(UT + vtok * 72 + vseg * 8) = pv;
        } else {
            const float sa = KIND == 1 ? pdt2 : 1.0f, sb = sa * __expf(pcl - pcum2);
            const float v0 = bf_lo(pv.x), v1 = bf_hi(pv.x), v2 = bf_lo(pv.y), v3 = bf_hi(pv.y), v4 = bf_lo(pv.z), v5 = bf_hi(pv.z), v6 = bf_lo(pv.w), v7 = bf_hi(pv.w);
            u32x4 wa = pv;
            if (KIND == 1) { wa.x = pk_bf16(v0 * sa, v1 * sa); wa.y = pk_bf16(v2 * sa, v3 * sa); wa.z = pk_bf16(v4 * sa, v5 * sa); wa.w = pk_bf16(v6 * sa, v7 * sa); }
            u32x4 wb; wb.x = pk_bf16(v0 * sb, v1 * sb); wb.y = pk_bf16(v2 * sb, v3 * sb); wb.z = pk_bf16(v4 * sb, v5 * sb); wb.w = pk_bf16(v6 * sb, v7 * sb);
            *(LAS u32x4*)(VT + vtok * 72 + vseg * 8) = wa;
            *(LAS u32x4*)(VST + vtok * 72 + vseg * 8) = wb;
        }
        if (tid < 64) { cumS[tid] = pcum; if (KIND == 1) dtS[tid] = pdt; }
        if (KIND == 1) { cz0 = pz0; cz1 = pz1; }
        if (c > 0) {
            *(u32x2*)(proj + pidx(t0 - 64 + nt0 * 16 + r, vcol + mt * 16 + q * 4)) = ow0;
            *(u32x2*)(proj + pidx(t0 - 64 + (nt0 + 1) * 16 + r, vcol + mt * 16 + q * 4)) = ow1;
        }
        __syncthreads();
        if (KIND == 0) *(LAS u32x4*)(AT + (tid >> 3) * 72 + (tid & 7) * 8) = pat;
        if (c + 1 < NCHUNK) PREFETCH(c + 1);
        const float cl = cumS[63];
        bf16x8 gb[2][4];
        {
            bf16x8 fa[4], fb[2][4], ga[4];
            if (KIND == 0) { ldfrag<4>(fa, Ws + mt * 16 * 136, 136, r, q); ldfrag<4>(fb[0], ST + nt0 * 16 * 136, 136, r, q); ldfrag<4>(fb[1], ST + (nt0 + 1) * 16 * 136, 136, r, q); }
            if (KIND != 0) ldfrag<4>(ga, Ks + mt * 16 * 136, 136, r, q);
            ldfrag<4>(gb[0], Qs + nt0 * 16 * 136, 136, r, q); ldfrag<4>(gb[1], Qs + (nt0 + 1) * 16 * 136, 136, r, q);
            const f32x4 cj = *(const LAS f32x4*)(cumS + mt * 16 + q * 4);
            u32x2 uu[2]; float ci[2], dti[2];
#pragma unroll
            for (int tt = 0; tt < 2; ++tt) {
                if (KIND == 0) uu[tt] = *(const LAS u32x2*)(UT + ((nt0 + tt) * 16 + r) * 72 + mt * 16 + q * 4);
                ci[tt] = cumS[(nt0 + tt) * 16 + r];
                if (KIND == 1) dti[tt] = dtS[(nt0 + tt) * 16 + r];
            }
            __builtin_amdgcn_sched_barrier(0);
            if (KIND == 0) {
                f32x4 a0 = (f32x4){0.f, 0.f, 0.f, 0.f}, a1 = a0;
                a0 = mmafrag<4>(a0, fa, fb[0]); a1 = mmafrag<4>(a1, fa, fb[1]);
                const float e0 = __expf(cl - cj[0]), e1 = __expf(cl - cj[1]), e2 = __expf(cl - cj[2]), e3 = __expf(cl - cj[3]);
#pragma unroll
                for (int tt = 0; tt < 2; ++tt) {
                    const f32x4 acc = tt ? a1 : a0;
                    const float v0 = bf_lo(uu[tt].x) - acc[0], v1 = bf_hi(uu[tt].x) - acc[1], v2 = bf_lo(uu[tt].y) - acc[2], v3 = bf_hi(uu[tt].y) - acc[3];
                    u32x2 w; w.x = pk_bf16(v0, v1); w.y = pk_bf16(v2, v3);
                    *(LAS u32x2*)(VT + ((nt0 + tt) * 16 + r) * 72 + mt * 16 + q * 4) = w;
                    u32x2 ws; ws.x = pk_bf16(v0 * e0, v1 * e1); ws.y = pk_bf16(v2 * e2, v3 * e3);
                    *(LAS u32x2*)(VST + ((nt0 + tt) * 16 + r) * 72 + mt * 16 + q * 4) = ws;
                }
            }
            if (KIND != 0) {
                f32x4 a0 = (f32x4){0.f, 0.f, 0.f, 0.f}, a1 = a0;
                a0 = mmafrag<4>(a0, ga, gb[0]); a1 = mmafrag<4>(a1, ga, gb[1]);
#pragma unroll
                for (int tt = 0; tt < 2; ++tt) {
                    const f32x4 acc = tt ? a1 : a0;
                    const int i = (nt0 + tt) * 16 + r;
                    float f[4];
#pragma unroll
                    for (int jj = 0; jj < 4; ++jj) {
                        const int j = mt * 16 + q * 4 + jj;
                        float v = (j <= i) ? acc[jj] * __expf(ci[tt] - cj[jj]) : 0.f;
                        if (KIND == 1 && j == i) v += Dval * __builtin_amdgcn_rcpf(dti[tt]);
                        f[jj] = v;
                    }
                    u32x2 w; w.x = pk_bf16(f[0], f[1]); w.y = pk_bf16(f[2], f[3]);
                    *(LAS u32x2*)(AT + i * 72 + mt * 16 + q * 4) = w;
                }
            }
        }
        __syncthreads();
        {
            bf16x8 sa[4], va[2], ab[2][2], ka[2], vb[4][2];
            ldfrag<4>(sa, ST + mt * 16 * 136, 136, r, q);
            ldfrag<2>(ab[0], AT + nt0 * 16 * 72, 72, r, q); ldfrag<2>(ab[1], AT + (nt0 + 1) * 16 * 72, 72, r, q);
            if (KIND == 0) {
                ldfrag<2>(va, VT + mt * 16 * 72, 72, r, q);
#pragma unroll
                for (int n = 0; n < 4; ++n) ldfrag<2>(vb[n], VST + n * 16 * 72, 72, r, q);
            } else {
#pragma unroll
                for (int ks = 0; ks < 2; ++ks) {
                    va[ks] = ldfrag_tr(VT, 72, ks * 32, mt * 16, r, q);
#pragma unroll
                    for (int n = 0; n < 4; ++n) vb[n][ks] = ldfrag_tr(VST, 72, ks * 32, n * 16, r, q);
                }
            }
#pragma unroll
            for (int ks = 0; ks < 2; ++ks) ka[ks] = ldfrag_tr(Ks, 136, ks * 32, wid * 16, r, q);
            const float ei0 = __expf(cumS[nt0 * 16 + r]), ei1 = __expf(cumS[(nt0 + 1) * 16 + r]);
            const float dl = __expf(cl);
            __builtin_amdgcn_sched_barrier(0);
            f32x4 o0 = (f32x4){0.f, 0.f, 0.f, 0.f}, o1 = o0;
            o0 = mmafrag<4>(o0, sa, gb[0]); o1 = mmafrag<4>(o1, sa, gb[1]);
            o0 *= ei0; o1 *= ei1;
            o0 = mmafrag<2>(o0, va, ab[0]); o1 = mmafrag<2>(o1, va, ab[1]);
#pragma unroll
            for (int n = 0; n < 4; ++n) { Sacc[n] *= dl; Sacc[n] = mmafrag<2>(Sacc[n], ka, vb[n]); }
            if (KIND == 1) {
                o0[0] *= siluf(bf_lo(cz0.x)); o0[1] *= siluf(bf_hi(cz0.x)); o0[2] *= siluf(bf_lo(cz0.y)); o0[3] *= siluf(bf_hi(cz0.y));
                o1[0] *= siluf(bf_lo(cz1.x)); o1[1] *= siluf(bf_hi(cz1.x)); o1[2] *= siluf(bf_lo(cz1.y)); o1[3] *= siluf(bf_hi(cz1.y));
            }
            ow0.x = pk_bf16(o0[0], o0[1]); ow0.y = pk_bf16(o0[2], o0[3]);
            ow1.x = pk_bf16(o1[0], o1[1]); ow1.y = pk_bf16(o1[2], o1[3]);
        }
#pragma unroll
        for (int n = 0; n < 4; ++n) {
            u32x2 w; w.x = pk_bf16(Sacc[n][0], Sacc[n][1]); w.y = pk_bf16(Sacc[n][2], Sacc[n][3]);
            *(LAS u32x2*)(STn + (n * 16 + r) * 136 + wid * 16 + q * 4) = w;
        }
    }
    {
        const size_t tl = ((size_t)b * NCHUNK + NCHUNK - 1) * 64;
        *(u32x2*)(proj + pidx(tl + nt0 * 16 + r, vcol + mt * 16 + q * 4)) = ow0;
        *(u32x2*)(proj + pidx(tl + (nt0 + 1) * 16 + r, vcol + mt * 16 + q * 4)) = ow1;
    }
    __syncthreads();
#undef PREFETCH
}

__device__ void phaseD(const P& p, int layer) {
    const int tid_ = opaque_tid(); const int lane = tid_ & 63, wv = tid_ >> 6;
    bf16_t* proj = (bf16_t*)(p.ws + WS_PROJ);
    const float* gw = p.gdn_norm + layer * 128; const float* rw = p.ret_norm + layer * 128; const float* sw = p.ssd_norm + layer * 1024;
    const int stride = gridDim.x * 8;
    u32x4 cur[8], nxt[8];
#define D_LOAD(dst, rr) do { const size_t rr_ = (size_t)(rr); \
        dst[0] = __builtin_nontemporal_load((const u32x4*)(proj + pidx(rr_, C_GV + lane * 8))); dst[1] = __builtin_nontemporal_load((const u32x4*)(proj + pidx(rr_, C_GZ + lane * 8))); \
        dst[2] = __builtin_nontemporal_load((const u32x4*)(proj + pidx(rr_, C_RV + lane * 8))); dst[3] = __builtin_nontemporal_load((const u32x4*)(proj + pidx(rr_, C_RG + lane * 8))); \
        dst[4] = __builtin_nontemporal_load((const u32x4*)(proj + pidx(rr_, C_SX + lane * 16))); dst[5] = (u32x4){0u, 0u, 0u, 0u}; \
        dst[6] = __builtin_nontemporal_load((const u32x4*)(proj + pidx(rr_, C_SX + lane * 16 + 8))); dst[7] = (u32x4){0u, 0u, 0u, 0u}; } while (0)
    int row = blockIdx.x * 8 + wv;
    if (row < T_TOK) D_LOAD(nxt, row);
    for (; row < T_TOK; row += stride) {
#pragma unroll
        for (int k = 0; k < 8; ++k) cur[k] = nxt[k];
        if (row + stride < T_TOK) D_LOAD(nxt, row + stride);
#pragma unroll
        for (int s = 0; s < 2; ++s) {
            const int zc = (s == 0 ? C_GZ : C_RG) + lane * 8;
            const float* nw = (s == 0 ? gw : rw) + (lane & 15) * 8;
            const u32x4 o = cur[2 * s], z = cur[2 * s + 1];
            float ov[8] = {bf_lo(o.x), bf_hi(o.x), bf_lo(o.y), bf_hi(o.y), bf_lo(o.z), bf_hi(o.z), bf_lo(o.w), bf_hi(o.w)};
            const float zv[8] = {bf_lo(z.x), bf_hi(z.x), bf_lo(z.y), bf_hi(z.y), bf_lo(z.z), bf_hi(z.z), bf_lo(z.w), bf_hi(z.w)};
            float ss = 0.f;
#pragma unroll
            for (int e = 0; e < 8; ++e) ss += ov[e] * ov[e];
            ss += __shfl_xor(ss, 1); ss += __shfl_xor(ss, 2); ss += __shfl_xor(ss, 4); ss += __shfl_xor(ss, 8);
            const float rs = rsqrtf(ss * (1.0f / 128.0f) + EPS);
#pragma unroll
            for (int e = 0; e < 8; ++e) ov[e] = ov[e] * rs * nw[e] * siluf(zv[e]);
            u32x4 w; w.x = pk_bf16(ov[0], ov[1]); w.y = pk_bf16(ov[2], ov[3]); w.z = pk_bf16(ov[4], ov[5]); w.w = pk_bf16(ov[6], ov[7]);
            *(u32x4*)(proj + pidx((size_t)row, zc)) = w;
        }
        {
            float yv[16];
#pragma unroll
            for (int k = 0; k < 2; ++k) {
                const u32x4 o = cur[4 + 2 * k], z = cur[5 + 2 * k];
                const float ov[8] = {bf_lo(o.x), bf_hi(o.x), bf_lo(o.y), bf_hi(o.y), bf_lo(o.z), bf_hi(o.z), bf_lo(o.w), bf_hi(o.w)};
                const float zv[8] = {bf_lo(z.x), bf_hi(z.x), bf_lo(z.y), bf_hi(z.y), bf_lo(z.z), bf_hi(z.z), bf_lo(z.w), bf_hi(z.w)};
#pragma unroll
                for (int e = 0; e < 8; ++e) yv[k * 8 + e] = ov[e];
            }
            float ss = 0.f;
#pragma unroll
            for (int e = 0; e < 16; ++e) ss += yv[e] * yv[e];
            ss += __shfl_xor(ss, 1); ss += __shfl_xor(ss, 2); ss += __shfl_xor(ss, 4); ss += __shfl_xor(ss, 8); ss += __shfl_xor(ss, 16);
            const float rs = rsqrtf(ss * (1.0f / 512.0f) + EPS);
#pragma unroll
            for (int k = 0; k < 2; ++k) {
                const float* nw = sw + lane * 16 + k * 8;
                u32x4 w; w.x = pk_bf16(yv[k * 8] * rs * nw[0], yv[k * 8 + 1] * rs * nw[1]); w.y = pk_bf16(yv[k * 8 + 2] * rs * nw[2], yv[k * 8 + 3] * rs * nw[3]);
                w.z = pk_bf16(yv[k * 8 + 4] * rs * nw[4], yv[k * 8 + 5] * rs * nw[5]); w.w = pk_bf16(yv[k * 8 + 6] * rs * nw[6], yv[k * 8 + 7] * rs * nw[7]);
                *(u32x4*)(proj + pidx((size_t)row, C_SZ + lane * 16 + k * 8)) = w;
            }
        }
    }
#undef D_LOAD
}

__global__ void __launch_bounds__(512, 2) hybrid_fwd(P p) {
    extern __shared__ __attribute__((aligned(16))) unsigned char lds_raw[];
    LAS unsigned char* lds = (LAS unsigned char*)lds_raw;
    cg::grid_group grid = cg::this_grid();
    const int G = gridDim.x, bx = blockIdx.x;
    bf16_t* proj = (bf16_t*)(p.ws + WS_PROJ);
    bf16_t* hbuf = (bf16_t*)(p.ws + WS_H);
    if (threadIdx.x == 0) *(LAS u32x4*)(lds + LDS_BAR_OFF) = (u32x4){0u, 0u, 0u, 0u};
    __syncthreads();
    XcdBarrier xb = xcd_barrier_post((unsigned*)(p.ws + WS_BAR), (volatile LAS unsigned*)(lds + LDS_BAR_OFF));
    int nsync = 0;
    for (int ph = p.ph_lo; ph < p.ph_hi; ++ph) {
        if (ph > p.ph_lo) { if (nsync == 0) grid.sync(); else xcd_barrier(xb); ++nsync; }
        const int layer = ph >= 7 ? 1 : 0, sub = ph == 0 ? 0 : (ph - 1) % 6 + 1;
        if (sub == 0) {
            phase_convert(p);
            phase_rows(p.x, nullptr, 0, nullptr, nullptr, p.pre_norm, hbuf);
        } else if (sub == 1) {
            pg8::Gemm g; g.A = hbuf; g.Bt = (const bf16_t*)(p.ws + WS_WIN) + (size_t)layer * NPW * DM; g.M = T_TOK; g.N = NPW; g.K = DM; g.lda = DM; g.atiled = 0;
            pg8::StaticOrder S; S.init(g.M, g.N, G, bx);
            EpiProj E; E.proj = proj; E.small = (float*)(p.ws + WS_SMALL); E.halo = (bf16_t*)(p.ws + WS_HALO);
            pg8::gemm_phase<EpiProj>(lds, g, S, E);
        } else if (sub == 2) {
            for (int it = bx; it < 1024 * 6; it += G) {
                const int chunkg = it & 1023, kind = it >> 10;
                if (kind < 4) phaseB_gdn(lds, p, layer, chunkg, kind);
                else if (kind == 4) phaseB_ssd(p, layer, chunkg);
                else phaseB_ret(p, chunkg);
            }
        } else if (sub == 3) {
            for (int it = bx; it < 256; it += G) {
                int kind, sub;
                if (G == 256) {
                    const int xcd = it & 7, s = it >> 3;
                    if (s < 8) { kind = 0; sub = (xcd + 8 * (s >> 1)) * 2 + (s & 1); }
                    else if (s < 24) { const int s2 = s - 8, g = xcd + 8 * (s2 >> 3); kind = 1; sub = (g >> 1) * 16 + (g & 1) * 8 + (s2 & 7); }
                    else { const int s2 = s - 24; kind = 2; sub = (xcd + 8 * (s2 >> 1)) * 2 + (s2 & 1); }
                } else { kind = it < 64 ? 0 : (it < 192 ? 1 : 2); sub = it < 64 ? it : (it < 192 ? it - 64 : it - 192); }
                if (kind == 0) phaseC_item<0>(lds, p, layer, sub);
                else if (kind == 1) phaseC_item<1>(lds, p, layer, sub);
                else phaseC_item<2>(lds, p, layer, sub);
            }
        } else if (sub == 4) {
            phaseD(p, layer);
        } else if (sub == 5) {
            pg8::Gemm g; g.A = proj; g.Bt = (const bf16_t*)(p.ws + WS_WOUT) + (size_t)layer * 1024 * 2048; g.M = T_TOK; g.N = 1024; g.K = 2048; g.lda = 256; g.atiled = 1;
            pg8::StaticOrder S; S.init(g.M, g.N, G, bx);
            EpiOut E; E.O = proj;
            pg8::gemm_phase<EpiOut>(lds, g, S, E);
        } else {
            phase_rows(layer == 0 ? p.x : p.out, proj, NP, p.post_norm + layer * DM, p.out,
                       layer == 0 ? p.pre_norm + DM : nullptr, hbuf);
        }
    }
}

extern "C" void kernel_launch(void* const* d_in, const int* in_sizes, int n_in, void* d_out, int out_size, void* d_ws, size_t ws_size, hipStream_t stream) {
    static int grid_blocks = 0;
    if (grid_blocks == 0) {
        if (n_in != 16 || in_sizes[0] != T_TOK * DM || out_size != T_TOK * DM || ws_size < WS_TOTAL) {
            fprintf(stderr, "kernel_launch: unexpected shapes / workspace (%d inputs, in0 %d, out %d, ws %zu, need %zu)\n", n_in, n_in > 0 ? in_sizes[0] : -1, out_size, ws_size, (size_t)WS_TOTAL);
            grid_blocks = -1; return;
        }
        int dev = 0, cus = 0, per_cu = 0;
        hipGetDevice(&dev);
        hipDeviceGetAttribute(&cus, hipDeviceAttributeMultiprocessorCount, dev);
        if (hipFuncSetAttribute((const void*)hybrid_fwd, hipFuncAttributeMaxDynamicSharedMemorySize, LDS_BYTES) != hipSuccess) { fprintf(stderr, "hipFuncSetAttribute failed\n"); grid_blocks = -1; return; }
        hipOccupancyMaxActiveBlocksPerMultiprocessor(&per_cu, (const void*)hybrid_fwd, 512, LDS_BYTES);
        if (per_cu < 1) { fprintf(stderr, "occupancy query returned %d\n", per_cu); grid_blocks = -1; return; }
        grid_blocks = cus;
    }
    if (grid_blocks < 0) return;
    P p{};
    p.x = (const float*)d_in[0]; p.pre_norm = (const float*)d_in[1]; p.post_norm = (const float*)d_in[2]; p.w_in = (const float*)d_in[3];
    p.gdn_conv = (const float*)d_in[4]; p.gdn_A_log = (const float*)d_in[5]; p.gdn_dt_bias = (const float*)d_in[6]; p.gdn_norm = (const float*)d_in[7];
    p.ssd_conv = (const float*)d_in[8]; p.ssd_conv_b = (const float*)d_in[9]; p.ssd_A_log = (const float*)d_in[10]; p.ssd_dt_bias = (const float*)d_in[11];
    p.ssd_D = (const float*)d_in[12]; p.ssd_norm = (const float*)d_in[13]; p.ret_norm = (const float*)d_in[14]; p.w_out = (const float*)d_in[15];
    p.out = (float*)d_out; p.ws = (unsigned char*)d_ws;
    p.ph_lo = 0; p.ph_hi = 13;
    hipError_t me = hipMemsetAsync((unsigned char*)d_ws + WS_BAR, 0, XCD_BAR_WORDS * sizeof(unsigned), stream);
    if (me != hipSuccess) fprintf(stderr, "barrier memset failed: %s\n", hipGetErrorString(me));
    void* args[] = {&p};
    hipError_t e = hipLaunchCooperativeKernel((const void*)hybrid_fwd, dim3(grid_blocks), dim3(512), args, LDS_BYTES, stream);
    if (e != hipSuccess) fprintf(stderr, "cooperative launch failed: %s (grid %d)\n", hipGetErrorString(e), grid_blocks);
}
```

```cpp
#include <hip/hip_runtime.h>
#include <hip/hip_cooperative_groups.h>
#include <cstdio>
namespace cg = cooperative_groups;

#define LAS __attribute__((address_space(3)))
#define DI __device__ __forceinline__
typedef unsigned short bf16_t;
typedef short bf16x8 __attribute__((ext_vector_type(8)));
typedef float f32x4 __attribute__((ext_vector_type(4)));
typedef unsigned u32x4 __attribute__((ext_vector_type(4)));
typedef unsigned u32x2 __attribute__((ext_vector_type(2)));

constexpr int T_TOK = 65536, DM = 1024, NCHUNK = 128, NB = 8;
constexpr int NP = 6656;
constexpr int NPW = 6912;
constexpr int NIN = 6680;
constexpr int C_GZ = 0, C_SZ = 512, C_RG = 1536, C_GQ = 2048, C_GK = 2560, C_GV = 3072, C_SX = 3584, C_SB = 4608, C_SC = 4864,
              C_RQ = 5120, C_RK = 5632, C_RV = 6144;
constexpr float EPS = 1e-6f;
__device__ __forceinline__ size_t pidx(size_t row, int col) { return ((row >> 8) * 26 + (size_t)(col >> 8)) * 65536 + (row & 255) * 256 + (size_t)(col & 255); }
constexpr size_t WS_PROJ = 0;
constexpr size_t WS_H = (size_t)T_TOK * NP * 2;
constexpr size_t WS_WBUF = WS_H;
constexpr size_t WS_GCUM = WS_H + (size_t)T_TOK * 512 * 2;
constexpr size_t WS_DT = WS_GCUM + (size_t)T_TOK * 4 * 4;
constexpr size_t WS_ACUM = WS_DT + (size_t)T_TOK * 16 * 4;
constexpr size_t WS_WIN = WS_H + (size_t)T_TOK * DM * 2;
constexpr size_t WS_WOUT = WS_WIN + (size_t)2 * NPW * DM * 2;
constexpr size_t WS_SMALL = WS_WOUT + (size_t)2 * 1024 * 2048 * 2;
constexpr size_t WS_HALO = WS_SMALL + (size_t)T_TOK * 32 * 4;
constexpr size_t WS_END = WS_HALO + (size_t)1024 * 3 * 3072 * 2;
constexpr size_t WS_BAR = WS_END;
constexpr size_t WS_TOTAL = WS_END + 16384;
constexpr int LDS_BAR_OFF = 160768;
constexpr int LDS_BYTES = 160768 + 16;

struct P {
    const float* x; const float* pre_norm; const float* post_norm; const float* w_in; const float* gdn_conv; const float* gdn_A_log;
    const float* gdn_dt_bias; const float* gdn_norm; const float* ssd_conv; const float* ssd_conv_b; const float* ssd_A_log;
    const float* ssd_dt_bias; const float* ssd_D; const float* ssd_norm; const float* ret_norm; const float* w_out;
    float* out; unsigned char* ws; int ph_lo, ph_hi;
};

DI int opaque_tid() { int t = threadIdx.x; asm volatile("" : "+v"(t)); return t; }
typedef float f32x2 __attribute__((ext_vector_type(2)));
typedef __bf16 bf16x2_t __attribute__((ext_vector_type(2)));
DI unsigned pk_bf16(float lo, float hi) { const f32x2 v = {lo, hi}; const bf16x2_t b = __builtin_convertvector(v, bf16x2_t); return __builtin_bit_cast(unsigned, b); }
DI float bf_lo(unsigned w) { return __uint_as_float(w << 16); }
DI float bf_hi(unsigned w) { return __uint_as_float(w & 0xffff0000u); }
DI float siluf(float v) { return v * __builtin_amdgcn_rcpf(1.0f + __expf(-v)); }
DI void unpack8(const u32x4 w, f32x2 (&o)[4]) { o[0] = (f32x2){bf_lo(w.x), bf_hi(w.x)}; o[1] = (f32x2){bf_lo(w.y), bf_hi(w.y)}; o[2] = (f32x2){bf_lo(w.z), bf_hi(w.z)}; o[3] = (f32x2){bf_lo(w.w), bf_hi(w.w)}; }
DI f32x2 silu2(f32x2 v) { const f32x2 e = (f32x2){__expf(-v[0]), __expf(-v[1])}; const f32x2 d = e + 1.0f; const f32x2 rr = (f32x2){__builtin_amdgcn_rcpf(d[0]), __builtin_amdgcn_rcpf(d[1])}; return v * rr; }
DI float softplusf(float v) { return v > 20.f ? v : log1pf(__expf(v)); }
DI float wave_scan_incl(float v, int lane) {
#pragma unroll
    for (int o = 1; o < 64; o <<= 1) { float t = __shfl_up(v, o); if (lane >= o) v += t; }
    return v;
}

#define XB_TMO      128
#define XB_XCNT(j)  (256  + 64 * (j))
#define XB_XSUB(j)  (1280 + 64 * (j))
#define XB_XGEN(j)  (2304 + 64 * (j))
#define XB_TOP      3328
#define XB_TOPGEN   3392
#define XCD_BAR_WORDS 3456
#define XB_SPIN_CAP (1u << 18)

__device__ __forceinline__ unsigned xb_ld(unsigned* p)              { return __hip_atomic_load(p, __ATOMIC_RELAXED, __HIP_MEMORY_SCOPE_AGENT); }
__device__ __forceinline__ unsigned xb_add(unsigned* p, unsigned v) { return __hip_atomic_fetch_add(p, v, __ATOMIC_RELAXED, __HIP_MEMORY_SCOPE_AGENT); }
__device__ __forceinline__ unsigned xb_xcc_id() { return (unsigned)__builtin_amdgcn_s_getreg((3 << 11) | 20) & 0xFu; }
#define XB_SPIN(cond, bar) do { unsigned _sp = 0; while (cond) { __builtin_amdgcn_s_sleep(1); \
    if ((++_sp & 255u) == 0u) { if (xb_ld(&(bar)[XB_TMO])) break; if (_sp > XB_SPIN_CAP) { atomicAdd(&(bar)[XB_TMO], 1u); break; } } } } while (0)

struct XcdBarrier {
    unsigned* bar; unsigned x;
    volatile LAS unsigned* st;
};

__device__ __forceinline__ XcdBarrier xcd_barrier_post(unsigned* bar, volatile LAS unsigned* st) {
    XcdBarrier b; b.bar = bar; b.x = xb_xcc_id(); b.st = st;
    if (threadIdx.x == 0) (void)xb_add(&bar[XB_XCNT(b.x)], 1u);
    return b;
}
__device__ __forceinline__ void xcd_barrier_complete(unsigned* bar, unsigned x, unsigned& nloc, unsigned& nx) {
    const unsigned G = gridDim.x * gridDim.y * gridDim.z;
    unsigned sum, cnt, mine, sp = 0u;
    for (;;) {
        sum = 0u; cnt = 0u; mine = 0u;
#pragma unroll
        for (unsigned j = 0; j < 16; ++j) { const unsigned c = xb_ld(&bar[XB_XCNT(j)]); sum += c; cnt += (c > 0u) ? 1u : 0u; mine = (j == x) ? c : mine; }
        if (sum == G) break;
        __builtin_amdgcn_s_sleep(1);
        if ((++sp & 255u) == 0u) { if (xb_ld(&bar[XB_TMO])) break; if (sp > XB_SPIN_CAP) { atomicAdd(&bar[XB_TMO], 1u); break; } }
    }
    nloc = mine > 0u ? mine : 1u; nx = cnt > 0u ? cnt : 1u;
}

__device__ __forceinline__ void xcd_barrier(const XcdBarrier& b) {
    asm volatile("s_waitcnt vmcnt(0)" ::: "memory");
    __syncthreads();
    if (threadIdx.x == 0) {
        unsigned* bar = b.bar;
        __builtin_amdgcn_s_waitcnt(0);
        unsigned nloc = b.st[0], nx = b.st[1];
        if (nloc == 0u) { xcd_barrier_complete(bar, b.x, nloc, nx); b.st[0] = nloc; b.st[1] = nx; }
        const unsigned old = xb_add(&bar[XB_XSUB(b.x)], 1u);
        const unsigned gen = old / nloc;
        if (old + 1u == (gen + 1u) * nloc) {
            __builtin_amdgcn_fence(__ATOMIC_RELEASE, "agent");
            asm volatile("s_waitcnt vmcnt(0)" ::: "memory");
            const unsigned og = xb_add(&bar[XB_TOP], 1u);
            const unsigned tg = og / nx;
            if (og + 1u == (tg + 1u) * nx) xb_add(&bar[XB_TOPGEN], 1u);
            else XB_SPIN(xb_ld(&bar[XB_TOPGEN]) == tg, bar);
            __builtin_amdgcn_fence(__ATOMIC_ACQUIRE, "agent");
            xb_add(&bar[XB_XGEN(b.x)], 1u);
            asm volatile("s_waitcnt vmcnt(0)" ::: "memory");
        } else {
            XB_SPIN(xb_ld(&bar[XB_XGEN(b.x)]) == gen, bar);
            __builtin_amdgcn_fence(__ATOMIC_ACQUIRE, "agent");
            asm volatile("s_waitcnt vmcnt(0)" ::: "memory");
        }
    }
    __syncthreads();
}


namespace pg8 {
constexpr int BM = 256, BK = 64, HALF = 128, HTB = HALF * BK * 2, NXCD = 8, WGM = 8;
DI int lds_byte(int r, int c) { const int st = (r >> 4) * 2 + (c >> 5), rr = r & 15, cc = c & 31, ob = rr * 64 + cc * 2; return st * 1024 + (ob ^ (((ob >> 9) & 1) << 5)); }
DI void stage_rc(int b, int& R, int& C) { const int st = b / 1024, sb = b % 1024, swz = sb ^ (((sb >> 9) & 1) << 5); R = (st >> 1) * 16 + swz / 64; C = (st & 1) * 32 + (swz % 64) / 2; }
DI int perm32(int rho) { const int n = rho >> 4, i = rho & 15; return 8 * (i >> 2) + 4 * n + (i & 3); }
struct Unit { int pm, pn; };
struct Gemm { const bf16_t* A; const bf16_t* Bt; int M, N, K, lda, atiled; };
struct StaticOrder {
    int nM, nN, nwg, G, c;
    DI void init(int M, int N, int G_, int c_) { nM = M / BM; nN = N / BM; nwg = nM * nN; G = G_; c = c_; }
    DI bool next(int i, Unit& u) const {
        const long L = (long)i * G + c; if (L >= nwg) return false;
        int wgid = (int)L; { const int q = nwg / NXCD, r = nwg % NXCD, xcd = wgid % NXCD, off = wgid / NXCD; wgid = (xcd < r ? xcd * (q + 1) : r * (q + 1) + (xcd - r) * q) + off; }
        const int nig = WGM * nN, gid = wgid / nig, fm = gid * WGM, gsz = (nM - fm) < WGM ? (nM - fm) : WGM;
        u.pm = fm + ((wgid % nig) % gsz); u.pn = (wgid % nig) / gsz; return true;
    }
};

template <class Epi>
DI void gemm_phase(LAS unsigned char* lds, const Gemm g, const StaticOrder& S, const Epi& E) {
    const int tid = opaque_tid(), wid = __builtin_amdgcn_readfirstlane(tid >> 6), lane = tid & 63, wr = wid >> 2, wc = wid & 3, fr = lane & 15, fq = lane >> 4;
    const int K = g.K, nt = K / BK, lda = g.lda;
    unsigned voffA[2], voffB[2];
#pragma unroll
    for (int i = 0; i < 2; ++i) { int R, C; stage_rc(tid * 16 + i * 8192, R, C); const int Rb = Epi::PERM ? ((R & ~31) + perm32(R & 31)) : R;
        voffA[i] = (unsigned)(R * lda + C) * 2u; voffB[i] = (unsigned)(Rb * K + C) * 2u; }
    const size_t kstep = (size_t)(BK * 2);
    const size_t hA = (size_t)HALF * lda * 2, hB = (size_t)HALF * K * 2;
    const size_t tA = g.atiled ? (size_t)26 * 131072 : 2 * hA, tB = 2 * hB;
    const int atiled = g.atiled;
#define PG8_AKOFF(t) (atiled ? ((size_t)((t) >> 2) * 131072 + (size_t)((t) & 3) * 128) : (size_t)(t) * kstep)
    const unsigned ldsw = (unsigned)wid * 1024u;
    const int aoff = lds_byte(wr * 64 + fr, fq * 8), boff = lds_byte(wc * 32 + fr, fq * 8);
#define PG8_SA(b, h) (((b) * 2 + (h)) * HTB)
#define PG8_SB(b, h) ((4 + (b) * 2 + (h)) * HTB)
#define PG8_STAGE(bufoff, gbase, voff) do { _Pragma("unroll") for (int _i = 0; _i < 2; ++_i) \
        __builtin_amdgcn_global_load_lds((const unsigned*)((const char*)(gbase) + (voff)[_i]), (LAS unsigned*)(lds + (bufoff) + ldsw + _i * 8192), 16, 0, 0); } while (0)
#define PG8_LDA(dst, b, h) do { _Pragma("unroll") for (int m = 0; m < 4; ++m) _Pragma("unroll") for (int k = 0; k < 2; ++k) dst[m][k] = *(const LAS bf16x8*)(lds + PG8_SA(b, h) + aoff + m * 2048 + k * 1024); } while (0)
#define PG8_LDB(dst, b, h) do { _Pragma("unroll") for (int n = 0; n < 2; ++n) _Pragma("unroll") for (int k = 0; k < 2; ++k) dst[n][k] = *(const LAS bf16x8*)(lds + PG8_SB(b, h) + boff + n * 2048 + k * 1024); } while (0)
#define PG8_MMA(ai, bj, At, Bt) do { __builtin_amdgcn_s_setprio(1); _Pragma("unroll") for (int m = 0; m < 4; ++m) _Pragma("unroll") for (int n = 0; n < 2; ++n) _Pragma("unroll") for (int k = 0; k < 2; ++k) \
        acc[ai][bj][m][n] = __builtin_amdgcn_mfma_f32_16x16x32_bf16(Bt[n][k], At[m][k], acc[ai][bj][m][n], 0, 0, 0); __builtin_amdgcn_s_setprio(0); } while (0)
#define PG8_WAIT_V(n) asm volatile("s_waitcnt vmcnt(" #n ")" ::: "memory")
#define PG8_WAIT_L(n) asm volatile("s_waitcnt lgkmcnt(" #n ")" ::: "memory")
#define PG8_BAR __builtin_amdgcn_s_barrier()
#define PG8_SCHED __builtin_amdgcn_sched_barrier(0)
    Unit cur, nxt; int ui = 0;
    if (!S.next(0, cur)) return;
    f32x4 acc[2][2][4][2];
#pragma unroll
    for (int a = 0; a < 2; ++a)
#pragma unroll
        for (int b = 0; b < 2; ++b)
#pragma unroll
            for (int m = 0; m < 4; ++m)
#pragma unroll
                for (int n = 0; n < 2; ++n) acc[a][b][m][n] = (f32x4){0.f, 0.f, 0.f, 0.f};
    bf16x8 At[4][2], B0[2][2], B1[2][2];
    const char* cA = (const char*)g.A + (size_t)cur.pm * tA; const char* cB = (const char*)g.Bt + (size_t)cur.pn * tB;
    PG8_STAGE(PG8_SB(0, 0), cB, voffB); PG8_STAGE(PG8_SB(0, 1), cB + hB, voffB); PG8_STAGE(PG8_SA(0, 0), cA, voffA); PG8_STAGE(PG8_SA(0, 1), cA + hA, voffA);
    if (wr == 1) PG8_BAR;
    PG8_WAIT_V(2); PG8_BAR;
    PG8_STAGE(PG8_SB(1, 0), cB + kstep, voffB); PG8_STAGE(PG8_SA(1, 0), cA + kstep, voffA); PG8_STAGE(PG8_SB(1, 1), cB + hB + kstep, voffB);
    PG8_WAIT_V(6); PG8_BAR;
    for (;;) {
        const bool has_next = S.next(ui + 1, nxt);
        const char* nA = has_next ? (const char*)g.A + (size_t)nxt.pm * tA : cA; const char* nB = has_next ? (const char*)g.Bt + (size_t)nxt.pn * tB : cB;
        for (int t = 0; t < nt; t += 2) {
            const bool last = (t == nt - 2);
            const char* a1 = cA + PG8_AKOFF(t + 1);
            const char* a2 = last ? nA : cA + PG8_AKOFF(t + 2); const char* b2 = last ? nB : cB + (size_t)(t + 2) * kstep;
            const char* a3 = a2 + kstep; const char* b3 = b2 + kstep;
            PG8_LDB(B0, 0, 0); PG8_LDB(B1, 0, 1); PG8_SCHED; PG8_LDA(At, 0, 0); PG8_STAGE(PG8_SA(1, 1), a1 + hA, voffA);
            PG8_WAIT_V(8); PG8_WAIT_L(0); PG8_BAR; PG8_MMA(0, 0, At, B0); PG8_MMA(0, 1, At, B1); PG8_BAR; PG8_SCHED;
            PG8_LDA(At, 0, 1); PG8_STAGE(PG8_SB(0, 0), b2, voffB); PG8_STAGE(PG8_SB(0, 1), b2 + hB, voffB); PG8_STAGE(PG8_SA(0, 0), a2, voffA);
            PG8_WAIT_V(8); PG8_WAIT_L(0); PG8_BAR; PG8_MMA(1, 0, At, B0); PG8_MMA(1, 1, At, B1); PG8_BAR; PG8_SCHED;
            PG8_LDB(B0, 1, 0); PG8_LDB(B1, 1, 1); PG8_SCHED; PG8_LDA(At, 1, 0); PG8_STAGE(PG8_SA(0, 1), a2 + hA, voffA);
            PG8_WAIT_V(8); PG8_WAIT_L(0); PG8_BAR; PG8_MMA(0, 0, At, B0); PG8_MMA(0, 1, At, B1); PG8_BAR; PG8_SCHED;
            PG8_LDA(At, 1, 1); PG8_STAGE(PG8_SB(1, 0), b3, voffB); PG8_STAGE(PG8_SB(1, 1), b3 + hB, voffB); PG8_STAGE(PG8_SA(1, 0), a3, voffA);
            PG8_WAIT_V(8); PG8_WAIT_L(0); PG8_BAR; PG8_MMA(1, 0, At, B0); PG8_MMA(1, 1, At, B1); PG8_BAR; PG8_SCHED;
        }
        if (wr == 0) PG8_BAR;
        E(acc, cur, wr, wc, fr, fq);
        if (!has_next) break;
#pragma unroll
        for (int a = 0; a < 2; ++a)
#pragma unroll
            for (int b = 0; b < 2; ++b)
#pragma unroll
                for (int m = 0; m < 4; ++m)
#pragma unroll
                    for (int n = 0; n < 2; ++n) acc[a][b][m][n] = (f32x4){0.f, 0.f, 0.f, 0.f};
        cur = nxt; cA = nA; cB = nB; ++ui;
        if (wr == 1) PG8_BAR;
    }
    PG8_WAIT_V(0);
    PG8_BAR;
#undef PG8_SA
#undef PG8_AKOFF
#undef PG8_SB
#undef PG8_STAGE
#undef PG8_LDA
#undef PG8_LDB
#undef PG8_MMA
#undef PG8_WAIT_V
#undef PG8_WAIT_L
#undef PG8_BAR
#undef PG8_SCHED
}
}

struct EpiProj {
    static constexpr bool PERM = true;
    bf16_t* proj; float* small; bf16_t* halo;
    DI void operator()(const f32x4 (&acc)[2][2][4][2], const pg8::Unit& u, int wr, int wc, int fr, int fq) const {
        const int row0 = u.pm * 256 + wr * 64 + fr;
        if (u.pn < 26) {
            const int col0 = u.pn * 256 + wc * 32 + 8 * fq;
            const bool conv = (u.pn >= 8 && u.pn < 20);
#pragma unroll
            for (int ai = 0; ai < 2; ++ai)
#pragma unroll
                for (int m = 0; m < 4; ++m) {
                    const int row = row0 + ai * 128 + m * 16;
                    bf16_t* rowp = proj + pidx((size_t)row, col0);
#pragma unroll
                    for (int bj = 0; bj < 2; ++bj) {
                        const f32x4 v0 = acc[ai][bj][m][0], v1 = acc[ai][bj][m][1];
                        u32x4 w; w.x = pk_bf16(v0[0], v0[1]); w.y = pk_bf16(v0[2], v0[3]); w.z = pk_bf16(v1[0], v1[1]); w.w = pk_bf16(v1[2], v1[3]);
                        *(u32x4*)(rowp + bj * 128) = w;
                        if (m == 3 && conv && fr >= 13)
                            *(u32x4*)(halo + ((size_t)(row >> 6) * 3 + (fr - 13)) * 3072 + (col0 + bj * 128 - 2048)) = w;
                    }
                }
        } else if (wc == 0) {
#pragma unroll
            for (int ai = 0; ai < 2; ++ai)
#pragma unroll
                for (int m = 0; m < 4; ++m) {
                    const int row = row0 + ai * 128 + m * 16;
                    float* pp = small + (size_t)row * 32 + 8 * fq;
                    *(f32x4*)pp = acc[ai][0][m][0]; *(f32x4*)(pp + 4) = acc[ai][0][m][1];
                }
        }
    }
};
struct EpiOut {
    static constexpr bool PERM = true;
    bf16_t* O;
    DI void operator()(const f32x4 (&acc)[2][2][4][2], const pg8::Unit& u, int wr, int wc, int fr, int fq) const {
        const int row0 = u.pm * 256 + wr * 64 + fr, col0 = u.pn * 256 + wc * 32 + 8 * fq;
#pragma unroll
        for (int ai = 0; ai < 2; ++ai)
#pragma unroll
            for (int m = 0; m < 4; ++m) {
                bf16_t* rowp = O + pidx((size_t)(row0 + ai * 128 + m * 16), 2048 + col0);
#pragma unroll
                for (int bj = 0; bj < 2; ++bj) {
                    const f32x4 v0 = acc[ai][bj][m][0], v1 = acc[ai][bj][m][1];
                    u32x4 w; w.x = pk_bf16(v0[0], v0[1]); w.y = pk_bf16(v0[2], v0[3]); w.z = pk_bf16(v1[0], v1[1]); w.w = pk_bf16(v1[2], v1[3]);
                    *(u32x4*)(rowp + bj * 128) = w;
                }
            }
    }
};

template <int KSTEPS>
DI f32x4 mma_tile(f32x4 acc, const LAS bf16_t* A, int lda, const LAS bf16_t* B, int ldb, int r, int q) {
#pragma unroll
    for (int k = 0; k < KSTEPS; ++k) {
        const bf16x8 a = *(const LAS bf16x8*)(A + r * lda + k * 32 + q * 8);
        const bf16x8 b = *(const LAS bf16x8*)(B + r * ldb + k * 32 + q * 8);
        acc = __builtin_amdgcn_mfma_f32_16x16x32_bf16(a, b, acc, 0, 0, 0);
    }
    return acc;
}

template <int KS> DI void ldfrag(bf16x8 (&f)[KS], const LAS bf16_t* base, int ld, int r, int q) {
#pragma unroll
    for (int k = 0; k < KS; ++k) f[k] = *(const LAS bf16x8*)(base + r * ld + k * 32 + q * 8);
}
template <int KS> DI f32x4 mmafrag(f32x4 acc, const bf16x8 (&a)[KS], const bf16x8 (&b)[KS]) {
#pragma unroll
    for (int k = 0; k < KS; ++k) acc = __builtin_amdgcn_mfma_f32_16x16x32_bf16(a[k], b[k], acc, 0, 0, 0);
    return acc;
}

DI int orig_col(int n) {
    if (n < 512) return 1536 + n;
    if (n < 1536) return 3592 + (n - 512);
    if (n < 2048) return 6168 + (n - 1536);
    if (n < 3584) return n - 2048;
    if (n < 5120) return 2056 + (n - 3584);
    if (n < 6656) return 4632 + (n - 5120);
    if (n < 6664) return 2048 + (n - 6656);
    if (n < 6680) return 4616 + (n - 6664);
    return -1;
}
__device__ void phase_convert(const P& p) {
    bf16_t* WinT = (bf16_t*)(p.ws + WS_WIN); bf16_t* WoutT = (bf16_t*)(p.ws + WS_WOUT);
    const size_t gsz = (size_t)gridDim.x * blockDim.x, g0 = (size_t)blockIdx.x * blockDim.x + opaque_tid();
    const size_t n1 = (size_t)2 * 128 * NPW;
    for (size_t i = g0; i < n1; i += gsz) {
        const int n = (int)(i % NPW); const int k8 = (int)((i / NPW) % 128); const int l = (int)(i / ((size_t)NPW * 128));
        const int oc = orig_col(n);
        float v[8];
#pragma unroll
        for (int e = 0; e < 8; ++e) v[e] = oc >= 0 ? p.w_in[((size_t)l * 1024 + k8 * 8 + e) * NIN + oc] : 0.f;
        u32x4 w; w.x = pk_bf16(v[0], v[1]); w.y = pk_bf16(v[2], v[3]); w.z = pk_bf16(v[4], v[5]); w.w = pk_bf16(v[6], v[7]);
        *(u32x4*)(WinT + ((size_t)l * NPW + n) * 1024 + k8 * 8) = w;
    }
    const size_t n2 = (size_t)2 * 256 * 1024;
    for (size_t i = g0; i < n2; i += gsz) {
        const int n = (int)(i % 1024); const int k8 = (int)((i / 1024) % 256); const int l = (int)(i / (1024 * 256));
        float v[8];
#pragma unroll
        for (int e = 0; e < 8; ++e) v[e] = p.w_out[((size_t)l * 2048 + k8 * 8 + e) * 1024 + n];
        u32x4 w; w.x = pk_bf16(v[0], v[1]); w.y = pk_bf16(v[2], v[3]); w.z = pk_bf16(v[4], v[5]); w.w = pk_bf16(v[6], v[7]);
        *(u32x4*)(WoutT + ((size_t)l * 1024 + n) * 2048 + k8 * 8) = w;
    }
}
__device__ void phase_rows(const float* xin, const bf16_t* o, int ldo, const float* post, float* xout, const float* pre, bf16_t* h) {
    const int tid_ = opaque_tid(); const int lane = tid_ & 63, wv = tid_ >> 6;
    const int stride = gridDim.x * 8;
    f32x4 xn[4]; u32x2 on[4];
#define R_LOAD(rr) do { _Pragma("unroll") for (int j = 0; j < 4; ++j) { xn[j] = __builtin_nontemporal_load((const f32x4*)(xin + (size_t)(rr) * DM + j * 256 + lane * 4)); \
        if (o) on[j] = __builtin_nontemporal_load((const u32x2*)(o + pidx((size_t)(rr), 2048 + j * 256 + lane * 4))); } } while (0)
    int row = blockIdx.x * 8 + wv;
#pragma unroll
    for (int j = 0; j < 4; ++j) on[j] = (u32x2){0u, 0u};
    if (row < T_TOK) R_LOAD(row);
    for (; row < T_TOK; row += stride) {
        f32x4 xv[4]; u32x2 ow[4];
#pragma unroll
        for (int j = 0; j < 4; ++j) { xv[j] = xn[j]; ow[j] = on[j]; }
        if (row + stride < T_TOK) R_LOAD(row + stride);
        if (o) {
            f32x4 ov[4]; float ss = 0.f;
#pragma unroll
            for (int j = 0; j < 4; ++j) { ov[j] = (f32x4){bf_lo(ow[j].x), bf_hi(ow[j].x), bf_lo(ow[j].y), bf_hi(ow[j].y)}; ss += ov[j][0] * ov[j][0] + ov[j][1] * ov[j][1] + ov[j][2] * ov[j][2] + ov[j][3] * ov[j][3]; }
#pragma unroll
            for (int s = 1; s < 64; s <<= 1) ss += __shfl_xor(ss, s);
            const float rs = rsqrtf(ss * (1.0f / DM) + EPS);
#pragma unroll
            for (int j = 0; j < 4; ++j) { const f32x4 pw = *(const f32x4*)(post + j * 256 + lane * 4); xv[j] += ov[j] * rs * pw;
                *(f32x4*)(xout + (size_t)row * DM + j * 256 + lane * 4) = xv[j]; }
        }
        if (pre) {
            float ss = 0.f;
#pragma unroll
            for (int j = 0; j < 4; ++j) ss += xv[j][0] * xv[j][0] + xv[j][1] * xv[j][1] + xv[j][2] * xv[j][2] + xv[j][3] * xv[j][3];
#pragma unroll
            for (int s = 1; s < 64; s <<= 1) ss += __shfl_xor(ss, s);
            const float rs = rsqrtf(ss * (1.0f / DM) + EPS);
#pragma unroll
            for (int j = 0; j < 4; ++j) { const f32x4 pw = *(const f32x4*)(pre + j * 256 + lane * 4); const f32x4 hv = xv[j] * rs * pw;
                u32x2 w; w.x = pk_bf16(hv[0], hv[1]); w.y = pk_bf16(hv[2], hv[3]); *(u32x2*)(h + (size_t)row * DM + j * 256 + lane * 4) = w; }
        }
    }
#undef R_LOAD
}

__device__ void phaseB_gdn(LAS unsigned char* lds, const P& p, int layer, int chunkg, int h) {
    const int tid = opaque_tid(), lane = tid & 63, wid = tid >> 6, r = lane & 15, q = lane >> 4;
    const int c = chunkg & 127;
    const size_t t0 = (size_t)chunkg * 64;
    bf16_t* proj = (bf16_t*)(p.ws + WS_PROJ); const bf16_t* halo = (const bf16_t*)(p.ws + WS_HALO);
    const float* small = (const float*)(p.ws + WS_SMALL);
    LAS bf16_t* kb = (LAS bf16_t*)lds;
    LAS float* rhs = (LAS float*)(lds + 17408);
    LAS float* Am = (LAS float*)(lds + 17408 + 65536);
    LAS float* gS = (LAS float*)(lds + 17408 + 65536 + 16384);
    const float* cw = p.gdn_conv + (size_t)layer * 4 * 1536;
    LAS float* cwS = (LAS float*)(lds + 17408 + 65536 + 16384 + 512);
    float braw = 0.f, araw = 0.f;
    if (wid == 0) { braw = small[(t0 + lane) * 32 + h]; araw = small[(t0 + lane) * 32 + 4 + h]; }
    float wl[3];
#pragma unroll
    for (int k = 0; k < 3; ++k) { const int rem = tid; wl[k] = cw[(rem >> 7) * 1536 + k * 512 + h * 128 + (rem & 127)]; }
    u32x4 xr[3][2][4];
#pragma unroll
    for (int s = 0; s < 3; ++s)
#pragma unroll
        for (int pass = 0; pass < 2; ++pass) {
            const int tok = pass * 32 + (tid >> 4), seg = tid & 15, col = C_GQ + s * 512 + h * 128 + seg * 8;
#pragma unroll
            for (int d = 0; d < 4; ++d) {
                const int tt = tok - 3 + d;
                u32x4 v = (u32x4){0u, 0u, 0u, 0u};
                if (tt >= 0) v = *(const u32x4*)(proj + pidx(t0 + tt, col));
                else if (c > 0) v = *(const u32x4*)(halo + ((size_t)(chunkg - 1) * 3 + (tt + 3)) * 3072 + (col - 2048));
                xr[s][pass][d] = v;
            }
        }
#pragma unroll
    for (int k = 0; k < 3; ++k) cwS[k * 512 + tid] = wl[k];
    if (wid == 0) {
        const float beta = 1.0f / (1.0f + __expf(-braw));
        const float g = -__expf(p.gdn_A_log[layer * 4 + h]) * softplusf(araw + p.gdn_dt_bias[layer * 4 + h]);
        const float gc = wave_scan_incl(g, lane);
        gS[lane] = gc; gS[64 + lane] = beta;
        ((float*)(p.ws + WS_GCUM))[(t0 + lane) * 4 + h] = gc;
    }
    __syncthreads();
    u32x4 qpk[2];
#pragma unroll
    for (int s = 0; s < 3; ++s) {
#pragma unroll
        for (int pass = 0; pass < 2; ++pass) {
            const int tok = pass * 32 + (tid >> 4), seg = tid & 15;
            f32x2 v2[4];
#pragma unroll
            for (int k = 0; k < 4; ++k) v2[k] = (f32x2){0.f, 0.f};
#pragma unroll
            for (int d = 0; d < 4; ++d) {
                f32x2 x2[4]; unpack8(xr[s][pass][d], x2);
                const f32x4 w0 = *(const LAS f32x4*)(cwS + s * 512 + d * 128 + seg * 8), w1 = *(const LAS f32x4*)(cwS + s * 512 + d * 128 + seg * 8 + 4);
                v2[0] = __builtin_elementwise_fma((f32x2){w0[0], w0[1]}, x2[0], v2[0]); v2[1] = __builtin_elementwise_fma((f32x2){w0[2], w0[3]}, x2[1], v2[1]);
                v2[2] = __builtin_elementwise_fma((f32x2){w1[0], w1[1]}, x2[2], v2[2]); v2[3] = __builtin_elementwise_fma((f32x2){w1[2], w1[3]}, x2[3], v2[3]);
            }
            f32x2 ss2 = (f32x2){0.f, 0.f};
#pragma unroll
            for (int k = 0; k < 4; ++k) { v2[k] = silu2(v2[k]); ss2 = __builtin_elementwise_fma(v2[k], v2[k], ss2); }
            float ss = ss2[0] + ss2[1];
            if (s < 2) {
                ss += __shfl_xor(ss, 1); ss += __shfl_xor(ss, 2); ss += __shfl_xor(ss, 4); ss += __shfl_xor(ss, 8);
                const float rn = rsqrtf(ss + EPS) * (s == 0 ? 0.08838834764831845f : 1.0f);
#pragma unroll
                for (int k = 0; k < 4; ++k) v2[k] *= rn;
            }
            const float val[8] = {v2[0][0], v2[0][1], v2[1][0], v2[1][1], v2[2][0], v2[2][1], v2[3][0], v2[3][1]};
            if (s == 0) {
                u32x4 w; w.x = pk_bf16(val[0], val[1]); w.y = pk_bf16(val[2], val[3]); w.z = pk_bf16(val[4], val[5]); w.w = pk_bf16(val[6], val[7]);
                qpk[pass] = w;
            } else if (s == 1) {
                u32x4 w; w.x = pk_bf16(val[0], val[1]); w.y = pk_bf16(val[2], val[3]); w.z = pk_bf16(val[4], val[5]); w.w = pk_bf16(val[6], val[7]);
                *(LAS u32x4*)(kb + tok * 136 + seg * 8) = w;
                const float f = gS[64 + tok] * __expf(gS[tok]);
                *(LAS f32x4*)(rhs + tok * 256 + 128 + seg * 8) = (f32x4){f * val[0], f * val[1], f * val[2], f * val[3]};
                *(LAS f32x4*)(rhs + tok * 256 + 128 + seg * 8 + 4) = (f32x4){f * val[4], f * val[5], f * val[6], f * val[7]};
            } else {
                const float f = gS[64 + tok];
                *(LAS f32x4*)(rhs + tok * 256 + seg * 8) = (f32x4){f * val[0], f * val[1], f * val[2], f * val[3]};
                *(LAS f32x4*)(rhs + tok * 256 + seg * 8 + 4) = (f32x4){f * val[4], f * val[5], f * val[6], f * val[7]};
            }
        }
    }
    __syncthreads();
#pragma unroll
    for (int pass = 0; pass < 2; ++pass) {
        const int item = pass * 512 + tid, tok = item >> 4, seg = item & 15;
        *(u32x4*)(proj + pidx(t0 + tok, C_GQ + h * 128 + seg * 8)) = qpk[pass];
    }
#pragma unroll
    for (int tt = 0; tt < 2; ++tt) {
        const int id = wid * 2 + tt, mt = id >> 2, nt = id & 3;
        f32x4 acc = (f32x4){0.f, 0.f, 0.f, 0.f};
        acc = mma_tile<4>(acc, kb + mt * 16 * 136, 136, kb + nt * 16 * 136, 136, r, q);
        const int j = nt * 16 + r; const float gj = gS[j];
        f32x4 av;
#pragma unroll
        for (int jj = 0; jj < 4; ++jj) {
            const int i = mt * 16 + q * 4 + jj;
            av[jj] = (j < i) ? -(gS[64 + i] * acc[jj] * __expf(gS[i] - gj)) : 0.f;
        }
        *(LAS f32x4*)(Am + j * 64 + mt * 16 + q * 4) = av;
    }
    __syncthreads();
    if (tid < 256) {
        float xs[64];
        int zoff; asm volatile("v_mov_b32 %0, 0" : "=v"(zoff));
        const LAS float* Az = Am + zoff;
        {
            f32x2 x2[32];
#pragma unroll
            for (int k = 0; k < 32; ++k) x2[k] = (f32x2){rhs[(2 * k) * 256 + tid], rhs[(2 * k + 1) * 256 + tid]};
            f32x4 an[16], ac[16];
#pragma unroll
            for (int k = 0; k < 16; ++k) an[k] = *(const LAS f32x4*)(Az + 4 * k);
#pragma unroll
            for (int j = 0; j < 63; ++j) {
#pragma unroll
                for (int k = 0; k < 16; ++k) ac[k] = an[k];
                if (j + 1 < 63) {
#pragma unroll
                    for (int k = (j + 2) / 4; k < 16; ++k) an[k] = *(const LAS f32x4*)(Az + (j + 1) * 64 + 4 * k);
                }
                __builtin_amdgcn_sched_barrier(0);
                const float xj = x2[j >> 1][j & 1];
                const f32x2 xj2 = (f32x2){xj, xj};
#pragma unroll
                for (int k = (j + 1) >> 1; k < 32; ++k) {
                    const f32x2 a2 = (k & 1) ? (f32x2){ac[k >> 1][2], ac[k >> 1][3]} : (f32x2){ac[k >> 1][0], ac[k >> 1][1]};
                    x2[k] = __builtin_elementwise_fma(a2, xj2, x2[k]);
                }
                __builtin_amdgcn_sched_barrier(0);
            }
#pragma unroll
            for (int k = 0; k < 32; ++k) { xs[2 * k] = x2[k][0]; xs[2 * k + 1] = x2[k][1]; }
        }
        if (tid < 128) {
            const int e = tid >> 6, dvl = tid & 63;
            bf16_t* dst = proj + pidx(t0 + dvl, C_GV + h * 128 + e * 64);
#pragma unroll
            for (int k = 0; k < 8; ++k) {
                u32x4 w; w.x = pk_bf16(xs[8 * k], xs[8 * k + 1]); w.y = pk_bf16(xs[8 * k + 2], xs[8 * k + 3]); w.z = pk_bf16(xs[8 * k + 4], xs[8 * k + 5]); w.w = pk_bf16(xs[8 * k + 6], xs[8 * k + 7]);
                *(u32x4*)(dst + 8 * k) = w;
            }
        } else {
            bf16_t* wb = (bf16_t*)(p.ws + WS_WBUF) + t0 * 512 + h * 128 + (tid - 128);
#pragma unroll
            for (int i = 0; i < 64; ++i) wb[(size_t)i * 512] = (bf16_t)(pk_bf16(xs[i], 0.f) & 0xffffu);
        }
    }
#pragma unroll
    for (int pass = 0; pass < 2; ++pass) {
        const int item = pass * 512 + tid, tok = item >> 4, seg = item & 15;
        *(u32x4*)(proj + pidx(t0 + tok, C_GK + h * 128 + seg * 8)) = *(const LAS u32x4*)(kb + tok * 136 + seg * 8);
    }
    __syncthreads();
}
__device__ void phaseB_ssd(const P& p, int layer, int chunkg) {
    const int tid = opaque_tid(), lane = tid & 63, wid = tid >> 6;
    const int c = chunkg & 127;
    const size_t t0 = (size_t)chunkg * 64;
    bf16_t* proj = (bf16_t*)(p.ws + WS_PROJ); const bf16_t* halo = (const bf16_t*)(p.ws + WS_HALO);
    const float* small = (const float*)(p.ws + WS_SMALL);
#pragma unroll
    for (int k = 0; k < 2; ++k) {
        const int hd = wid * 2 + k;
        const float dt = softplusf(small[(t0 + lane) * 32 + 8 + hd] + p.ssd_dt_bias[layer * 16 + hd]);
        const float a = -__expf(p.ssd_A_log[layer * 16 + hd]) * dt;
        const float ac = wave_scan_incl(a, lane);
        { ((float*)(p.ws + WS_DT))[(t0 + lane) * 16 + hd] = dt;
        ((float*)(p.ws + WS_ACUM))[(t0 + lane) * 16 + hd] = ac; }
    }
    const int seg = tid % 192, half = tid / 192;
    const int col = C_SX + seg * 8, ch = seg * 8;
    const bool act = tid < 384;
    u32x4 win[3];
    win[0] = win[1] = win[2] = (u32x4){0u, 0u, 0u, 0u};
    u32x4 rows[32];
    f32x2 wg2[4][4], bias2[4];
    if (act) {
        if (half == 1) {
#pragma unroll
            for (int d = 0; d < 3; ++d) win[d] = *(const u32x4*)(proj + pidx(t0 + 29 + d, col));
        } else if (c > 0) {
#pragma unroll
            for (int d = 0; d < 3; ++d) win[d] = *(const u32x4*)(halo + ((size_t)(chunkg - 1) * 3 + d) * 3072 + (col - 2048));
        }
#pragma unroll
        for (int k = 0; k < 32; ++k) rows[k] = *(const u32x4*)(proj + pidx(t0 + half * 32 + k, col));
        const float* cw = p.ssd_conv + (size_t)layer * 4 * 1536; const float* cb = p.ssd_conv_b + (size_t)layer * 1536;
#pragma unroll
        for (int d = 0; d < 4; ++d) {
            const f32x4 a = *(const f32x4*)(cw + d * 1536 + ch), bq = *(const f32x4*)(cw + d * 1536 + ch + 4);
            wg2[d][0] = (f32x2){a[0], a[1]}; wg2[d][1] = (f32x2){a[2], a[3]}; wg2[d][2] = (f32x2){bq[0], bq[1]}; wg2[d][3] = (f32x2){bq[2], bq[3]};
        }
        { const f32x4 a = *(const f32x4*)(cb + ch), bq = *(const f32x4*)(cb + ch + 4);
          bias2[0] = (f32x2){a[0], a[1]}; bias2[1] = (f32x2){a[2], a[3]}; bias2[2] = (f32x2){bq[0], bq[1]}; bias2[3] = (f32x2){bq[2], bq[3]}; }
    }
    __syncthreads();
    if (act) {
        f32x2 w0[4], w1[4], w2[4];
        unpack8(win[0], w0); unpack8(win[1], w1); unpack8(win[2], w2);
#pragma unroll
        for (int k = 0; k < 32; ++k) {
            f32x2 x3[4]; unpack8(rows[k], x3);
            f32x2 v2[4];
#pragma unroll
            for (int e = 0; e < 4; ++e) {
                f32x2 a = __builtin_elementwise_fma(wg2[0][e], w0[e], bias2[e]);
                a = __builtin_elementwise_fma(wg2[1][e], w1[e], a);
                a = __builtin_elementwise_fma(wg2[2][e], w2[e], a);
                a = __builtin_elementwise_fma(wg2[3][e], x3[e], a);
                v2[e] = silu2(a);
                w0[e] = w1[e]; w1[e] = w2[e]; w2[e] = x3[e];
            }
            u32x4 w; w.x = pk_bf16(v2[0][0], v2[0][1]); w.y = pk_bf16(v2[1][0], v2[1][1]); w.z = pk_bf16(v2[2][0], v2[2][1]); w.w = pk_bf16(v2[3][0], v2[3][1]);
            *(u32x4*)(proj + pidx(t0 + half * 32 + k, col)) = w;
        }
    }
}
__device__ void phaseB_ret(const P& p, int chunkg) {
    const int tid = opaque_tid();
    const int c = chunkg & 127;
    const size_t t0 = (size_t)chunkg * 64;
    bf16_t* proj = (bf16_t*)(p.ws + WS_PROJ);
    const int tok = tid >> 3, pg = tid & 7;
    const float pos = (float)(c * 64 + tok);
    float cs[8], sn[8];
#pragma unroll
    for (int e = 0; e < 8; ++e) {
        const float inv = exp2f(-(float)(pg * 8 + e) * (13.287712379549449f / 64.0f));
        const float ang = pos * inv;
        const float n = rintf(ang * 0.15915494309189535f);
        float rr = fmaf(-n, 6.28125f, ang); rr = fmaf(-n, 0.0019353071795864769f, rr);
        cs[e] = __cosf(rr); sn[e] = __sinf(rr);
    }
    u32x4 ra[4][2], rb[4][2];
#pragma unroll
    for (int hh = 0; hh < 4; ++hh)
#pragma unroll
        for (int s = 0; s < 2; ++s) {
            const bf16_t* base = proj + pidx(t0 + tok, (s == 0 ? C_RQ : C_RK) + hh * 128 + pg * 8);
            ra[hh][s] = *(const u32x4*)base; rb[hh][s] = *(const u32x4*)(base + 64);
        }
#pragma unroll
    for (int hh = 0; hh < 4; ++hh)
#pragma unroll
        for (int s = 0; s < 2; ++s) {
            bf16_t* base = proj + pidx(t0 + tok, (s == 0 ? C_RQ : C_RK) + hh * 128 + pg * 8);
            const float sc = s == 0 ? 1.0f : 0.08838834764831845f;
            const u32x4 a = ra[hh][s], b = rb[hh][s];
            const float t1[8] = {bf_lo(a.x), bf_hi(a.x), bf_lo(a.y), bf_hi(a.y), bf_lo(a.z), bf_hi(a.z), bf_lo(a.w), bf_hi(a.w)};
            const float t2[8] = {bf_lo(b.x), bf_hi(b.x), bf_lo(b.y), bf_hi(b.y), bf_lo(b.z), bf_hi(b.z), bf_lo(b.w), bf_hi(b.w)};
            float o1[8], o2[8];
#pragma unroll
            for (int e = 0; e < 8; ++e) { o1[e] = (t1[e] * cs[e] - t2[e] * sn[e]) * sc; o2[e] = (t1[e] * sn[e] + t2[e] * cs[e]) * sc; }
            u32x4 w1, w2;
            w1.x = pk_bf16(o1[0], o1[1]); w1.y = pk_bf16(o1[2], o1[3]); w1.z = pk_bf16(o1[4], o1[5]); w1.w = pk_bf16(o1[6], o1[7]);
            w2.x = pk_bf16(o2[0], o2[1]); w2.y = pk_bf16(o2[2], o2[3]); w2.z = pk_bf16(o2[4], o2[5]); w2.w = pk_bf16(o2[6], o2[7]);
            { *(u32x4*)base = w1; *(u32x4*)(base + 64) = w2; }
        }
}

constexpr int L_QS = 0, L_KS = 17408, L_WS = 34816, L_ST = 52224, L_VT = 69632, L_VST = 78848, L_AT = 88064, L_UT = 97280, L_CUM = 106496, L_DT = 106752;
constexpr int L_ALT = 107008;
constexpr int D_KS = L_ALT - L_KS, D_ST = L_ALT + 17408 - L_ST, D_VT = L_ALT + 34816 - L_VT, D_VST = L_ALT + 44032 - L_VST, D_CUM = L_ALT + 53248 - L_CUM;
typedef short s16x4 __attribute__((ext_vector_type(4)));
DI bf16x8 ldfrag_tr(const LAS bf16_t* X, int ld, int k0, int m0, int r, int q) {
    const LAS bf16_t* a = X + (k0 + q * 8 + (r >> 2)) * ld + m0 + 4 * (r & 3);
    const s16x4 lo = __builtin_amdgcn_ds_read_tr16_b64_v4i16((LAS s16x4*)a);
    const s16x4 hi = __builtin_amdgcn_ds_read_tr16_b64_v4i16((LAS s16x4*)(a + 4 * ld));
    return __builtin_shufflevector(lo, hi, 0, 1, 2, 3, 4, 5, 6, 7);
}
template <int KIND>
__device__ void phaseC_item(LAS unsigned char* lds, const P& p, int layer, int sub) {
    const int tid = opaque_tid(), lane = tid & 63, wid = __builtin_amdgcn_readfirstlane(tid >> 6), r = lane & 15, q = lane >> 4;
    bf16_t* proj = (bf16_t*)(p.ws + WS_PROJ);
    int b, qcol, kcol, vcol, hidx; float Dval = 0.f, lg = 0.f;
    if (KIND == 0) { b = sub >> 3; const int h = (sub >> 1) & 3, e = sub & 1; hidx = h; qcol = C_GQ + h * 128; kcol = C_GK + h * 128; vcol = C_GV + h * 128 + e * 64; }
    else if (KIND == 1) { b = sub >> 4; const int hd = sub & 15, grp = hd >> 3; hidx = hd; qcol = C_SC + grp * 128; kcol = C_SB + grp * 128; vcol = C_SX + hd * 64; Dval = p.ssd_D[layer * 16 + hd]; }
    else { b = sub >> 3; const int h = (sub >> 1) & 3, e = sub & 1; hidx = h; qcol = C_RQ + h * 128; kcol = C_RK + h * 128; vcol = C_RV + h * 128 + e * 64; lg = logf(1.0f - exp2f(-5.0f - (float)h)); }
    LAS bf16_t* Qs = (LAS bf16_t*)(lds + L_QS); LAS bf16_t* Ws = (LAS bf16_t*)(lds + L_WS);
    LAS bf16_t* AT = (LAS bf16_t*)(lds + L_AT); LAS bf16_t* UT = (LAS bf16_t*)(lds + L_UT);
    const bf16_t* Wbuf = (const bf16_t*)(p.ws + WS_WBUF);
    const float* gate = KIND == 0 ? (const float*)(p.ws + WS_GCUM) : (const float*)(p.ws + WS_ACUM);
    const float* gdt = (const float*)(p.ws + WS_DT);
    const int gstride = KIND == 0 ? 4 : 16;
    for (int i = tid; i < 17408 / 16; i += 512) *(LAS u32x4*)(lds + L_ST + i * 16) = (u32x4){0u, 0u, 0u, 0u};
    f32x4 Sacc[4];
#pragma unroll
    for (int n = 0; n < 4; ++n) Sacc[n] = (f32x4){0.f, 0.f, 0.f, 0.f};
    u32x4 pq[2], pk[2], pw[2], pv; float pcum = 0.f, pcl = 0.f, pdt = 1.f, pcum2 = 0.f, pdt2 = 1.f;
    const int mt = wid >> 1, nt0 = (wid & 1) * 2;
    u32x2 pz0 = (u32x2){0u, 0u}, pz1 = pz0, cz0 = pz0, cz1 = pz0;
    const int zcol = C_SZ + (vcol - C_SX);
    const int mytok = tid & 63, vtok = tid >> 3, vseg = tid & 7;
#define PREFETCH(cc) do { const size_t t0_ = ((size_t)b * NCHUNK + (cc)) * 64; \
        _Pragma("unroll") for (int it = 0; it < 2; ++it) { const int pp = tid + 512 * it; \
            pq[it] = *(const u32x4*)(proj + pidx(t0_ + (pp >> 4), qcol + (pp & 15) * 8)); \
            pk[it] = *(const u32x4*)(proj + pidx(t0_ + (pp >> 4), kcol + (pp & 15) * 8)); \
            if (KIND == 0) pw[it] = *(const u32x4*)(Wbuf + (t0_ + (pp >> 4)) * 512 + hidx * 128 + (pp & 15) * 8); } \
        pv = *(const u32x4*)(proj + pidx(t0_ + vtok, vcol + vseg * 8)); \
        if (KIND != 2) { pcum = gate[(t0_ + mytok) * gstride + hidx]; pcl = gate[(t0_ + 63) * gstride + hidx]; } \
        else { pcum = (float)(mytok + 1) * lg; pcl = 64.0f * lg; } \
        if (KIND == 1) { pdt = gdt[(t0_ + mytok) * 16 + hidx]; pdt2 = gdt[(t0_ + vtok) * 16 + hidx]; pcum2 = gate[(t0_ + vtok) * gstride + hidx]; } \
        if (KIND == 2) pcum2 = (float)(vtok + 1) * lg; \
        if (KIND == 1) { pz0 = *(const u32x2*)(proj + pidx(t0_ + nt0 * 16 + r, zcol + mt * 16 + q * 4)); pz1 = *(const u32x2*)(proj + pidx(t0_ + (nt0 + 1) * 16 + r, zcol + mt * 16 + q * 4)); } } while (0)
    PREFETCH(0);
    u32x2 ow0 = (u32x2){0u, 0u}, ow1 = ow0;
    for (int c = 0; c < NCHUNK; ++c) {
        const size_t t0 = ((size_t)b * NCHUNK + c) * 64;
        const int par = c & 1;
        LAS bf16_t* Ks = (LAS bf16_t*)(lds + L_KS + par * D_KS); LAS bf16_t* ST = (LAS bf16_t*)(lds + L_ST + par * D_ST); LAS bf16_t* STn = (LAS bf16_t*)(lds + L_ST + (par ^ 1) * D_ST);
        LAS bf16_t* VT = (LAS bf16_t*)(lds + L_VT + par * D_VT);
        LAS bf16_t* VST = (LAS bf16_t*)(lds + L_VST + par * D_VST);
        LAS float* cumS = (LAS float*)(lds + L_CUM + par * D_CUM); LAS float* dtS = cumS + 64;
#pragma unroll
        for (int it = 0; it < 2; ++it) {
            const int pp = tid + 512 * it;
            *(LAS u32x4*)(Qs + (pp >> 4) * 136 + (pp & 15) * 8) = pq[it];
            *(LAS u32x4*)(Ks + (pp >> 4) * 136 + (pp & 15) * 8) = pk[it];
            if (KIND == 0) *(LAS u32x4*)(Ws + (pp >> 4) * 136 + (pp & 15) * 8) = pw[it];
        }
        if (KIND == 0) {
            *(LAS u32x4*)(UT + vtok * 72 + vseg * 8) = pv;
        } else {
            const float sa = KIND == 1 ? pdt2 : 1.0f, sb = sa * __expf(pcl - pcum2);
            const float v0 = bf_lo(pv.x), v1 = bf_hi(pv.x), v2 = bf_lo(pv.y), v3 = bf_hi(pv.y), v4 = bf_lo(pv.z), v5 = bf_hi(pv.z), v6 = bf_lo(pv.w), v7 = bf_hi(pv.w);
            u32x4 wa = pv;
            if (KIND == 1) { wa.x = pk_bf16(v0 * sa, v1 * sa); wa.y = pk_bf16(v2 * sa, v3 * sa); wa.z = pk_bf16(v4 * sa, v5 * sa); wa.w = pk_bf16(v6 * sa, v7 * sa); }
            u32x4 wb; wb.x = pk_bf16(v0 * sb, v1 * sb); wb.y = pk_bf16(v2 * sb, v3 * sb); wb.z = pk_bf16(v4 * sb, v5 * sb); wb.w = pk_bf16(v6 * sb, v7 * sb);
            *(LAS u32x4*)(VT + vtok * 72 + vseg * 8) = wa;
            *(LAS u32x4*)(VST + vtok * 72 + vseg * 8) = wb;
        }
        if (tid < 64) { cumS[tid] = pcum; if (KIND == 1) dtS[tid] = pdt; }
        if (KIND == 1) { cz0 = pz0; cz1 = pz1; }
        if (c > 0) {
            *(u32x2*)(proj + pidx(t0 - 64 + nt0 * 16 + r, vcol + mt * 16 + q * 4)) = ow0;
            *(u32x2*)(proj + pidx(t0 - 64 + (nt0 + 1) * 16 + r, vcol + mt * 16 + q * 4)) = ow1;
        }
        __syncthreads();
        if (c + 1 < NCHUNK) PREFETCH(c + 1);
        const float cl = cumS[63];
        bf16x8 gb[2][4];
        {
            bf16x8 fa[4], fb[2][4], ga[4];
            if (KIND == 0) { ldfrag<4>(fa, Ws + mt * 16 * 136, 136, r, q); ldfrag<4>(fb[0], ST + nt0 * 16 * 136, 136, r, q); ldfrag<4>(fb[1], ST + (nt0 + 1) * 16 * 136, 136, r, q); }
            ldfrag<4>(ga, Ks + mt * 16 * 136, 136, r, q); ldfrag<4>(gb[0], Qs + nt0 * 16 * 136, 136, r, q); ldfrag<4>(gb[1], Qs + (nt0 + 1) * 16 * 136, 136, r, q);
            const f32x4 cj = *(const LAS f32x4*)(cumS + mt * 16 + q * 4);
            u32x2 uu[2]; float ci[2], dti[2];
#pragma unroll
            for (int tt = 0; tt < 2; ++tt) {
                if (KIND == 0) uu[tt] = *(const LAS u32x2*)(UT + ((nt0 + tt) * 16 + r) * 72 + mt * 16 + q * 4);
                ci[tt] = cumS[(nt0 + tt) * 16 + r];
                if (KIND == 1) dti[tt] = dtS[(nt0 + tt) * 16 + r];
            }
            __builtin_amdgcn_sched_barrier(0);
            if (KIND == 0) {
                f32x4 a0 = (f32x4){0.f, 0.f, 0.f, 0.f}, a1 = a0;
                a0 = mmafrag<4>(a0, fa, fb[0]); a1 = mmafrag<4>(a1, fa, fb[1]);
                const float e0 = __expf(cl - cj[0]), e1 = __expf(cl - cj[1]), e2 = __expf(cl - cj[2]), e3 = __expf(cl - cj[3]);
#pragma unroll
                for (int tt = 0; tt < 2; ++tt) {
                    const f32x4 acc = tt ? a1 : a0;
                    const float v0 = bf_lo(uu[tt].x) - acc[0], v1 = bf_hi(uu[tt].x) - acc[1], v2 = bf_lo(uu[tt].y) - acc[2], v3 = bf_hi(uu[tt].y) - acc[3];
                    u32x2 w; w.x = pk_bf16(v0, v1); w.y = pk_bf16(v2, v3);
                    *(LAS u32x2*)(VT + ((nt0 + tt) * 16 + r) * 72 + mt * 16 + q * 4) = w;
                    u32x2 ws; ws.x = pk_bf16(v0 * e0, v1 * e1); ws.y = pk_bf16(v2 * e2, v3 * e3);
                    *(LAS u32x2*)(VST + ((nt0 + tt) * 16 + r) * 72 + mt * 16 + q * 4) = ws;
                }
            }
            {
                f32x4 a0 = (f32x4){0.f, 0.f, 0.f, 0.f}, a1 = a0;
                a0 = mmafrag<4>(a0, ga, gb[0]); a1 = mmafrag<4>(a1, ga, gb[1]);
#pragma unroll
                for (int tt = 0; tt < 2; ++tt) {
                    const f32x4 acc = tt ? a1 : a0;
                    const int i = (nt0 + tt) * 16 + r;
                    float f[4];
#pragma unroll
                    for (int jj = 0; jj < 4; ++jj) {
                        const int j = mt * 16 + q * 4 + jj;
                        float v = (j <= i) ? acc[jj] * __expf(ci[tt] - cj[jj]) : 0.f;
                        if (KIND == 1 && j == i) v += Dval * __builtin_amdgcn_rcpf(dti[tt]);
                        f[jj] = v;
                    }
                    u32x2 w; w.x = pk_bf16(f[0], f[1]); w.y = pk_bf16(f[2], f[3]);
                    *(LAS u32x2*)(AT + i * 72 + mt * 16 + q * 4) = w;
                }
            }
        }
        __syncthreads();
        {
            bf16x8 sa[4], va[2], ab[2][2], ka[2], vb[4][2];
            ldfrag<4>(sa, ST + mt * 16 * 136, 136, r, q);
            ldfrag<2>(ab[0], AT + nt0 * 16 * 72, 72, r, q); ldfrag<2>(ab[1], AT + (nt0 + 1) * 16 * 72, 72, r, q);
            if (KIND == 0) {
                ldfrag<2>(va, VT + mt * 16 * 72, 72, r, q);
#pragma unroll
                for (int n = 0; n < 4; ++n) ldfrag<2>(vb[n], VST + n * 16 * 72, 72, r, q);
            } else {
#pragma unroll
                for (int ks = 0; ks < 2; ++ks) {
                    va[ks] = ldfrag_tr(VT, 72, ks * 32, mt * 16, r, q);
#pragma unroll
                    for (int n = 0; n < 4; ++n) vb[n][ks] = ldfrag_tr(VST, 72, ks * 32, n * 16, r, q);
                }
            }
#pragma unroll
            for (int ks = 0; ks < 2; ++ks) ka[ks] = ldfrag_tr(Ks, 136, ks * 32, wid * 16, r, q);
            const float ei0 = __expf(cumS[nt0 * 16 + r]), ei1 = __expf(cumS[(nt0 + 1) * 16 + r]);
            const float dl = __expf(cl);
            __builtin_amdgcn_sched_barrier(0);
            f32x4 o0 = (f32x4){0.f, 0.f, 0.f, 0.f}, o1 = o0;
            o0 = mmafrag<4>(o0, sa, gb[0]); o1 = mmafrag<4>(o1, sa, gb[1]);
            o0 *= ei0; o1 *= ei1;
            o0 = mmafrag<2>(o0, va, ab[0]); o1 = mmafrag<2>(o1, va, ab[1]);
#pragma unroll
            for (int n = 0; n < 4; ++n) { Sacc[n] *= dl; Sacc[n] = mmafrag<2>(Sacc[n], ka, vb[n]); }
            if (KIND == 1) {
                o0[0] *= siluf(bf_lo(cz0.x)); o0[1] *= siluf(bf_hi(cz0.x)); o0[2] *= siluf(bf_lo(cz0.y)); o0[3] *= siluf(bf_hi(cz0.y));
                o1[0] *= siluf(bf_lo(cz1.x)); o1[1] *= siluf(bf_hi(cz1.x)); o1[2] *= siluf(bf_lo(cz1.y)); o1[3] *= siluf(bf_hi(cz1.y));
            }
            ow0.x = pk_bf16(o0[0], o0[1]); ow0.y = pk_bf16(o0[2], o0[3]);
            ow1.x = pk_bf16(o1[0], o1[1]); ow1.y = pk_bf16(o1[2], o1[3]);
        }
#pragma unroll
        for (int n = 0; n < 4; ++n) {
            u32x2 w; w.x = pk_bf16(Sacc[n][0], Sacc[n][1]); w.y = pk_bf16(Sacc[n][2], Sacc[n][3]);
            *(LAS u32x2*)(STn + (n * 16 + r) * 136 + wid * 16 + q * 4) = w;
        }
    }
    {
        const size_t tl = ((size_t)b * NCHUNK + NCHUNK - 1) * 64;
        *(u32x2*)(proj + pidx(tl + nt0 * 16 + r, vcol + mt * 16 + q * 4)) = ow0;
        *(u32x2*)(proj + pidx(tl + (nt0 + 1) * 16 + r, vcol + mt * 16 + q * 4)) = ow1;
    }
    __syncthreads();
#undef PREFETCH
}

__device__ void phaseD(const P& p, int layer) {
    const int tid_ = opaque_tid(); const int lane = tid_ & 63, wv = tid_ >> 6;
    bf16_t* proj = (bf16_t*)(p.ws + WS_PROJ);
    const float* gw = p.gdn_norm + layer * 128; const float* rw = p.ret_norm + layer * 128; const float* sw = p.ssd_norm + layer * 1024;
    const int stride = gridDim.x * 8;
    u32x4 cur[8], nxt[8];
#define D_LOAD(dst, rr) do { const size_t rr_ = (size_t)(rr); \
        dst[0] = __builtin_nontemporal_load((const u32x4*)(proj + pidx(rr_, C_GV + lane * 8))); dst[1] = __builtin_nontemporal_load((const u32x4*)(proj + pidx(rr_, C_GZ + lane * 8))); \
        dst[2] = __builtin_nontemporal_load((const u32x4*)(proj + pidx(rr_, C_RV + lane * 8))); dst[3] = __builtin_nontemporal_load((const u32x4*)(proj + pidx(rr_, C_RG + lane * 8))); \
        dst[4] = __builtin_nontemporal_load((const u32x4*)(proj + pidx(rr_, C_SX + lane * 16))); dst[5] = (u32x4){0u, 0u, 0u, 0u}; \
        dst[6] = __builtin_nontemporal_load((const u32x4*)(proj + pidx(rr_, C_SX + lane * 16 + 8))); dst[7] = (u32x4){0u, 0u, 0u, 0u}; } while (0)
    int row = blockIdx.x * 8 + wv;
    if (row < T_TOK) D_LOAD(nxt, row);
    for (; row < T_TOK; row += stride) {
#pragma unroll
        for (int k = 0; k < 8; ++k) cur[k] = nxt[k];
        if (row + stride < T_TOK) D_LOAD(nxt, row + stride);
#pragma unroll
        for (int s = 0; s < 2; ++s) {
            const int zc = (s == 0 ? C_GZ : C_RG) + lane * 8;
            const float* nw = (s == 0 ? gw : rw) + (lane & 15) * 8;
            const u32x4 o = cur[2 * s], z = cur[2 * s + 1];
            float ov[8] = {bf_lo(o.x), bf_hi(o.x), bf_lo(o.y), bf_hi(o.y), bf_lo(o.z), bf_hi(o.z), bf_lo(o.w), bf_hi(o.w)};
            const float zv[8] = {bf_lo(z.x), bf_hi(z.x), bf_lo(z.y), bf_hi(z.y), bf_lo(z.z), bf_hi(z.z), bf_lo(z.w), bf_hi(z.w)};
            float ss = 0.f;
#pragma unroll
            for (int e = 0; e < 8; ++e) ss += ov[e] * ov[e];
            ss += __shfl_xor(ss, 1); ss += __shfl_xor(ss, 2); ss += __shfl_xor(ss, 4); ss += __shfl_xor(ss, 8);
            const float rs = rsqrtf(ss * (1.0f / 128.0f) + EPS);
#pragma unroll
            for (int e = 0; e < 8; ++e) ov[e] = ov[e] * rs * nw[e] * siluf(zv[e]);
            u32x4 w; w.x = pk_bf16(ov[0], ov[1]); w.y = pk_bf16(ov[2], ov[3]); w.z = pk_bf16(ov[4], ov[5]); w.w = pk_bf16(ov[6], ov[7]);
            *(u32x4*)(proj + pidx((size_t)row, zc)) = w;
        }
        {
            float yv[16];
#pragma unroll
            for (int k = 0; k < 2; ++k) {
                const u32x4 o = cur[4 + 2 * k], z = cur[5 + 2 * k];
                const float ov[8] = {bf_lo(o.x), bf_hi(o.x), bf_lo(o.y), bf_hi(o.y), bf_lo(o.z), bf_hi(o.z), bf_lo(o.w), bf_hi(o.w)};
                const float zv[8] = {bf_lo(z.x), bf_hi(z.x), bf_lo(z.y), bf_hi(z.y), bf_lo(z.z), bf_hi(z.z), bf_lo(z.w), bf_hi(z.w)};
#pragma unroll
                for (int e = 0; e < 8; ++e) yv[k * 8 + e] = ov[e];
            }
            float ss = 0.f;
#pragma unroll
            for (int e = 0; e < 16; ++e) ss += yv[e] * yv[e];
            ss += __shfl_xor(ss, 1); ss += __shfl_xor(ss, 2); ss += __shfl_xor(ss, 4); ss += __shfl_xor(ss, 8); ss += __shfl_xor(ss, 16);
            const float rs = rsqrtf(ss * (1.0f / 512.0f) + EPS);
#pragma unroll
            for (int k = 0; k < 2; ++k) {
                const float* nw = sw + lane * 16 + k * 8;
                u32x4 w; w.x = pk_bf16(yv[k * 8] * rs * nw[0], yv[k * 8 + 1] * rs * nw[1]); w.y = pk_bf16(yv[k * 8 + 2] * rs * nw[2], yv[k * 8 + 3] * rs * nw[3]);
                w.z = pk_bf16(yv[k * 8 + 4] * rs * nw[4], yv[k * 8 + 5] * rs * nw[5]); w.w = pk_bf16(yv[k * 8 + 6] * rs * nw[6], yv[k * 8 + 7] * rs * nw[7]);
                *(u32x4*)(proj + pidx((size_t)row, C_SZ + lane * 16 + k * 8)) = w;
            }
        }
    }
#undef D_LOAD
}

__global__ void __launch_bounds__(512, 2) hybrid_fwd(P p) {
    extern __shared__ __attribute__((aligned(16))) unsigned char lds_raw[];
    LAS unsigned char* lds = (LAS unsigned char*)lds_raw;
    cg::grid_group grid = cg::this_grid();
    const int G = gridDim.x, bx = blockIdx.x;
    bf16_t* proj = (bf16_t*)(p.ws + WS_PROJ);
    bf16_t* hbuf = (bf16_t*)(p.ws + WS_H);
    if (threadIdx.x == 0) *(LAS u32x4*)(lds + LDS_BAR_OFF) = (u32x4){0u, 0u, 0u, 0u};
    __syncthreads();
    XcdBarrier xb = xcd_barrier_post((unsigned*)(p.ws + WS_BAR), (volatile LAS unsigned*)(lds + LDS_BAR_OFF));
    int nsync = 0;
    for (int ph = p.ph_lo; ph < p.ph_hi; ++ph) {
        if (ph > p.ph_lo) { if (nsync == 0) grid.sync(); else xcd_barrier(xb); ++nsync; }
        const int layer = ph >= 7 ? 1 : 0, sub = ph == 0 ? 0 : (ph - 1) % 6 + 1;
        if (sub == 0) {
            phase_convert(p);
            phase_rows(p.x, nullptr, 0, nullptr, nullptr, p.pre_norm, hbuf);
        } else if (sub == 1) {
            pg8::Gemm g; g.A = hbuf; g.Bt = (const bf16_t*)(p.ws + WS_WIN) + (size_t)layer * NPW * DM; g.M = T_TOK; g.N = NPW; g.K = DM; g.lda = DM; g.atiled = 0;
            pg8::StaticOrder S; S.init(g.M, g.N, G, bx);
            EpiProj E; E.proj = proj; E.small = (float*)(p.ws + WS_SMALL); E.halo = (bf16_t*)(p.ws + WS_HALO);
            pg8::gemm_phase<EpiProj>(lds, g, S, E);
        } else if (sub == 2) {
            for (int it = bx; it < 1024 * 6; it += G) {
                const int chunkg = it & 1023, kind = it >> 10;
                if (kind < 4) phaseB_gdn(lds, p, layer, chunkg, kind);
                else if (kind == 4) phaseB_ssd(p, layer, chunkg);
                else phaseB_ret(p, chunkg);
            }
        } else if (sub == 3) {
            for (int it = bx; it < 256; it += G) {
                int kind, sub;
                if (G == 256) {
                    const int xcd = it & 7, s = it >> 3;
                    if (s < 8) { kind = 0; sub = (xcd + 8 * (s >> 1)) * 2 + (s & 1); }
                    else if (s < 24) { const int s2 = s - 8, g = xcd + 8 * (s2 >> 3); kind = 1; sub = (g >> 1) * 16 + (g & 1) * 8 + (s2 & 7); }
                    else { const int s2 = s - 24; kind = 2; sub = (xcd + 8 * (s2 >> 1)) * 2 + (s2 & 1); }
                } else { kind = it < 64 ? 0 : (it < 192 ? 1 : 2); sub = it < 64 ? it : (it < 192 ? it - 64 : it - 192); }
                if (kind == 0) phaseC_item<0>(lds, p, layer, sub);
                else if (kind == 1) phaseC_item<1>(lds, p, layer, sub);
                else phaseC_item<2>(lds, p, layer, sub);
            }
        } else if (sub == 4) {
            phaseD(p, layer);
        } else if (sub == 5) {
            pg8::Gemm g; g.A = proj; g.Bt = (const bf16_t*)(p.ws + WS_WOUT) + (size_t)layer * 1024 * 2048; g.M = T_TOK; g.N = 1024; g.K = 2048; g.lda = 256; g.atiled = 1;
            pg8::StaticOrder S; S.init(g.M, g.N, G, bx);
            EpiOut E; E.O = proj;
            pg8::gemm_phase<EpiOut>(lds, g, S, E);
        } else {
            phase_rows(layer == 0 ? p.x : p.out, proj, NP, p.post_norm + layer * DM, p.out,
                       layer == 0 ? p.pre_norm + DM : nullptr, hbuf);
        }
    }
}

extern "C" void kernel_launch(void* const* d_in, const int* in_sizes, int n_in, void* d_out, int out_size, void* d_ws, size_t ws_size, hipStream_t stream) {
    static int grid_blocks = 0;
    if (grid_blocks == 0) {
        if (n_in != 16 || in_sizes[0] != T_TOK * DM || out_size != T_TOK * DM || ws_size < WS_TOTAL) {
            fprintf(stderr, "kernel_launch: unexpected shapes / workspace (%d inputs, in0 %d, out %d, ws %zu, need %zu)\n", n_in, n_in > 0 ? in_sizes[0] : -1, out_size, ws_size, (size_t)WS_TOTAL);
            grid_blocks = -1; return;
        }
        int dev = 0, cus = 0, per_cu = 0;
        hipGetDevice(&dev);
        hipDeviceGetAttribute(&cus, hipDeviceAttributeMultiprocessorCount, dev);
        if (hipFuncSetAttribute((const void*)hybrid_fwd, hipFuncAttributeMaxDynamicSharedMemorySize, LDS_BYTES) != hipSuccess) { fprintf(stderr, "hipFuncSetAttribute failed\n"); grid_blocks = -1; return; }
        hipOccupancyMaxActiveBlocksPerMultiprocessor(&per_cu, (const void*)hybrid_fwd, 512, LDS_BYTES);
        if (per_cu < 1) { fprintf(stderr, "occupancy query returned %d\n", per_cu); grid_blocks = -1; return; }
        grid_blocks = cus;
    }
    if (grid_blocks < 0) return;
    P p{};
    p.x = (const float*)d_in[0]; p.pre_norm = (const float*)d_in[1]; p.post_norm = (const float*)d_in[2]; p.w_in = (const float*)d_in[3];
    p.gdn_conv = (const float*)d_in[4]; p.gdn_A_log = (const float*)d_in[5]; p.gdn_dt_bias = (const float*)d_in[6]; p.gdn_norm = (const float*)d_in[7];
    p.ssd_conv = (const float*)d_in[8]; p.ssd_conv_b = (const float*)d_in[9]; p.ssd_A_log = (const float*)d_in[10]; p.ssd_dt_bias = (const float*)d_in[11];
    p.ssd_D = (const float*)d_in[12]; p.ssd_norm = (const float*)d_in[13]; p.ret_norm = (const float*)d_in[14]; p.w_out = (const float*)d_in[15];
    p.out = (float*)d_out; p.ws = (unsigned char*)d_ws;
    p.ph_lo = 0; p.ph_hi = 13;
    hipError_t me = hipMemsetAsync((unsigned char*)d_ws + WS_BAR, 0, XCD_BAR_WORDS * sizeof(unsigned), stream);
    if (me != hipSuccess) fprintf(stderr, "barrier memset failed: %s\n", hipGetErrorString(me));
    void* args[] = {&p};
    hipError_t e = hipLaunchCooperativeKernel((const void*)hybrid_fwd, dim3(grid_blocks), dim3(512), args, LDS_BYTES, stream);
    if (e != hipSuccess) fprintf(stderr, "cooperative launch failed: %s (grid %d)\n", hipGetErrorString(e), grid_blocks);
}
```

```cpp
#include <hip/hip_runtime.h>
#include <hip/hip_cooperative_groups.h>
#include <cstdio>
namespace cg = cooperative_groups;

#define LAS __attribute__((address_space(3)))
#define DI __device__ __forceinline__
typedef unsigned short bf16_t;
typedef short bf16x8 __attribute__((ext_vector_type(8)));
typedef float f32x4 __attribute__((ext_vector_type(4)));
typedef unsigned u32x4 __attribute__((ext_vector_type(4)));
typedef unsigned u32x2 __attribute__((ext_vector_type(2)));

constexpr int T_TOK = 65536, DM = 1024, NCHUNK = 128, NB = 8;
constexpr int NP = 6656;
constexpr int NPW = 6912;
constexpr int NIN = 6680;
constexpr int C_GZ = 0, C_SZ = 512, C_RG = 1536, C_GQ = 2048, C_GK = 2560, C_GV = 3072, C_SX = 3584, C_SB = 4608, C_SC = 4864,
              C_RQ = 5120, C_RK = 5632, C_RV = 6144;
constexpr float EPS = 1e-6f;
__device__ __forceinline__ size_t pidx(size_t row, int col) { return ((row >> 8) * 26 + (size_t)(col >> 8)) * 65536 + (row & 255) * 256 + (size_t)(col & 255); }
constexpr size_t WS_PROJ = 0;
constexpr size_t WS_H = (size_t)T_TOK * NP * 2;
constexpr size_t WS_WBUF = WS_H;
constexpr size_t WS_GCUM = WS_H + (size_t)T_TOK * 512 * 2;
constexpr size_t WS_DT = WS_GCUM + (size_t)T_TOK * 4 * 4;
constexpr size_t WS_ACUM = WS_DT + (size_t)T_TOK * 16 * 4;
constexpr size_t WS_WIN = WS_H + (size_t)T_TOK * DM * 2;
constexpr size_t WS_WOUT = WS_WIN + (size_t)2 * NPW * DM * 2;
constexpr size_t WS_SMALL = WS_WOUT + (size_t)2 * 1024 * 2048 * 2;
constexpr size_t WS_HALO = WS_SMALL + (size_t)T_TOK * 32 * 4;
constexpr size_t WS_END = WS_HALO + (size_t)1024 * 3 * 3072 * 2;
constexpr size_t WS_BAR = WS_END;
constexpr size_t WS_TOTAL = WS_END + 16384;
constexpr int LDS_BAR_OFF = 160768;
constexpr int LDS_BYTES = 160768 + 16;

struct P {
    const float* x; const float* pre_norm; const float* post_norm; const float* w_in; const float* gdn_conv; const float* gdn_A_log;
    const float* gdn_dt_bias; const float* gdn_norm; const float* ssd_conv; const float* ssd_conv_b; const float* ssd_A_log;
    const float* ssd_dt_bias; const float* ssd_D; const float* ssd_norm; const float* ret_norm; const float* w_out;
    float* out; unsigned char* ws; int ph_lo, ph_hi;
};

DI int opaque_tid() { int t = threadIdx.x; asm volatile("" : "+v"(t)); return t; }
typedef float f32x2 __attribute__((ext_vector_type(2)));
typedef __bf16 bf16x2_t __attribute__((ext_vector_type(2)));
DI unsigned pk_bf16(float lo, float hi) { const f32x2 v = {lo, hi}; const bf16x2_t b = __builtin_convertvector(v, bf16x2_t); return __builtin_bit_cast(unsigned, b); }
DI float bf_lo(unsigned w) { return __uint_as_float(w << 16); }
DI float bf_hi(unsigned w) { return __uint_as_float(w & 0xffff0000u); }
DI float siluf(float v) { return v * __builtin_amdgcn_rcpf(1.0f + __expf(-v)); }
DI void unpack8(const u32x4 w, f32x2 (&o)[4]) { o[0] = (f32x2){bf_lo(w.x), bf_hi(w.x)}; o[1] = (f32x2){bf_lo(w.y), bf_hi(w.y)}; o[2] = (f32x2){bf_lo(w.z), bf_hi(w.z)}; o[3] = (f32x2){bf_lo(w.w), bf_hi(w.w)}; }
DI f32x2 silu2(f32x2 v) { const f32x2 e = (f32x2){__expf(-v[0]), __expf(-v[1])}; const f32x2 d = e + 1.0f; const f32x2 rr = (f32x2){__builtin_amdgcn_rcpf(d[0]), __builtin_amdgcn_rcpf(d[1])}; return v * rr; }
DI float softplusf(float v) { return v > 20.f ? v : log1pf(__expf(v)); }
DI float wave_scan_incl(float v, int lane) {
#pragma unroll
    for (int o = 1; o < 64; o <<= 1) { float t = __shfl_up(v, o); if (lane >= o) v += t; }
    return v;
}

#define XB_TMO      128
#define XB_XCNT(j)  (256  + 64 * (j))
#define XB_XSUB(j)  (1280 + 64 * (j))
#define XB_XGEN(j)  (2304 + 64 * (j))
#define XB_TOP      3328
#define XB_TOPGEN   3392
#define XCD_BAR_WORDS 3456
#define XB_SPIN_CAP (1u << 18)

__device__ __forceinline__ unsigned xb_ld(unsigned* p)              { return __hip_atomic_load(p, __ATOMIC_RELAXED, __HIP_MEMORY_SCOPE_AGENT); }
__device__ __forceinline__ unsigned xb_add(unsigned* p, unsigned v) { return __hip_atomic_fetch_add(p, v, __ATOMIC_RELAXED, __HIP_MEMORY_SCOPE_AGENT); }
__device__ __forceinline__ unsigned xb_xcc_id() { return (unsigned)__builtin_amdgcn_s_getreg((3 << 11) | 20) & 0xFu; }
#define XB_SPIN(cond, bar) do { unsigned _sp = 0; while (cond) { __builtin_amdgcn_s_sleep(1); \
    if ((++_sp & 255u) == 0u) { if (xb_ld(&(bar)[XB_TMO])) break; if (_sp > XB_SPIN_CAP) { atomicAdd(&(bar)[XB_TMO], 1u); break; } } } } while (0)

struct XcdBarrier {
    unsigned* bar; unsigned x;
    volatile LAS unsigned* st;
};

__device__ __forceinline__ XcdBarrier xcd_barrier_post(unsigned* bar, volatile LAS unsigned* st) {
    XcdBarrier b; b.bar = bar; b.x = xb_xcc_id(); b.st = st;
    if (threadIdx.x == 0) (void)xb_add(&bar[XB_XCNT(b.x)], 1u);
    return b;
}
__device__ __forceinline__ void xcd_barrier_complete(unsigned* bar, unsigned x, unsigned& nloc, unsigned& nx) {
    const unsigned G = gridDim.x * gridDim.y * gridDim.z;
    unsigned sum, cnt, mine, sp = 0u;
    for (;;) {
        sum = 0u; cnt = 0u; mine = 0u;
#pragma unroll
        for (unsigned j = 0; j < 16; ++j) { const unsigned c = xb_ld(&bar[XB_XCNT(j)]); sum += c; cnt += (c > 0u) ? 1u : 0u; mine = (j == x) ? c : mine; }
        if (sum == G) break;
        __builtin_amdgcn_s_sleep(1);
        if ((++sp & 255u) == 0u) { if (xb_ld(&bar[XB_TMO])) break; if (sp > XB_SPIN_CAP) { atomicAdd(&bar[XB_TMO], 1u); break; } }
    }
    nloc = mine > 0u ? mine : 1u; nx = cnt > 0u ? cnt : 1u;
}

__device__ __forceinline__ void xcd_barrier(const XcdBarrier& b) {
    asm volatile("s_waitcnt vmcnt(0)" ::: "memory");
    __syncthreads();
    if (threadIdx.x == 0) {
        unsigned* bar = b.bar;
        __builtin_amdgcn_s_waitcnt(0);
        unsigned nloc = b.st[0], nx = b.st[1];
        if (nloc == 0u) { xcd_barrier_complete(bar, b.x, nloc, nx); b.st[0] = nloc; b.st[1] = nx; }
        const unsigned old = xb_add(&bar[XB_XSUB(b.x)], 1u);
        const unsigned gen = old / nloc;
        if (old + 1u == (gen + 1u) * nloc) {
            __builtin_amdgcn_fence(__ATOMIC_RELEASE, "agent");
            asm volatile("s_waitcnt vmcnt(0)" ::: "memory");
            const unsigned og = xb_add(&bar[XB_TOP], 1u);
            const unsigned tg = og / nx;
            if (og + 1u == (tg + 1u) * nx) xb_add(&bar[XB_TOPGEN], 1u);
            else XB_SPIN(xb_ld(&bar[XB_TOPGEN]) == tg, bar);
            __builtin_amdgcn_fence(__ATOMIC_ACQUIRE, "agent");
            xb_add(&bar[XB_XGEN(b.x)], 1u);
            asm volatile("s_waitcnt vmcnt(0)" ::: "memory");
        } else {
            XB_SPIN(xb_ld(&bar[XB_XGEN(b.x)]) == gen, bar);
            __builtin_amdgcn_fence(__ATOMIC_ACQUIRE, "agent");
            asm volatile("s_waitcnt vmcnt(0)" ::: "memory");
        }
    }
    __syncthreads();
}


namespace pg8 {
constexpr int BM = 256, BK = 64, HALF = 128, HTB = HALF * BK * 2, NXCD = 8, WGM = 4;
DI int lds_byte(int r, int c) { const int st = (r >> 4) * 2 + (c >> 5), rr = r & 15, cc = c & 31, ob = rr * 64 + cc * 2; return st * 1024 + (ob ^ (((ob >> 9) & 1) << 5)); }
DI void stage_rc(int b, int& R, int& C) { const int st = b / 1024, sb = b % 1024, swz = sb ^ (((sb >> 9) & 1) << 5); R = (st >> 1) * 16 + swz / 64; C = (st & 1) * 32 + (swz % 64) / 2; }
DI int perm32(int rho) { const int n = rho >> 4, i = rho & 15; return 8 * (i >> 2) + 4 * n + (i & 3); }
struct Unit { int pm, pn; };
struct Gemm { const bf16_t* A; const bf16_t* Bt; int M, N, K, lda, atiled; };
struct StaticOrder {
    int nM, nN, nwg, G, c;
    DI void init(int M, int N, int G_, int c_) { nM = M / BM; nN = N / BM; nwg = nM * nN; G = G_; c = c_; }
    DI bool next(int i, Unit& u) const {
        const long L = (long)i * G + c; if (L >= nwg) return false;
        int wgid = (int)L; { const int q = nwg / NXCD, r = nwg % NXCD, xcd = wgid % NXCD, off = wgid / NXCD; wgid = (xcd < r ? xcd * (q + 1) : r * (q + 1) + (xcd - r) * q) + off; }
        const int nig = WGM * nN, gid = wgid / nig, fm = gid * WGM, gsz = (nM - fm) < WGM ? (nM - fm) : WGM;
        u.pm = fm + ((wgid % nig) % gsz); u.pn = (wgid % nig) / gsz; return true;
    }
};

template <class Epi>
DI void gemm_phase(LAS unsigned char* lds, const Gemm g, const StaticOrder& S, const Epi& E) {
    const int tid = opaque_tid(), wid = __builtin_amdgcn_readfirstlane(tid >> 6), lane = tid & 63, wr = wid >> 2, wc = wid & 3, fr = lane & 15, fq = lane >> 4;
    const int K = g.K, nt = K / BK, lda = g.lda;
    unsigned voffA[2], voffB[2];
#pragma unroll
    for (int i = 0; i < 2; ++i) { int R, C; stage_rc(tid * 16 + i * 8192, R, C); const int Rb = Epi::PERM ? ((R & ~31) + perm32(R & 31)) : R;
        voffA[i] = (unsigned)(R * lda + C) * 2u; voffB[i] = (unsigned)(Rb * K + C) * 2u; }
    const size_t kstep = (size_t)(BK * 2);
    const size_t hA = (size_t)HALF * lda * 2, hB = (size_t)HALF * K * 2;
    const size_t tA = g.atiled ? (size_t)26 * 131072 : 2 * hA, tB = 2 * hB;
    const int atiled = g.atiled;
#define PG8_AKOFF(t) (atiled ? ((size_t)((t) >> 2) * 131072 + (size_t)((t) & 3) * 128) : (size_t)(t) * kstep)
    const unsigned ldsw = (unsigned)wid * 1024u;
    const int aoff = lds_byte(wr * 64 + fr, fq * 8), boff = lds_byte(wc * 32 + fr, fq * 8);
#define PG8_SA(b, h) (((b) * 2 + (h)) * HTB)
#define PG8_SB(b, h) ((4 + (b) * 2 + (h)) * HTB)
#define PG8_STAGE(bufoff, gbase, voff) do { _Pragma("unroll") for (int _i = 0; _i < 2; ++_i) \
        __builtin_amdgcn_global_load_lds((const unsigned*)((const char*)(gbase) + (voff)[_i]), (LAS unsigned*)(lds + (bufoff) + ldsw + _i * 8192), 16, 0, 0); } while (0)
#define PG8_LDA(dst, b, h) do { _Pragma("unroll") for (int m = 0; m < 4; ++m) _Pragma("unroll") for (int k = 0; k < 2; ++k) dst[m][k] = *(const LAS bf16x8*)(lds + PG8_SA(b, h) + aoff + m * 2048 + k * 1024); } while (0)
#define PG8_LDB(dst, b, h) do { _Pragma("unroll") for (int n = 0; n < 2; ++n) _Pragma("unroll") for (int k = 0; k < 2; ++k) dst[n][k] = *(const LAS bf16x8*)(lds + PG8_SB(b, h) + boff + n * 2048 + k * 1024); } while (0)
#define PG8_MMA(ai, bj, At, Bt) do { __builtin_amdgcn_s_setprio(1); _Pragma("unroll") for (int m = 0; m < 4; ++m) _Pragma("unroll") for (int n = 0; n < 2; ++n) _Pragma("unroll") for (int k = 0; k < 2; ++k) \
        acc[ai][bj][m][n] = __builtin_amdgcn_mfma_f32_16x16x32_bf16(Bt[n][k], At[m][k], acc[ai][bj][m][n], 0, 0, 0); __builtin_amdgcn_s_setprio(0); } while (0)
#define PG8_WAIT_V(n) asm volatile("s_waitcnt vmcnt(" #n ")" ::: "memory")
#define PG8_WAIT_L(n) asm volatile("s_waitcnt lgkmcnt(" #n ")" ::: "memory")
#define PG8_BAR __builtin_amdgcn_s_barrier()
#define PG8_SCHED __builtin_amdgcn_sched_barrier(0)
    Unit cur, nxt; int ui = 0;
    if (!S.next(0, cur)) return;
    f32x4 acc[2][2][4][2];
#pragma unroll
    for (int a = 0; a < 2; ++a)
#pragma unroll
        for (int b = 0; b < 2; ++b)
#pragma unroll
            for (int m = 0; m < 4; ++m)
#pragma unroll
                for (int n = 0; n < 2; ++n) acc[a][b][m][n] = (f32x4){0.f, 0.f, 0.f, 0.f};
    bf16x8 At[4][2], B0[2][2], B1[2][2];
    const char* cA = (const char*)g.A + (size_t)cur.pm * tA; const char* cB = (const char*)g.Bt + (size_t)cur.pn * tB;
    PG8_STAGE(PG8_SB(0, 0), cB, voffB); PG8_STAGE(PG8_SB(0, 1), cB + hB, voffB); PG8_STAGE(PG8_SA(0, 0), cA, voffA); PG8_STAGE(PG8_SA(0, 1), cA + hA, voffA);
    if (wr == 1) PG8_BAR;
    PG8_WAIT_V(2); PG8_BAR;
    PG8_STAGE(PG8_SB(1, 0), cB + kstep, voffB); PG8_STAGE(PG8_SA(1, 0), cA + kstep, voffA); PG8_STAGE(PG8_SB(1, 1), cB + hB + kstep, voffB);
    PG8_WAIT_V(6); PG8_BAR;
    for (;;) {
        const bool has_next = S.next(ui + 1, nxt);
        const char* nA = has_next ? (const char*)g.A + (size_t)nxt.pm * tA : cA; const char* nB = has_next ? (const char*)g.Bt + (size_t)nxt.pn * tB : cB;
        const bool full = (Epi::SMALLTILE < 0) || (cur.pn != Epi::SMALLTILE);
        for (int t = 0; t < nt; t += 2) {
            const bool last = (t == nt - 2);
            const char* a1 = cA + PG8_AKOFF(t + 1);
            const char* a2 = last ? nA : cA + PG8_AKOFF(t + 2); const char* b2 = last ? nB : cB + (size_t)(t + 2) * kstep;
            const char* a3 = a2 + kstep; const char* b3 = b2 + kstep;
            PG8_LDB(B0, 0, 0); PG8_LDB(B1, 0, 1); PG8_SCHED; PG8_LDA(At, 0, 0); PG8_STAGE(PG8_SA(1, 1), a1 + hA, voffA);
            PG8_WAIT_V(8); PG8_WAIT_L(0); PG8_BAR; PG8_MMA(0, 0, At, B0); if (full) PG8_MMA(0, 1, At, B1); PG8_BAR; PG8_SCHED;
            PG8_LDA(At, 0, 1); PG8_STAGE(PG8_SB(0, 0), b2, voffB); PG8_STAGE(PG8_SB(0, 1), b2 + hB, voffB); PG8_STAGE(PG8_SA(0, 0), a2, voffA);
            PG8_WAIT_V(8); PG8_WAIT_L(0); PG8_BAR; PG8_MMA(1, 0, At, B0); if (full) PG8_MMA(1, 1, At, B1); PG8_BAR; PG8_SCHED;
            PG8_LDB(B0, 1, 0); PG8_LDB(B1, 1, 1); PG8_SCHED; PG8_LDA(At, 1, 0); PG8_STAGE(PG8_SA(0, 1), a2 + hA, voffA);
            PG8_WAIT_V(8); PG8_WAIT_L(0); PG8_BAR; PG8_MMA(0, 0, At, B0); if (full) PG8_MMA(0, 1, At, B1); PG8_BAR; PG8_SCHED;
            PG8_LDA(At, 1, 1); PG8_STAGE(PG8_SB(1, 0), b3, voffB); PG8_STAGE(PG8_SB(1, 1), b3 + hB, voffB); PG8_STAGE(PG8_SA(1, 0), a3, voffA);
            PG8_WAIT_V(8); PG8_WAIT_L(0); PG8_BAR; PG8_MMA(1, 0, At, B0); if (full) PG8_MMA(1, 1, At, B1); PG8_BAR; PG8_SCHED;
        }
        if (wr == 0) PG8_BAR;
        E(acc, cur, wr, wc, fr, fq);
        if (!has_next) break;
#pragma unroll
        for (int a = 0; a < 2; ++a)
#pragma unroll
            for (int b = 0; b < 2; ++b)
#pragma unroll
                for (int m = 0; m < 4; ++m)
#pragma unroll
                    for (int n = 0; n < 2; ++n) acc[a][b][m][n] = (f32x4){0.f, 0.f, 0.f, 0.f};
        cur = nxt; cA = nA; cB = nB; ++ui;
        if (wr == 1) PG8_BAR;
    }
    PG8_WAIT_V(0);
    PG8_BAR;
#undef PG8_SA
#undef PG8_AKOFF
#undef PG8_SB
#undef PG8_STAGE
#undef PG8_LDA
#undef PG8_LDB
#undef PG8_MMA
#undef PG8_WAIT_V
#undef PG8_WAIT_L
#undef PG8_BAR
#undef PG8_SCHED
}
}

struct EpiProj {
    static constexpr bool PERM = true;
    static constexpr int SMALLTILE = 26;
    bf16_t* proj; float* small; bf16_t* halo;
    DI void operator()(const f32x4 (&acc)[2][2][4][2], const pg8::Unit& u, int wr, int wc, int fr, int fq) const {
        const int row0 = u.pm * 256 + wr * 64 + fr;
        if (u.pn < 26) {
            const int col0 = u.pn * 256 + wc * 32 + 8 * fq;
            const bool conv = (u.pn >= 8 && u.pn < 20);
#pragma unroll
            for (int ai = 0; ai < 2; ++ai)
#pragma unroll
                for (int m = 0; m < 4; ++m) {
                    const int row = row0 + ai * 128 + m * 16;
                    bf16_t* rowp = proj + pidx((size_t)row, col0);
#pragma unroll
                    for (int bj = 0; bj < 2; ++bj) {
                        const f32x4 v0 = acc[ai][bj][m][0], v1 = acc[ai][bj][m][1];
                        u32x4 w; w.x = pk_bf16(v0[0], v0[1]); w.y = pk_bf16(v0[2], v0[3]); w.z = pk_bf16(v1[0], v1[1]); w.w = pk_bf16(v1[2], v1[3]);
                        *(u32x4*)(rowp + bj * 128) = w;
                        if (m == 3 && conv && fr >= 13)
                            *(u32x4*)(halo + ((size_t)(row >> 6) * 3 + (fr - 13)) * 3072 + (col0 + bj * 128 - 2048)) = w;
                    }
                }
        } else if (wc == 0) {
#pragma unroll
            for (int ai = 0; ai < 2; ++ai)
#pragma unroll
                for (int m = 0; m < 4; ++m) {
                    const int row = row0 + ai * 128 + m * 16;
                    float* pp = small + (size_t)row * 32 + 8 * fq;
                    *(f32x4*)pp = acc[ai][0][m][0]; *(f32x4*)(pp + 4) = acc[ai][0][m][1];
                }
        }
    }
};
struct EpiOut {
    static constexpr bool PERM = true;
    static constexpr int SMALLTILE = -1;
    bf16_t* O;
    DI void operator()(const f32x4 (&acc)[2][2][4][2], const pg8::Unit& u, int wr, int wc, int fr, int fq) const {
        const int row0 = u.pm * 256 + wr * 64 + fr, col0 = u.pn * 256 + wc * 32 + 8 * fq;
#pragma unroll
        for (int ai = 0; ai < 2; ++ai)
#pragma unroll
            for (int m = 0; m < 4; ++m) {
                bf16_t* rowp = O + pidx((size_t)(row0 + ai * 128 + m * 16), 2048 + col0);
#pragma unroll
                for (int bj = 0; bj < 2; ++bj) {
                    const f32x4 v0 = acc[ai][bj][m][0], v1 = acc[ai][bj][m][1];
                    u32x4 w; w.x = pk_bf16(v0[0], v0[1]); w.y = pk_bf16(v0[2], v0[3]); w.z = pk_bf16(v1[0], v1[1]); w.w = pk_bf16(v1[2], v1[3]);
                    *(u32x4*)(rowp + bj * 128) = w;
                }
            }
    }
};

template <int KSTEPS>
DI f32x4 mma_tile(f32x4 acc, const LAS bf16_t* A, int lda, const LAS bf16_t* B, int ldb, int r, int q) {
#pragma unroll
    for (int k = 0; k < KSTEPS; ++k) {
        const bf16x8 a = *(const LAS bf16x8*)(A + r * lda + k * 32 + q * 8);
        const bf16x8 b = *(const LAS bf16x8*)(B + r * ldb + k * 32 + q * 8);
        acc = __builtin_amdgcn_mfma_f32_16x16x32_bf16(a, b, acc, 0, 0, 0);
    }
    return acc;
}

template <int KS> DI void ldfrag(bf16x8 (&f)[KS], const LAS bf16_t* base, int ld, int r, int q) {
#pragma unroll
    for (int k = 0; k < KS; ++k) f[k] = *(const LAS bf16x8*)(base + r * ld + k * 32 + q * 8);
}
template <int KS> DI f32x4 mmafrag(f32x4 acc, const bf16x8 (&a)[KS], const bf16x8 (&b)[KS]) {
#pragma unroll
    for (int k = 0; k < KS; ++k) acc = __builtin_amdgcn_mfma_f32_16x16x32_bf16(a[k], b[k], acc, 0, 0, 0);
    return acc;
}

DI int orig_col(int n) {
    if (n < 512) return 1536 + n;
    if (n < 1536) return 3592 + (n - 512);
    if (n < 2048) return 6168 + (n - 1536);
    if (n < 3584) return n - 2048;
    if (n < 5120) return 2056 + (n - 3584);
    if (n < 6656) return 4632 + (n - 5120);
    if (n < 6664) return 2048 + (n - 6656);
    if (n < 6680) return 4616 + (n - 6664);
    return -1;
}
__device__ void phase_convert(const P& p) {
    bf16_t* WinT = (bf16_t*)(p.ws + WS_WIN); bf16_t* WoutT = (bf16_t*)(p.ws + WS_WOUT);
    const size_t gsz = (size_t)gridDim.x * blockDim.x, g0 = (size_t)blockIdx.x * blockDim.x + opaque_tid();
    const size_t n1 = (size_t)2 * 128 * NPW;
    for (size_t i = g0; i < n1; i += gsz) {
        const int n = (int)(i % NPW); const int k8 = (int)((i / NPW) % 128); const int l = (int)(i / ((size_t)NPW * 128));
        const int oc = orig_col(n);
        float v[8];
#pragma unroll
        for (int e = 0; e < 8; ++e) v[e] = oc >= 0 ? p.w_in[((size_t)l * 1024 + k8 * 8 + e) * NIN + oc] : 0.f;
        u32x4 w; w.x = pk_bf16(v[0], v[1]); w.y = pk_bf16(v[2], v[3]); w.z = pk_bf16(v[4], v[5]); w.w = pk_bf16(v[6], v[7]);
        *(u32x4*)(WinT + ((size_t)l * NPW + n) * 1024 + k8 * 8) = w;
    }
    const size_t n2 = (size_t)2 * 256 * 1024;
    for (size_t i = g0; i < n2; i += gsz) {
        const int n = (int)(i % 1024); const int k8 = (int)((i / 1024) % 256); const int l = (int)(i / (1024 * 256));
        float v[8];
#pragma unroll
        for (int e = 0; e < 8; ++e) v[e] = p.w_out[((size_t)l * 2048 + k8 * 8 + e) * 1024 + n];
        u32x4 w; w.x = pk_bf16(v[0], v[1]); w.y = pk_bf16(v[2], v[3]); w.z = pk_bf16(v[4], v[5]); w.w = pk_bf16(v[6], v[7]);
        *(u32x4*)(WoutT + ((size_t)l * 1024 + n) * 2048 + k8 * 8) = w;
    }
}
__device__ void phase_rows(const float* xin, const bf16_t* o, int ldo, const float* post, float* xout, const float* pre, bf16_t* h) {
    const int tid_ = opaque_tid(); const int lane = tid_ & 63, wv = tid_ >> 6;
    const int stride = gridDim.x * 8;
    f32x4 xn[4]; u32x2 on[4];
#define R_LOAD(rr) do { _Pragma("unroll") for (int j = 0; j < 4; ++j) { xn[j] = __builtin_nontemporal_load((const f32x4*)(xin + (size_t)(rr) * DM + j * 256 + lane * 4)); \
        if (o) on[j] = __builtin_nontemporal_load((const u32x2*)(o + pidx((size_t)(rr), 2048 + j * 256 + lane * 4))); } } while (0)
    int row = blockIdx.x * 8 + wv;
#pragma unroll
    for (int j = 0; j < 4; ++j) on[j] = (u32x2){0u, 0u};
    if (row < T_TOK) R_LOAD(row);
    for (; row < T_TOK; row += stride) {
        f32x4 xv[4]; u32x2 ow[4];
#pragma unroll
        for (int j = 0; j < 4; ++j) { xv[j] = xn[j]; ow[j] = on[j]; }
        if (row + stride < T_TOK) R_LOAD(row + stride);
        if (o) {
            f32x4 ov[4]; float ss = 0.f;
#pragma unroll
            for (int j = 0; j < 4; ++j) { ov[j] = (f32x4){bf_lo(ow[j].x), bf_hi(ow[j].x), bf_lo(ow[j].y), bf_hi(ow[j].y)}; ss += ov[j][0] * ov[j][0] + ov[j][1] * ov[j][1] + ov[j][2] * ov[j][2] + ov[j][3] * ov[j][3]; }
#pragma unroll
            for (int s = 1; s < 64; s <<= 1) ss += __shfl_xor(ss, s);
            const float rs = rsqrtf(ss * (1.0f / DM) + EPS);
#pragma unroll
            for (int j = 0; j < 4; ++j) { const f32x4 pw = *(const f32x4*)(post + j * 256 + lane * 4); xv[j] += ov[j] * rs * pw;
                *(f32x4*)(xout + (size_t)row * DM + j * 256 + lane * 4) = xv[j]; }
        }
        if (pre) {
            float ss = 0.f;
#pragma unroll
            for (int j = 0; j < 4; ++j) ss += xv[j][0] * xv[j][0] + xv[j][1] * xv[j][1] + xv[j][2] * xv[j][2] + xv[j][3] * xv[j][3];
#pragma unroll
            for (int s = 1; s < 64; s <<= 1) ss += __shfl_xor(ss, s);
            const float rs = rsqrtf(ss * (1.0f / DM) + EPS);
#pragma unroll
            for (int j = 0; j < 4; ++j) { const f32x4 pw = *(const f32x4*)(pre + j * 256 + lane * 4); const f32x4 hv = xv[j] * rs * pw;
                u32x2 w; w.x = pk_bf16(hv[0], hv[1]); w.y = pk_bf16(hv[2], hv[3]); *(u32x2*)(h + (size_t)row * DM + j * 256 + lane * 4) = w; }
        }
    }
#undef R_LOAD
}

__device__ void phaseB_gdn(LAS unsigned char* lds, const P& p, int layer, int chunkg, int h) {
    const int tid = opaque_tid(), lane = tid & 63, wid = tid >> 6, r = lane & 15, q = lane >> 4;
    const int c = chunkg & 127;
    const size_t t0 = (size_t)chunkg * 64;
    bf16_t* proj = (bf16_t*)(p.ws + WS_PROJ); const bf16_t* halo = (const bf16_t*)(p.ws + WS_HALO);
    const float* small = (const float*)(p.ws + WS_SMALL);
    LAS bf16_t* kb = (LAS bf16_t*)lds;
    LAS float* rhs = (LAS float*)(lds + 17408);
    LAS float* Am = (LAS float*)(lds + 17408 + 65536);
    LAS float* gS = (LAS float*)(lds + 17408 + 65536 + 16384);
    const float* cw = p.gdn_conv + (size_t)layer * 4 * 1536;
    LAS float* cwS = (LAS float*)(lds + 17408 + 65536 + 16384 + 512);
    float braw = 0.f, araw = 0.f;
    if (wid == 0) { braw = small[(t0 + lane) * 32 + h]; araw = small[(t0 + lane) * 32 + 4 + h]; }
    float wl[3];
#pragma unroll
    for (int k = 0; k < 3; ++k) { const int rem = tid; wl[k] = cw[(rem >> 7) * 1536 + k * 512 + h * 128 + (rem & 127)]; }
    u32x4 xr[3][2][4];
#pragma unroll
    for (int s = 0; s < 3; ++s)
#pragma unroll
        for (int pass = 0; pass < 2; ++pass) {
            const int tok = pass * 32 + (tid >> 4), seg = tid & 15, col = C_GQ + s * 512 + h * 128 + seg * 8;
#pragma unroll
            for (int d = 0; d < 4; ++d) {
                const int tt = tok - 3 + d;
                u32x4 v = (u32x4){0u, 0u, 0u, 0u};
                if (tt >= 0) v = *(const u32x4*)(proj + pidx(t0 + tt, col));
                else if (c > 0) v = *(const u32x4*)(halo + ((size_t)(chunkg - 1) * 3 + (tt + 3)) * 3072 + (col - 2048));
                xr[s][pass][d] = v;
            }
        }
#pragma unroll
    for (int k = 0; k < 3; ++k) cwS[k * 512 + tid] = wl[k];
    if (wid == 0) {
        const float beta = 1.0f / (1.0f + __expf(-braw));
        const float g = -__expf(p.gdn_A_log[layer * 4 + h]) * softplusf(araw + p.gdn_dt_bias[layer * 4 + h]);
        const float gc = wave_scan_incl(g, lane);
        gS[lane] = gc; gS[64 + lane] = beta;
        ((float*)(p.ws + WS_GCUM))[(t0 + lane) * 4 + h] = gc;
    }
    __syncthreads();
    u32x4 qpk[2];
#pragma unroll
    for (int s = 0; s < 3; ++s) {
#pragma unroll
        for (int pass = 0; pass < 2; ++pass) {
            const int tok = pass * 32 + (tid >> 4), seg = tid & 15;
            f32x2 v2[4];
#pragma unroll
            for (int k = 0; k < 4; ++k) v2[k] = (f32x2){0.f, 0.f};
#pragma unroll
            for (int d = 0; d < 4; ++d) {
                f32x2 x2[4]; unpack8(xr[s][pass][d], x2);
                const f32x4 w0 = *(const LAS f32x4*)(cwS + s * 512 + d * 128 + seg * 8), w1 = *(const LAS f32x4*)(cwS + s * 512 + d * 128 + seg * 8 + 4);
                v2[0] = __builtin_elementwise_fma((f32x2){w0[0], w0[1]}, x2[0], v2[0]); v2[1] = __builtin_elementwise_fma((f32x2){w0[2], w0[3]}, x2[1], v2[1]);
                v2[2] = __builtin_elementwise_fma((f32x2){w1[0], w1[1]}, x2[2], v2[2]); v2[3] = __builtin_elementwise_fma((f32x2){w1[2], w1[3]}, x2[3], v2[3]);
            }
            f32x2 ss2 = (f32x2){0.f, 0.f};
#pragma unroll
            for (int k = 0; k < 4; ++k) { v2[k] = silu2(v2[k]); ss2 = __builtin_elementwise_fma(v2[k], v2[k], ss2); }
            float ss = ss2[0] + ss2[1];
            if (s < 2) {
                ss += __shfl_xor(ss, 1); ss += __shfl_xor(ss, 2); ss += __shfl_xor(ss, 4); ss += __shfl_xor(ss, 8);
                const float rn = rsqrtf(ss + EPS) * (s == 0 ? 0.08838834764831845f : 1.0f);
#pragma unroll
                for (int k = 0; k < 4; ++k) v2[k] *= rn;
            }
            const float val[8] = {v2[0][0], v2[0][1], v2[1][0], v2[1][1], v2[2][0], v2[2][1], v2[3][0], v2[3][1]};
            if (s == 0) {
                u32x4 w; w.x = pk_bf16(val[0], val[1]); w.y = pk_bf16(val[2], val[3]); w.z = pk_bf16(val[4], val[5]); w.w = pk_bf16(val[6], val[7]);
                qpk[pass] = w;
            } else if (s == 1) {
                u32x4 w; w.x = pk_bf16(val[0], val[1]); w.y = pk_bf16(val[2], val[3]); w.z = pk_bf16(val[4], val[5]); w.w = pk_bf16(val[6], val[7]);
                *(LAS u32x4*)(kb + tok * 136 + seg * 8) = w;
                const float f = gS[64 + tok] * __expf(gS[tok]);
                *(LAS f32x4*)(rhs + tok * 256 + 128 + seg * 8) = (f32x4){f * val[0], f * val[1], f * val[2], f * val[3]};
                *(LAS f32x4*)(rhs + tok * 256 + 128 + seg * 8 + 4) = (f32x4){f * val[4], f * val[5], f * val[6], f * val[7]};
            } else {
                const float f = gS[64 + tok];
                *(LAS f32x4*)(rhs + tok * 256 + seg * 8) = (f32x4){f * val[0], f * val[1], f * val[2], f * val[3]};
                *(LAS f32x4*)(rhs + tok * 256 + seg * 8 + 4) = (f32x4){f * val[4], f * val[5], f * val[6], f * val[7]};
            }
        }
    }
    __syncthreads();
#pragma unroll
    for (int pass = 0; pass < 2; ++pass) {
        const int item = pass * 512 + tid, tok = item >> 4, seg = item & 15;
        *(u32x4*)(proj + pidx(t0 + tok, C_GQ + h * 128 + seg * 8)) = qpk[pass];
    }
#pragma unroll
    for (int tt = 0; tt < 2; ++tt) {
        const int id = wid * 2 + tt, mt = id >> 2, nt = id & 3;
        f32x4 acc = (f32x4){0.f, 0.f, 0.f, 0.f};
        acc = mma_tile<4>(acc, kb + mt * 16 * 136, 136, kb + nt * 16 * 136, 136, r, q);
        const int j = nt * 16 + r; const float gj = gS[j];
        f32x4 av;
#pragma unroll
        for (int jj = 0; jj < 4; ++jj) {
            const int i = mt * 16 + q * 4 + jj;
            av[jj] = (j < i) ? -(gS[64 + i] * acc[jj] * __expf(gS[i] - gj)) : 0.f;
        }
        *(LAS f32x4*)(Am + j * 64 + mt * 16 + q * 4) = av;
    }
    __syncthreads();
    if (tid < 256) {
        float xs[64];
        int zoff; asm volatile("v_mov_b32 %0, 0" : "=v"(zoff));
        const LAS float* Az = Am + zoff;
        {
            f32x2 x2[32];
#pragma unroll
            for (int k = 0; k < 32; ++k) x2[k] = (f32x2){rhs[(2 * k) * 256 + tid], rhs[(2 * k + 1) * 256 + tid]};
            f32x4 an[16], ac[16];
#pragma unroll
            for (int k = 0; k < 16; ++k) an[k] = *(const LAS f32x4*)(Az + 4 * k);
#pragma unroll
            for (int j = 0; j < 63; ++j) {
#pragma unroll
                for (int k = 0; k < 16; ++k) ac[k] = an[k];
                if (j + 1 < 63) {
#pragma unroll
                    for (int k = (j + 2) / 4; k < 16; ++k) an[k] = *(const LAS f32x4*)(Az + (j + 1) * 64 + 4 * k);
                }
                __builtin_amdgcn_sched_barrier(0);
                const float xj = x2[j >> 1][j & 1];
                const f32x2 xj2 = (f32x2){xj, xj};
#pragma unroll
                for (int k = (j + 1) >> 1; k < 32; ++k) {
                    const f32x2 a2 = (k & 1) ? (f32x2){ac[k >> 1][2], ac[k >> 1][3]} : (f32x2){ac[k >> 1][0], ac[k >> 1][1]};
                    x2[k] = __builtin_elementwise_fma(a2, xj2, x2[k]);
                }
                __builtin_amdgcn_sched_barrier(0);
            }
#pragma unroll
            for (int k = 0; k < 32; ++k) { xs[2 * k] = x2[k][0]; xs[2 * k + 1] = x2[k][1]; }
        }
        if (tid < 128) {
            const int e = tid >> 6, dvl = tid & 63;
            bf16_t* dst = proj + pidx(t0 + dvl, C_GV + h * 128 + e * 64);
#pragma unroll
            for (int k = 0; k < 8; ++k) {
                u32x4 w; w.x = pk_bf16(xs[8 * k], xs[8 * k + 1]); w.y = pk_bf16(xs[8 * k + 2], xs[8 * k + 3]); w.z = pk_bf16(xs[8 * k + 4], xs[8 * k + 5]); w.w = pk_bf16(xs[8 * k + 6], xs[8 * k + 7]);
                *(u32x4*)(dst + 8 * k) = w;
            }
        } else {
            bf16_t* wb = (bf16_t*)(p.ws + WS_WBUF) + t0 * 512 + h * 128 + (tid - 128);
#pragma unroll
            for (int i = 0; i < 64; ++i) wb[(size_t)i * 512] = (bf16_t)(pk_bf16(xs[i], 0.f) & 0xffffu);
        }
    }
#pragma unroll
    for (int pass = 0; pass < 2; ++pass) {
        const int item = pass * 512 + tid, tok = item >> 4, seg = item & 15;
        *(u32x4*)(proj + pidx(t0 + tok, C_GK + h * 128 + seg * 8)) = *(const LAS u32x4*)(kb + tok * 136 + seg * 8);
    }
    __syncthreads();
}
__device__ void phaseB_ssd(const P& p, int layer, int chunkg) {
    const int tid = opaque_tid(), lane = tid & 63, wid = tid >> 6;
    const int c = chunkg & 127;
    const size_t t0 = (size_t)chunkg * 64;
    bf16_t* proj = (bf16_t*)(p.ws + WS_PROJ); const bf16_t* halo = (const bf16_t*)(p.ws + WS_HALO);
    const float* small = (const float*)(p.ws + WS_SMALL);
#pragma unroll
    for (int k = 0; k < 2; ++k) {
        const int hd = wid * 2 + k;
        const float dt = softplusf(small[(t0 + lane) * 32 + 8 + hd] + p.ssd_dt_bias[layer * 16 + hd]);
        const float a = -__expf(p.ssd_A_log[layer * 16 + hd]) * dt;
        const float ac = wave_scan_incl(a, lane);
        { ((float*)(p.ws + WS_DT))[(t0 + lane) * 16 + hd] = dt;
        ((float*)(p.ws + WS_ACUM))[(t0 + lane) * 16 + hd] = ac; }
    }
    const int seg = tid % 192, half = tid / 192;
    const int col = C_SX + seg * 8, ch = seg * 8;
    const bool act = tid < 384;
    u32x4 win[3];
    win[0] = win[1] = win[2] = (u32x4){0u, 0u, 0u, 0u};
    u32x4 rows[32];
    f32x2 wg2[4][4], bias2[4];
    if (act) {
        if (half == 1) {
#pragma unroll
            for (int d = 0; d < 3; ++d) win[d] = *(const u32x4*)(proj + pidx(t0 + 29 + d, col));
        } else if (c > 0) {
#pragma unroll
            for (int d = 0; d < 3; ++d) win[d] = *(const u32x4*)(halo + ((size_t)(chunkg - 1) * 3 + d) * 3072 + (col - 2048));
        }
#pragma unroll
        for (int k = 0; k < 32; ++k) rows[k] = *(const u32x4*)(proj + pidx(t0 + half * 32 + k, col));
        const float* cw = p.ssd_conv + (size_t)layer * 4 * 1536; const float* cb = p.ssd_conv_b + (size_t)layer * 1536;
#pragma unroll
        for (int d = 0; d < 4; ++d) {
            const f32x4 a = *(const f32x4*)(cw + d * 1536 + ch), bq = *(const f32x4*)(cw + d * 1536 + ch + 4);
            wg2[d][0] = (f32x2){a[0], a[1]}; wg2[d][1] = (f32x2){a[2], a[3]}; wg2[d][2] = (f32x2){bq[0], bq[1]}; wg2[d][3] = (f32x2){bq[2], bq[3]};
        }
        { const f32x4 a = *(const f32x4*)(cb + ch), bq = *(const f32x4*)(cb + ch + 4);
          bias2[0] = (f32x2){a[0], a[1]}; bias2[1] = (f32x2){a[2], a[3]}; bias2[2] = (f32x2){bq[0], bq[1]}; bias2[3] = (f32x2){bq[2], bq[3]}; }
    }
    __syncthreads();
    if (act) {
        f32x2 w0[4], w1[4], w2[4];
        unpack8(win[0], w0); unpack8(win[1], w1); unpack8(win[2], w2);
#pragma unroll
        for (int k = 0; k < 32; ++k) {
            f32x2 x3[4]; unpack8(rows[k], x3);
            f32x2 v2[4];
#pragma unroll
            for (int e = 0; e < 4; ++e) {
                f32x2 a = __builtin_elementwise_fma(wg2[0][e], w0[e], bias2[e]);
                a = __builtin_elementwise_fma(wg2[1][e], w1[e], a);
                a = __builtin_elementwise_fma(wg2[2][e], w2[e], a);
                a = __builtin_elementwise_fma(wg2[3][e], x3[e], a);
                v2[e] = silu2(a);
                w0[e] = w1[e]; w1[e] = w2[e]; w2[e] = x3[e];
            }
            u32x4 w; w.x = pk_bf16(v2[0][0], v2[0][1]); w.y = pk_bf16(v2[1][0], v2[1][1]); w.z = pk_bf16(v2[2][0], v2[2][1]); w.w = pk_bf16(v2[3][0], v2[3][1]);
            *(u32x4*)(proj + pidx(t0 + half * 32 + k, col)) = w;
        }
    }
}
__device__ void phaseB_ret(const P& p, int chunkg) {
    const int tid = opaque_tid();
    const int c = chunkg & 127;
    const size_t t0 = (size_t)chunkg * 64;
    bf16_t* proj = (bf16_t*)(p.ws + WS_PROJ);
    const int tok = tid >> 3, pg = tid & 7;
    const float pos = (float)(c * 64 + tok);
    float cs[8], sn[8];
#pragma unroll
    for (int e = 0; e < 8; ++e) {
        const float inv = exp2f(-(float)(pg * 8 + e) * (13.287712379549449f / 64.0f));
        const float ang = pos * inv;
        const float n = rintf(ang * 0.15915494309189535f);
        float rr = fmaf(-n, 6.28125f, ang); rr = fmaf(-n, 0.0019353071795864769f, rr);
        cs[e] = __cosf(rr); sn[e] = __sinf(rr);
    }
    u32x4 ra[4][2], rb[4][2];
#pragma unroll
    for (int hh = 0; hh < 4; ++hh)
#pragma unroll
        for (int s = 0; s < 2; ++s) {
            const bf16_t* base = proj + pidx(t0 + tok, (s == 0 ? C_RQ : C_RK) + hh * 128 + pg * 8);
            ra[hh][s] = *(const u32x4*)base; rb[hh][s] = *(const u32x4*)(base + 64);
        }
#pragma unroll
    for (int hh = 0; hh < 4; ++hh)
#pragma unroll
        for (int s = 0; s < 2; ++s) {
            bf16_t* base = proj + pidx(t0 + tok, (s == 0 ? C_RQ : C_RK) + hh * 128 + pg * 8);
            const float sc = s == 0 ? 1.0f : 0.08838834764831845f;
            const u32x4 a = ra[hh][s], b = rb[hh][s];
            const float t1[8] = {bf_lo(a.x), bf_hi(a.x), bf_lo(a.y), bf_hi(a.y), bf_lo(a.z), bf_hi(a.z), bf_lo(a.w), bf_hi(a.w)};
            const float t2[8] = {bf_lo(b.x), bf_hi(b.x), bf_lo(b.y), bf_hi(b.y), bf_lo(b.z), bf_hi(b.z), bf_lo(b.w), bf_hi(b.w)};
            float o1[8], o2[8];
#pragma unroll
            for (int e = 0; e < 8; ++e) { o1[e] = (t1[e] * cs[e] - t2[e] * sn[e]) * sc; o2[e] = (t1[e] * sn[e] + t2[e] * cs[e]) * sc; }
            u32x4 w1, w2;
            w1.x = pk_bf16(o1[0], o1[1]); w1.y = pk_bf16(o1[2], o1[3]); w1.z = pk_bf16(o1[4], o1[5]); w1.w = pk_bf16(o1[6], o1[7]);
            w2.x = pk_bf16(o2[0], o2[1]); w2.y = pk_bf16(o2[2], o2[3]); w2.z = pk_bf16(o2[4], o2[5]); w2.w = pk_bf16(o2[6], o2[7]);
            { *(u32x4*)base = w1; *(u32x4*)(base + 64) = w2; }
        }
}

constexpr int L_QS = 0, L_KS = 17408, L_WS = 34816, L_ST = 52224, L_VT = 69632, L_VST = 78848, L_AT = 88064, L_UT = 97280, L_CUM = 106496, L_DT = 106752;
constexpr int L_ALT = 107008;
constexpr int D_KS = L_ALT - L_KS, D_ST = L_ALT + 17408 - L_ST, D_VT = L_ALT + 34816 - L_VT, D_VST = L_ALT + 44032 - L_VST, D_CUM = L_ALT + 53248 - L_CUM;
typedef short s16x4 __attribute__((ext_vector_type(4)));
DI bf16x8 ldfrag_tr(const LAS bf16_t* X, int ld, int k0, int m0, int r, int q) {
    const LAS bf16_t* a = X + (k0 + q * 8 + (r >> 2)) * ld + m0 + 4 * (r & 3);
    const s16x4 lo = __builtin_amdgcn_ds_read_tr16_b64_v4i16((LAS s16x4*)a);
    const s16x4 hi = __builtin_amdgcn_ds_read_tr16_b64_v4i16((LAS s16x4*)(a + 4 * ld));
    return __builtin_shufflevector(lo, hi, 0, 1, 2, 3, 4, 5, 6, 7);
}
template <int KIND>
__device__ void phaseC_item(LAS unsigned char* lds, const P& p, int layer, int sub) {
    const int tid = opaque_tid(), lane = tid & 63, wid = __builtin_amdgcn_readfirstlane(tid >> 6), r = lane & 15, q = lane >> 4;
    bf16_t* proj = (bf16_t*)(p.ws + WS_PROJ);
    int b, qcol, kcol, vcol, hidx; float Dval = 0.f, lg = 0.f;
    if (KIND == 0) { b = sub >> 3; const int h = (sub >> 1) & 3, e = sub & 1; hidx = h; qcol = C_GQ + h * 128; kcol = C_GK + h * 128; vcol = C_GV + h * 128 + e * 64; }
    else if (KIND == 1) { b = sub >> 4; const int hd = sub & 15, grp = hd >> 3; hidx = hd; qcol = C_SC + grp * 128; kcol = C_SB + grp * 128; vcol = C_SX + hd * 64; Dval = p.ssd_D[layer * 16 + hd]; }
    else { b = sub >> 3; const int h = (sub >> 1) & 3, e = sub & 1; hidx = h; qcol = C_RQ + h * 128; kcol = C_RK + h * 128; vcol = C_RV + h * 128 + e * 64; lg = logf(1.0f - exp2f(-5.0f - (float)h)); }
    LAS bf16_t* Qs = (LAS bf16_t*)(lds + L_QS); LAS bf16_t* Ws = (LAS bf16_t*)(lds + L_WS);
    LAS bf16_t* AT = (LAS bf16_t*)(lds + L_AT); LAS bf16_t* UT = (LAS bf16_t*)(lds + L_UT);
    const bf16_t* Wbuf = (const bf16_t*)(p.ws + WS_WBUF);
    const float* gate = KIND == 0 ? (const float*)(p.ws + WS_GCUM) : (const float*)(p.ws + WS_ACUM);
    const float* gdt = (const float*)(p.ws + WS_DT);
    const int gstride = KIND == 0 ? 4 : 16;
    for (int i = tid; i < 17408 / 16; i += 512) *(LAS u32x4*)(lds + L_ST + i * 16) = (u32x4){0u, 0u, 0u, 0u};
    f32x4 Sacc[4];
#pragma unroll
    for (int n = 0; n < 4; ++n) Sacc[n] = (f32x4){0.f, 0.f, 0.f, 0.f};
    u32x4 pq[2], pk[2], pw[2], pv; float pcum = 0.f, pcl = 0.f, pdt = 1.f, pcum2 = 0.f, pdt2 = 1.f;
    const int mt = wid >> 1, nt0 = (wid & 1) * 2;
    u32x2 pz0 = (u32x2){0u, 0u}, pz1 = pz0, cz0 = pz0, cz1 = pz0;
    const int zcol = C_SZ + (vcol - C_SX);
    const int mytok = tid & 63, vtok = tid >> 3, vseg = tid & 7;
#define PREFETCH(cc) do { const size_t t0_ = ((size_t)b * NCHUNK + (cc)) * 64; \
        _Pragma("unroll") for (int it = 0; it < 2; ++it) { const int pp = tid + 512 * it; \
            pq[it] = *(const u32x4*)(proj + pidx(t0_ + (pp >> 4), qcol + (pp & 15) * 8)); \
            pk[it] = *(const u32x4*)(proj + pidx(t0_ + (pp >> 4), kcol + (pp & 15) * 8)); \
            if (KIND == 0) pw[it] = *(const u32x4*)(Wbuf + (t0_ + (pp >> 4)) * 512 + hidx * 128 + (pp & 15) * 8); } \
        pv = *(const u32x4*)(proj + pidx(t0_ + vtok, vcol + vseg * 8)); \
        if (KIND != 2) { pcum = gate[(t0_ + mytok) * gstride + hidx]; pcl = gate[(t0_ + 63) * gstride + hidx]; } \
        else { pcum = (float)(mytok + 1) * lg; pcl = 64.0f * lg; } \
        if (KIND == 1) { pdt = gdt[(t0_ + mytok) * 16 + hidx]; pdt2 = gdt[(t0_ + vtok) * 16 + hidx]; pcum2 = gate[(t0_ + vtok) * gstride + hidx]; } \
        if (KIND == 2) pcum2 = (float)(vtok + 1) * lg; \
        if (KIND == 1) { pz0 = *(const u32x2*)(proj + pidx(t0_ + nt0 * 16 + r, zcol + mt * 16 + q * 4)); pz1 = *(const u32x2*)(proj + pidx(t0_ + (nt0 + 1) * 16 + r, zcol + mt * 16 + q * 4)); } } while (0)
    PREFETCH(0);
    u32x2 ow0 = (u32x2){0u, 0u}, ow1 = ow0;
    for (int c = 0; c < NCHUNK; ++c) {
        const size_t t0 = ((size_t)b * NCHUNK + c) * 64;
        const int par = c & 1;
        LAS bf16_t* Ks = (LAS bf16_t*)(lds + L_KS + par * D_KS); LAS bf16_t* ST = (LAS bf16_t*)(lds + L_ST + par * D_ST); LAS bf16_t* STn = (LAS bf16_t*)(lds + L_ST + (par ^ 1) * D_ST);
        LAS bf16_t* VT = (LAS bf16_t*)(lds + L_VT + par * D_VT);
        LAS bf16_t* VST = (LAS bf16_t*)(lds + L_VST + par * D_VST);
        LAS float* cumS = (LAS float*)(lds + L_CUM + par * D_CUM); LAS float* dtS = cumS + 64;
#pragma unroll
        for (int it = 0; it < 2; ++it) {
            const int pp = tid + 512 * it;
            *(LAS u32x4*)(Qs + (pp >> 4) * 136 + (pp & 15) * 8) = pq[it];
            *(LAS u32x4*)(Ks + (pp >> 4) * 136 + (pp & 15) * 8) = pk[it];
            if (KIND == 0) *(LAS u32x4*)(Ws + (pp >> 4) * 136 + (pp & 15) * 8) = pw[it];
        }
        if (KIND == 0) {
            *(LAS u32x4*)(UT + vtok * 72 + vseg * 8) = pv;
        } else {
            const float sa = KIND == 1 ? pdt2 : 1.0f, sb = sa * __expf(pcl - pcum2);
            const float v0 = bf_lo(pv.x), v1 = bf_hi(pv.x), v2 = bf_lo(pv.y), v3 = bf_hi(pv.y), v4 = bf_lo(pv.z), v5 = bf_hi(pv.z), v6 = bf_lo(pv.w), v7 = bf_hi(pv.w);
            u32x4 wa = pv;
            if (KIND == 1) { wa.x = pk_bf16(v0 * sa, v1 * sa); wa.y = pk_bf16(v2 * sa, v3 * sa); wa.z = pk_bf16(v4 * sa, v5 * sa); wa.w = pk_bf16(v6 * sa, v7 * sa); }
            u32x4 wb; wb.x = pk_bf16(v0 * sb, v1 * sb); wb.y = pk_bf16(v2 * sb, v3 * sb); wb.z = pk_bf16(v4 * sb, v5 * sb); wb.w = pk_bf16(v6 * sb, v7 * sb);
            *(LAS u32x4*)(VT + vtok * 72 + vseg * 8) = wa;
            *(LAS u32x4*)(VST + vtok * 72 + vseg * 8) = wb;
        }
        if (tid < 64) { cumS[tid] = pcum; if (KIND == 1) dtS[tid] = pdt; }
        if (KIND == 1) { cz0 = pz0; cz1 = pz1; }
        if (c > 0) {
            *(u32x2*)(proj + pidx(t0 - 64 + nt0 * 16 + r, vcol + mt * 16 + q * 4)) = ow0;
            *(u32x2*)(proj + pidx(t0 - 64 + (nt0 + 1) * 16 + r, vcol + mt * 16 + q * 4)) = ow1;
        }
        __syncthreads();
        if (c + 1 < NCHUNK) PREFETCH(c + 1);
        const float cl = cumS[63];
        bf16x8 gb[2][4];
        {
            bf16x8 fa[4], fb[2][4], ga[4];
            if (KIND == 0) { ldfrag<4>(fa, Ws + mt * 16 * 136, 136, r, q); ldfrag<4>(fb[0], ST + nt0 * 16 * 136, 136, r, q); ldfrag<4>(fb[1], ST + (nt0 + 1) * 16 * 136, 136, r, q); }
            ldfrag<4>(ga, Ks + mt * 16 * 136, 136, r, q); ldfrag<4>(gb[0], Qs + nt0 * 16 * 136, 136, r, q); ldfrag<4>(gb[1], Qs + (nt0 + 1) * 16 * 136, 136, r, q);
            const f32x4 cj = *(const LAS f32x4*)(cumS + mt * 16 + q * 4);
            u32x2 uu[2]; float ci[2], dti[2];
#pragma unroll
            for (int tt = 0; tt < 2; ++tt) {
                if (KIND == 0) uu[tt] = *(const LAS u32x2*)(UT + ((nt0 + tt) * 16 + r) * 72 + mt * 16 + q * 4);
                ci[tt] = cumS[(nt0 + tt) * 16 + r];
                if (KIND == 1) dti[tt] = dtS[(nt0 + tt) * 16 + r];
            }
            __builtin_amdgcn_sched_barrier(0);
            if (KIND == 0) {
                f32x4 a0 = (f32x4){0.f, 0.f, 0.f, 0.f}, a1 = a0;
                a0 = mmafrag<4>(a0, fa, fb[0]); a1 = mmafrag<4>(a1, fa, fb[1]);
                const float e0 = __expf(cl - cj[0]), e1 = __expf(cl - cj[1]), e2 = __expf(cl - cj[2]), e3 = __expf(cl - cj[3]);
#pragma unroll
                for (int tt = 0; tt < 2; ++tt) {
                    const f32x4 acc = tt ? a1 : a0;
                    const float v0 = bf_lo(uu[tt].x) - acc[0], v1 = bf_hi(uu[tt].x) - acc[1], v2 = bf_lo(uu[tt].y) - acc[2], v3 = bf_hi(uu[tt].y) - acc[3];
                    u32x2 w; w.x = pk_bf16(v0, v1); w.y = pk_bf16(v2, v3);
                    *(LAS u32x2*)(VT + ((nt0 + tt) * 16 + r) * 72 + mt * 16 + q * 4) = w;
                    u32x2 ws; ws.x = pk_bf16(v0 * e0, v1 * e1); ws.y = pk_bf16(v2 * e2, v3 * e3);
                    *(LAS u32x2*)(VST + ((nt0 + tt) * 16 + r) * 72 + mt * 16 + q * 4) = ws;
                }
            }
            {
                f32x4 a0 = (f32x4){0.f, 0.f, 0.f, 0.f}, a1 = a0;
                a0 = mmafrag<4>(a0, ga, gb[0]); a1 = mmafrag<4>(a1, ga, gb[1]);
#pragma unroll
                for (int tt = 0; tt < 2; ++tt) {
                    const f32x4 acc = tt ? a1 : a0;
                    const int i = (nt0 + tt) * 16 + r;
                    float f[4];
#pragma unroll
                    for (int jj = 0; jj < 4; ++jj) {
                        const int j = mt * 16 + q * 4 + jj;
                        float v = (j <= i) ? acc[jj] * __expf(ci[tt] - cj[jj]) : 0.f;
                        if (KIND == 1 && j == i) v += Dval * __builtin_amdgcn_rcpf(dti[tt]);
                        f[jj] = v;
                    }
                    u32x2 w; w.x = pk_bf16(f[0], f[1]); w.y = pk_bf16(f[2], f[3]);
                    *(LAS u32x2*)(AT + i * 72 + mt * 16 + q * 4) = w;
                }
            }
        }
        __syncthreads();
        {
            bf16x8 sa[4], va[2], ab[2][2], ka[2], vb[4][2];
            ldfrag<4>(sa, ST + mt * 16 * 136, 136, r, q);
            ldfrag<2>(ab[0], AT + nt0 * 16 * 72, 72, r, q); ldfrag<2>(ab[1], AT + (nt0 + 1) * 16 * 72, 72, r, q);
            if (KIND == 0) {
                ldfrag<2>(va, VT + mt * 16 * 72, 72, r, q);
#pragma unroll
                for (int n = 0; n < 4; ++n) ldfrag<2>(vb[n], VST + n * 16 * 72, 72, r, q);
            } else {
#pragma unroll
                for (int ks = 0; ks < 2; ++ks) {
                    va[ks] = ldfrag_tr(VT, 72, ks * 32, mt * 16, r, q);
#pragma unroll
                    for (int n = 0; n < 4; ++n) vb[n][ks] = ldfrag_tr(VST, 72, ks * 32, n * 16, r, q);
                }
            }
#pragma unroll
            for (int ks = 0; ks < 2; ++ks) ka[ks] = ldfrag_tr(Ks, 136, ks * 32, wid * 16, r, q);
            const float ei0 = __expf(cumS[nt0 * 16 + r]), ei1 = __expf(cumS[(nt0 + 1) * 16 + r]);
            const float dl = __expf(cl);
            __builtin_amdgcn_sched_barrier(0);
            f32x4 o0 = (f32x4){0.f, 0.f, 0.f, 0.f}, o1 = o0;
            o0 = mmafrag<4>(o0, sa, gb[0]); o1 = mmafrag<4>(o1, sa, gb[1]);
            o0 *= ei0; o1 *= ei1;
            o0 = mmafrag<2>(o0, va, ab[0]); o1 = mmafrag<2>(o1, va, ab[1]);
#pragma unroll
            for (int n = 0; n < 4; ++n) { Sacc[n] *= dl; Sacc[n] = mmafrag<2>(Sacc[n], ka, vb[n]); }
            if (KIND == 1) {
                o0[0] *= siluf(bf_lo(cz0.x)); o0[1] *= siluf(bf_hi(cz0.x)); o0[2] *= siluf(bf_lo(cz0.y)); o0[3] *= siluf(bf_hi(cz0.y));
                o1[0] *= siluf(bf_lo(cz1.x)); o1[1] *= siluf(bf_hi(cz1.x)); o1[2] *= siluf(bf_lo(cz1.y)); o1[3] *= siluf(bf_hi(cz1.y));
            }
            ow0.x = pk_bf16(o0[0], o0[1]); ow0.y = pk_bf16(o0[2], o0[3]);
            ow1.x = pk_bf16(o1[0], o1[1]); ow1.y = pk_bf16(o1[2], o1[3]);
        }
#pragma unroll
        for (int n = 0; n < 4; ++n) {
            u32x2 w; w.x = pk_bf16(Sacc[n][0], Sacc[n][1]); w.y = pk_bf16(Sacc[n][2], Sacc[n][3]);
            *(LAS u32x2*)(STn + (n * 16 + r) * 136 + wid * 16 + q * 4) = w;
        }
    }
    {
        const size_t tl = ((size_t)b * NCHUNK + NCHUNK - 1) * 64;
        *(u32x2*)(proj + pidx(tl + nt0 * 16 + r, vcol + mt * 16 + q * 4)) = ow0;
        *(u32x2*)(proj + pidx(tl + (nt0 + 1) * 16 + r, vcol + mt * 16 + q * 4)) = ow1;
    }
    __syncthreads();
#undef PREFETCH
}

__device__ void phaseD(const P& p, int layer) {
    const int tid_ = opaque_tid(); const int lane = tid_ & 63, wv = tid_ >> 6;
    bf16_t* proj = (bf16_t*)(p.ws + WS_PROJ);
    const float* gw = p.gdn_norm + layer * 128; const float* rw = p.ret_norm + layer * 128; const float* sw = p.ssd_norm + layer * 1024;
    const int stride = gridDim.x * 8;
    u32x4 cur[8], nxt[8];
#define D_LOAD(dst, rr) do { const size_t rr_ = (size_t)(rr); \
        dst[0] = __builtin_nontemporal_load((const u32x4*)(proj + pidx(rr_, C_GV + lane * 8))); dst[1] = __builtin_nontemporal_load((const u32x4*)(proj + pidx(rr_, C_GZ + lane * 8))); \
        dst[2] = __builtin_nontemporal_load((const u32x4*)(proj + pidx(rr_, C_RV + lane * 8))); dst[3] = __builtin_nontemporal_load((const u32x4*)(proj + pidx(rr_, C_RG + lane * 8))); \
        dst[4] = __builtin_nontemporal_load((const u32x4*)(proj + pidx(rr_, C_SX + lane * 16))); dst[5] = (u32x4){0u, 0u, 0u, 0u}; \
        dst[6] = __builtin_nontemporal_load((const u32x4*)(proj + pidx(rr_, C_SX + lane * 16 + 8))); dst[7] = (u32x4){0u, 0u, 0u, 0u}; } while (0)
    int row = blockIdx.x * 8 + wv;
    if (row < T_TOK) D_LOAD(nxt, row);
    for (; row < T_TOK; row += stride) {
#pragma unroll
        for (int k = 0; k < 8; ++k) cur[k] = nxt[k];
        if (row + stride < T_TOK) D_LOAD(nxt, row + stride);
#pragma unroll
        for (int s = 0; s < 2; ++s) {
            const int zc = (s == 0 ? C_GZ : C_RG) + lane * 8;
            const float* nw = (s == 0 ? gw : rw) + (lane & 15) * 8;
            const u32x4 o = cur[2 * s], z = cur[2 * s + 1];
            float ov[8] = {bf_lo(o.x), bf_hi(o.x), bf_lo(o.y), bf_hi(o.y), bf_lo(o.z), bf_hi(o.z), bf_lo(o.w), bf_hi(o.w)};
            const float zv[8] = {bf_lo(z.x), bf_hi(z.x), bf_lo(z.y), bf_hi(z.y), bf_lo(z.z), bf_hi(z.z), bf_lo(z.w), bf_hi(z.w)};
            float ss = 0.f;
#pragma unroll
            for (int e = 0; e < 8; ++e) ss += ov[e] * ov[e];
            ss += __shfl_xor(ss, 1); ss += __shfl_xor(ss, 2); ss += __shfl_xor(ss, 4); ss += __shfl_xor(ss, 8);
            const float rs = rsqrtf(ss * (1.0f / 128.0f) + EPS);
#pragma unroll
            for (int e = 0; e < 8; ++e) ov[e] = ov[e] * rs * nw[e] * siluf(zv[e]);
            u32x4 w; w.x = pk_bf16(ov[0], ov[1]); w.y = pk_bf16(ov[2], ov[3]); w.z = pk_bf16(ov[4], ov[5]); w.w = pk_bf16(ov[6], ov[7]);
            *(u32x4*)(proj + pidx((size_t)row, zc)) = w;
        }
        {
            float yv[16];
#pragma unroll
            for (int k = 0; k < 2; ++k) {
                const u32x4 o = cur[4 + 2 * k], z = cur[5 + 2 * k];
                const float ov[8] = {bf_lo(o.x), bf_hi(o.x), bf_lo(o.y), bf_hi(o.y), bf_lo(o.z), bf_hi(o.z), bf_lo(o.w), bf_hi(o.w)};
                const float zv[8] = {bf_lo(z.x), bf_hi(z.x), bf_lo(z.y), bf_hi(z.y), bf_lo(z.z), bf_hi(z.z), bf_lo(z.w), bf_hi(z.w)};
#pragma unroll
                for (int e = 0; e < 8; ++e) yv[k * 8 + e] = ov[e];
            }
            float ss = 0.f;
#pragma unroll
            for (int e = 0; e < 16; ++e) ss += yv[e] * yv[e];
            ss += __shfl_xor(ss, 1); ss += __shfl_xor(ss, 2); ss += __shfl_xor(ss, 4); ss += __shfl_xor(ss, 8); ss += __shfl_xor(ss, 16);
            const float rs = rsqrtf(ss * (1.0f / 512.0f) + EPS);
#pragma unroll
            for (int k = 0; k < 2; ++k) {
                const float* nw = sw + lane * 16 + k * 8;
                u32x4 w; w.x = pk_bf16(yv[k * 8] * rs * nw[0], yv[k * 8 + 1] * rs * nw[1]); w.y = pk_bf16(yv[k * 8 + 2] * rs * nw[2], yv[k * 8 + 3] * rs * nw[3]);
                w.z = pk_bf16(yv[k * 8 + 4] * rs * nw[4], yv[k * 8 + 5] * rs * nw[5]); w.w = pk_bf16(yv[k * 8 + 6] * rs * nw[6], yv[k * 8 + 7] * rs * nw[7]);
                *(u32x4*)(proj + pidx((size_t)row, C_SZ + lane * 16 + k * 8)) = w;
            }
        }
    }
#undef D_LOAD
}

__global__ void __launch_bounds__(512, 2) hybrid_fwd(P p) {
    extern __shared__ __attribute__((aligned(16))) unsigned char lds_raw[];
    LAS unsigned char* lds = (LAS unsigned char*)lds_raw;
    cg::grid_group grid = cg::this_grid();
    const int G = gridDim.x, bx = blockIdx.x;
    bf16_t* proj = (bf16_t*)(p.ws + WS_PROJ);
    bf16_t* hbuf = (bf16_t*)(p.ws + WS_H);
    if (threadIdx.x == 0) *(LAS u32x4*)(lds + LDS_BAR_OFF) = (u32x4){0u, 0u, 0u, 0u};
    __syncthreads();
    XcdBarrier xb = xcd_barrier_post((unsigned*)(p.ws + WS_BAR), (volatile LAS unsigned*)(lds + LDS_BAR_OFF));
    int nsync = 0;
    for (int ph = p.ph_lo; ph < p.ph_hi; ++ph) {
        if (ph > p.ph_lo) { if (nsync == 0) grid.sync(); else xcd_barrier(xb); ++nsync; }
        const int layer = ph >= 7 ? 1 : 0, sub = ph == 0 ? 0 : (ph - 1) % 6 + 1;
        if (sub == 0) {
            phase_convert(p);
            phase_rows(p.x, nullptr, 0, nullptr, nullptr, p.pre_norm, hbuf);
        } else if (sub == 1) {
            pg8::Gemm g; g.A = hbuf; g.Bt = (const bf16_t*)(p.ws + WS_WIN) + (size_t)layer * NPW * DM; g.M = T_TOK; g.N = NPW; g.K = DM; g.lda = DM; g.atiled = 0;
            pg8::StaticOrder S; S.init(g.M, g.N, G, bx);
            EpiProj E; E.proj = proj; E.small = (float*)(p.ws + WS_SMALL); E.halo = (bf16_t*)(p.ws + WS_HALO);
            pg8::gemm_phase<EpiProj>(lds, g, S, E);
        } else if (sub == 2) {
            for (int it = bx; it < 1024 * 6; it += G) {
                const int chunkg = it & 1023, kind = it >> 10;
                if (kind < 4) phaseB_gdn(lds, p, layer, chunkg, kind);
                else if (kind == 4) phaseB_ssd(p, layer, chunkg);
                else phaseB_ret(p, chunkg);
            }
        } else if (sub == 3) {
            for (int it = bx; it < 256; it += G) {
                int kind, sub;
                if (G == 256) {
                    const int xcd = it & 7, s = it >> 3;
                    if (s < 8) { kind = 0; sub = (xcd + 8 * (s >> 1)) * 2 + (s & 1); }
                    else if (s < 24) { const int s2 = s - 8, g = xcd + 8 * (s2 >> 3); kind = 1; sub = (g >> 1) * 16 + (g & 1) * 8 + (s2 & 7); }
                    else { const int s2 = s - 24; kind = 2; sub = (xcd + 8 * (s2 >> 1)) * 2 + (s2 & 1); }
                } else { kind = it < 64 ? 0 : (it < 192 ? 1 : 2); sub = it < 64 ? it : (it < 192 ? it - 64 : it - 192); }
                if (kind == 0) phaseC_item<0>(lds, p, layer, sub);
                else if (kind == 1) phaseC_item<1>(lds, p, layer, sub);
                else phaseC_item<2>(lds, p, layer, sub);
            }
        } else if (sub == 4) {
            phaseD(p, layer);
        } else if (sub == 5) {
            pg8::Gemm g; g.A = proj; g.Bt = (const bf16_t*)(p.ws + WS_WOUT) + (size_t)layer * 1024 * 2048; g.M = T_TOK; g.N = 1024; g.K = 2048; g.lda = 256; g.atiled = 1;
            pg8::StaticOrder S; S.init(g.M, g.N, G, bx);
            EpiOut E; E.O = proj;
            pg8::gemm_phase<EpiOut>(lds, g, S, E);
        } else {
            phase_rows(layer == 0 ? p.x : p.out, proj, NP, p.post_norm + layer * DM, p.out,
                       layer == 0 ? p.pre_norm + DM : nullptr, hbuf);
        }
    }
}

extern "C" void kernel_launch(void* const* d_in, const int* in_sizes, int n_in, void* d_out, int out_size, void* d_ws, size_t ws_size, hipStream_t stream) {
    static int grid_blocks = 0;
    if (grid_blocks == 0) {
        if (n_in != 16 || in_sizes[0] != T_TOK * DM || out_size != T_TOK * DM || ws_size < WS_TOTAL) {
            fprintf(stderr, "kernel_launch: unexpected shapes / workspace (%d inputs, in0 %d, out %d, ws %zu, need %zu)\n", n_in, n_in > 0 ? in_sizes[0] : -1, out_size, ws_size, (size_t)WS_TOTAL);
            grid_blocks = -1; return;
        }
        int dev = 0, cus = 0, per_cu = 0;
        hipGetDevice(&dev);
        hipDeviceGetAttribute(&cus, hipDeviceAttributeMultiprocessorCount, dev);
        if (hipFuncSetAttribute((const void*)hybrid_fwd, hipFuncAttributeMaxDynamicSharedMemorySize, LDS_BYTES) != hipSuccess) { fprintf(stderr, "hipFuncSetAttribute failed\n"); grid_blocks = -1; return; }
        hipOccupancyMaxActiveBlocksPerMultiprocessor(&per_cu, (const void*)hybrid_fwd, 512, LDS_BYTES);
        if (per_cu < 1) { fprintf(stderr, "occupancy query returned %d\n", per_cu); grid_blocks = -1; return; }
        grid_blocks = cus;
    }
    if (grid_blocks < 0) return;
    P p{};
    p.x = (const float*)d_in[0]; p.pre_norm = (const float*)d_in[1]; p.post_norm = (const float*)d_in[2]; p.w_in = (const float*)d_in[3];
    p.gdn_conv = (const float*)d_in[4]; p.gdn_A_log = (const float*)d_in[5]; p.gdn_dt_bias = (const float*)d_in[6]; p.gdn_norm = (const float*)d_in[7];
    p.ssd_conv = (const float*)d_in[8]; p.ssd_conv_b = (const float*)d_in[9]; p.ssd_A_log = (const float*)d_in[10]; p.ssd_dt_bias = (const float*)d_in[11];
    p.ssd_D = (const float*)d_in[12]; p.ssd_norm = (const float*)d_in[13]; p.ret_norm = (const float*)d_in[14]; p.w_out = (const float*)d_in[15];
    p.out = (float*)d_out; p.ws = (unsigned char*)d_ws;
    p.ph_lo = 0; p.ph_hi = 13;
    hipError_t me = hipMemsetAsync((unsigned char*)d_ws + WS_BAR, 0, XCD_BAR_WORDS * sizeof(unsigned), stream);
    if (me != hipSuccess) fprintf(stderr, "barrier memset failed: %s\n", hipGetErrorString(me));
    void* args[] = {&p};
    hipError_t e = hipLaunchCooperativeKernel((const void*)hybrid_fwd, dim3(grid_blocks), dim3(512), args, LDS_BYTES, stream);
    if (e != hipSuccess) fprintf(stderr, "cooperative launch failed: %s (grid %d)\n", hipGetErrorString(e), grid_blocks);
}
```

```cpp
#include <hip/hip_runtime.h>
#include <hip/hip_cooperative_groups.h>
#include <cstdio>
namespace cg = cooperative_groups;

#define LAS __attribute__((address_space(3)))
#define DI __device__ __forceinline__
typedef unsigned short bf16_t;
typedef short bf16x8 __attribute__((ext_vector_type(8)));
typedef float f32x4 __attribute__((ext_vector_type(4)));
typedef unsigned u32x4 __attribute__((ext_vector_type(4)));
typedef unsigned u32x2 __attribute__((ext_vector_type(2)));

constexpr int T_TOK = 65536, DM = 1024, NCHUNK = 128, NB = 8;
constexpr int NP = 6656;
constexpr int NPW = 6912;
constexpr int NIN = 6680;
constexpr int C_GZ = 0, C_SZ = 512, C_RG = 1536, C_GQ = 2048, C_GK = 2560, C_GV = 3072, C_SX = 3584, C_SB = 4608, C_SC = 4864,
              C_RQ = 5120, C_RK = 5632, C_RV = 6144;
constexpr float EPS = 1e-6f;
__device__ __forceinline__ size_t pidx(size_t row, int col) { return ((row >> 8) * 26 + (size_t)(col >> 8)) * 65536 + (row & 255) * 256 + (size_t)(col & 255); }
constexpr size_t WS_PROJ = 0;
constexpr size_t WS_H = (size_t)T_TOK * NP * 2;
constexpr size_t WS_WBUF = WS_H;
constexpr size_t WS_GCUM = WS_H + (size_t)T_TOK * 512 * 2;
constexpr size_t WS_DT = WS_GCUM + (size_t)T_TOK * 4 * 4;
constexpr size_t WS_ACUM = WS_DT + (size_t)T_TOK * 16 * 4;
constexpr size_t WS_WIN = WS_H + (size_t)T_TOK * DM * 2;
constexpr size_t WS_WOUT = WS_WIN + (size_t)2 * NPW * DM * 2;
constexpr size_t WS_SMALL = WS_WOUT + (size_t)2 * 1024 * 2048 * 2;
constexpr size_t WS_HALO = WS_SMALL + (size_t)T_TOK * 32 * 4;
constexpr size_t WS_END = WS_HALO + (size_t)1024 * 3 * 3072 * 2;
constexpr size_t WS_BAR = WS_END;
constexpr size_t WS_TOTAL = WS_END + 16384;
constexpr int LDS_BAR_OFF = 160768;
constexpr int LDS_BYTES = 160768 + 16;

struct P {
    const float* x; const float* pre_norm; const float* post_norm; const float* w_in; const float* gdn_conv; const float* gdn_A_log;
    const float* gdn_dt_bias; const float* gdn_norm; const float* ssd_conv; const float* ssd_conv_b; const float* ssd_A_log;
    const float* ssd_dt_bias; const float* ssd_D; const float* ssd_norm; const float* ret_norm; const float* w_out;
    float* out; unsigned char* ws; int ph_lo, ph_hi;
};

DI int opaque_tid() { int t = threadIdx.x; asm volatile("" : "+v"(t)); return t; }
typedef float f32x2 __attribute__((ext_vector_type(2)));
typedef __bf16 bf16x2_t __attribute__((ext_vector_type(2)));
DI unsigned pk_bf16(float lo, float hi) { const f32x2 v = {lo, hi}; const bf16x2_t b = __builtin_convertvector(v, bf16x2_t); return __builtin_bit_cast(unsigned, b); }
DI float bf_lo(unsigned w) { return __uint_as_float(w << 16); }
DI float bf_hi(unsigned w) { return __uint_as_float(w & 0xffff0000u); }
DI float siluf(float v) { return v * __builtin_amdgcn_rcpf(1.0f + __expf(-v)); }
DI void unpack8(const u32x4 w, f32x2 (&o)[4]) { o[0] = (f32x2){bf_lo(w.x), bf_hi(w.x)}; o[1] = (f32x2){bf_lo(w.y), bf_hi(w.y)}; o[2] = (f32x2){bf_lo(w.z), bf_hi(w.z)}; o[3] = (f32x2){bf_lo(w.w), bf_hi(w.w)}; }
DI f32x2 silu2(f32x2 v) { const f32x2 e = (f32x2){__expf(-v[0]), __expf(-v[1])}; const f32x2 d = e + 1.0f; const f32x2 rr = (f32x2){__builtin_amdgcn_rcpf(d[0]), __builtin_amdgcn_rcpf(d[1])}; return v * rr; }
DI float softplusf(float v) { return v > 20.f ? v : log1pf(__expf(v)); }
DI float wave_scan_incl(float v, int lane) {
#pragma unroll
    for (int o = 1; o < 64; o <<= 1) { float t = __shfl_up(v, o); if (lane >= o) v += t; }
    return v;
}

#define XB_TMO      128
#define XB_XCNT(j)  (256  + 64 * (j))
#define XB_XSUB(j)  (1280 + 64 * (j))
#define XB_XGEN(j)  (2304 + 64 * (j))
#define XB_TOP      3328
#define XB_TOPGEN   3392
#define XCD_BAR_WORDS 3456
#define XB_SPIN_CAP (1u << 18)

__device__ __forceinline__ unsigned xb_ld(unsigned* p)              { return __hip_atomic_load(p, __ATOMIC_RELAXED, __HIP_MEMORY_SCOPE_AGENT); }
__device__ __forceinline__ unsigned xb_add(unsigned* p, unsigned v) { return __hip_atomic_fetch_add(p, v, __ATOMIC_RELAXED, __HIP_MEMORY_SCOPE_AGENT); }
__device__ __forceinline__ unsigned xb_xcc_id() { return (unsigned)__builtin_amdgcn_s_getreg((3 << 11) | 20) & 0xFu; }
#define XB_SPIN(cond, bar) do { unsigned _sp = 0; while (cond) { __builtin_amdgcn_s_sleep(1); \
    if ((++_sp & 255u) == 0u) { if (xb_ld(&(bar)[XB_TMO])) break; if (_sp > XB_SPIN_CAP) { atomicAdd(&(bar)[XB_TMO], 1u); break; } } } } while (0)

struct XcdBarrier {
    unsigned* bar; unsigned x;
    volatile LAS unsigned* st;
};

__device__ __forceinline__ XcdBarrier xcd_barrier_post(unsigned* bar, volatile LAS unsigned* st) {
    XcdBarrier b; b.bar = bar; b.x = xb_xcc_id(); b.st = st;
    if (threadIdx.x == 0) (void)xb_add(&bar[XB_XCNT(b.x)], 1u);
    return b;
}
__device__ __forceinline__ void xcd_barrier_complete(unsigned* bar, unsigned x, unsigned& nloc, unsigned& nx) {
    const unsigned G = gridDim.x * gridDim.y * gridDim.z;
    unsigned sum, cnt, mine, sp = 0u;
    for (;;) {
        sum = 0u; cnt = 0u; mine = 0u;
#pragma unroll
        for (unsigned j = 0; j < 16; ++j) { const unsigned c = xb_ld(&bar[XB_XCNT(j)]); sum += c; cnt += (c > 0u) ? 1u : 0u; mine = (j == x) ? c : mine; }
        if (sum == G) break;
        __builtin_amdgcn_s_sleep(1);
        if ((++sp & 255u) == 0u) { if (xb_ld(&bar[XB_TMO])) break; if (sp > XB_SPIN_CAP) { atomicAdd(&bar[XB_TMO], 1u); break; } }
    }
    nloc = mine > 0u ? mine : 1u; nx = cnt > 0u ? cnt : 1u;
}

__device__ __forceinline__ void xcd_barrier(const XcdBarrier& b) {
    asm volatile("s_waitcnt vmcnt(0)" ::: "memory");
    __syncthreads();
    if (threadIdx.x == 0) {
        unsigned* bar = b.bar;
        __builtin_amdgcn_s_waitcnt(0);
        unsigned nloc = b.st[0], nx = b.st[1];
        if (nloc == 0u) { xcd_barrier_complete(bar, b.x, nloc, nx); b.st[0] = nloc; b.st[1] = nx; }
        const unsigned old = xb_add(&bar[XB_XSUB(b.x)], 1u);
        const unsigned gen = old / nloc;
        if (old + 1u == (gen + 1u) * nloc) {
            __builtin_amdgcn_fence(__ATOMIC_RELEASE, "agent");
            asm volatile("s_waitcnt vmcnt(0)" ::: "memory");
            const unsigned og = xb_add(&bar[XB_TOP], 1u);
            const unsigned tg = og / nx;
            if (og + 1u == (tg + 1u) * nx) xb_add(&bar[XB_TOPGEN], 1u);
            else XB_SPIN(xb_ld(&bar[XB_TOPGEN]) == tg, bar);
            __builtin_amdgcn_fence(__ATOMIC_ACQUIRE, "agent");
            xb_add(&bar[XB_XGEN(b.x)], 1u);
            asm volatile("s_waitcnt vmcnt(0)" ::: "memory");
        } else {
            XB_SPIN(xb_ld(&bar[XB_XGEN(b.x)]) == gen, bar);
            __builtin_amdgcn_fence(__ATOMIC_ACQUIRE, "agent");
            asm volatile("s_waitcnt vmcnt(0)" ::: "memory");
        }
    }
    __syncthreads();
}


namespace pg8 {
constexpr int BM = 256, BK = 64, HALF = 128, HTB = HALF * BK * 2, NXCD = 8, WGM = 6;
DI int lds_byte(int r, int c) { const int st = (r >> 4) * 2 + (c >> 5), rr = r & 15, cc = c & 31, ob = rr * 64 + cc * 2; return st * 1024 + (ob ^ (((ob >> 9) & 1) << 5)); }
DI void stage_rc(int b, int& R, int& C) { const int st = b / 1024, sb = b % 1024, swz = sb ^ (((sb >> 9) & 1) << 5); R = (st >> 1) * 16 + swz / 64; C = (st & 1) * 32 + (swz % 64) / 2; }
DI int perm32(int rho) { const int n = rho >> 4, i = rho & 15; return 8 * (i >> 2) + 4 * n + (i & 3); }
struct Unit { int pm, pn; };
struct Gemm { const bf16_t* A; const bf16_t* Bt; int M, N, K, lda, atiled; };
struct StaticOrder {
    int nM, nN, nwg, G, c;
    DI void init(int M, int N, int G_, int c_) { nM = M / BM; nN = N / BM; nwg = nM * nN; G = G_; c = c_; }
    DI bool next(int i, Unit& u) const {
        const long L = (long)i * G + c; if (L >= nwg) return false;
        int wgid = (int)L; { const int q = nwg / NXCD, r = nwg % NXCD, xcd = wgid % NXCD, off = wgid / NXCD; wgid = (xcd < r ? xcd * (q + 1) : r * (q + 1) + (xcd - r) * q) + off; }
        const int nig = WGM * nN, gid = wgid / nig, fm = gid * WGM, gsz = (nM - fm) < WGM ? (nM - fm) : WGM;
        u.pm = fm + ((wgid % nig) % gsz); u.pn = (wgid % nig) / gsz; return true;
    }
};

template <class Epi>
DI void gemm_phase(LAS unsigned char* lds, const Gemm g, const StaticOrder& S, const Epi& E) {
    const int tid = opaque_tid(), wid = __builtin_amdgcn_readfirstlane(tid >> 6), lane = tid & 63, wr = wid >> 2, wc = wid & 3, fr = lane & 15, fq = lane >> 4;
    const int K = g.K, nt = K / BK, lda = g.lda;
    unsigned voffA[2], voffB[2];
#pragma unroll
    for (int i = 0; i < 2; ++i) { int R, C; stage_rc(tid * 16 + i * 8192, R, C); const int Rb = Epi::PERM ? ((R & ~31) + perm32(R & 31)) : R;
        voffA[i] = (unsigned)(R * lda + C) * 2u; voffB[i] = (unsigned)(Rb * K + C) * 2u; }
    const size_t kstep = (size_t)(BK * 2);
    const size_t hA = (size_t)HALF * lda * 2, hB = (size_t)HALF * K * 2;
    const size_t tA = g.atiled ? (size_t)26 * 131072 : 2 * hA, tB = 2 * hB;
    const int atiled = g.atiled;
#define PG8_AKOFF(t) (atiled ? ((size_t)((t) >> 2) * 131072 + (size_t)((t) & 3) * 128) : (size_t)(t) * kstep)
    const unsigned ldsw = (unsigned)wid * 1024u;
    const int aoff = lds_byte(wr * 64 + fr, fq * 8), boff = lds_byte(wc * 32 + fr, fq * 8);
#define PG8_SA(b, h) (((b) * 2 + (h)) * HTB)
#define PG8_SB(b, h) ((4 + (b) * 2 + (h)) * HTB)
#define PG8_STAGE(bufoff, gbase, voff) do { _Pragma("unroll") for (int _i = 0; _i < 2; ++_i) \
        __builtin_amdgcn_global_load_lds((const unsigned*)((const char*)(gbase) + (voff)[_i]), (LAS unsigned*)(lds + (bufoff) + ldsw + _i * 8192), 16, 0, 0); } while (0)
#define PG8_LDA(dst, b, h) do { _Pragma("unroll") for (int m = 0; m < 4; ++m) _Pragma("unroll") for (int k = 0; k < 2; ++k) dst[m][k] = *(const LAS bf16x8*)(lds + PG8_SA(b, h) + aoff + m * 2048 + k * 1024); } while (0)
#define PG8_LDB(dst, b, h) do { _Pragma("unroll") for (int n = 0; n < 2; ++n) _Pragma("unroll") for (int k = 0; k < 2; ++k) dst[n][k] = *(const LAS bf16x8*)(lds + PG8_SB(b, h) + boff + n * 2048 + k * 1024); } while (0)
#define PG8_MMA(ai, bj, At, Bt) do { __builtin_amdgcn_s_setprio(1); _Pragma("unroll") for (int m = 0; m < 4; ++m) _Pragma("unroll") for (int n = 0; n < 2; ++n) _Pragma("unroll") for (int k = 0; k < 2; ++k) \
        acc[ai][bj][m][n] = __builtin_amdgcn_mfma_f32_16x16x32_bf16(Bt[n][k], At[m][k], acc[ai][bj][m][n], 0, 0, 0); __builtin_amdgcn_s_setprio(0); } while (0)
#define PG8_WAIT_V(n) asm volatile("s_waitcnt vmcnt(" #n ")" ::: "memory")
#define PG8_WAIT_L(n) asm volatile("s_waitcnt lgkmcnt(" #n ")" ::: "memory")
#define PG8_BAR __builtin_amdgcn_s_barrier()
#define PG8_SCHED __builtin_amdgcn_sched_barrier(0)
    Unit cur, nxt; int ui = 0;
    if (!S.next(0, cur)) return;
    f32x4 acc[2][2][4][2];
#pragma unroll
    for (int a = 0; a < 2; ++a)
#pragma unroll
        for (int b = 0; b < 2; ++b)
#pragma unroll
            for (int m = 0; m < 4; ++m)
#pragma unroll
                for (int n = 0; n < 2; ++n) acc[a][b][m][n] = (f32x4){0.f, 0.f, 0.f, 0.f};
    bf16x8 At[4][2], B0[2][2], B1[2][2];
    const char* cA = (const char*)g.A + (size_t)cur.pm * tA; const char* cB = (const char*)g.Bt + (size_t)cur.pn * tB;
    PG8_STAGE(PG8_SB(0, 0), cB, voffB); PG8_STAGE(PG8_SB(0, 1), cB + hB, voffB); PG8_STAGE(PG8_SA(0, 0), cA, voffA); PG8_STAGE(PG8_SA(0, 1), cA + hA, voffA);
    if (wr == 1) PG8_BAR;
    PG8_WAIT_V(2); PG8_BAR;
    PG8_STAGE(PG8_SB(1, 0), cB + kstep, voffB); PG8_STAGE(PG8_SA(1, 0), cA + kstep, voffA); PG8_STAGE(PG8_SB(1, 1), cB + hB + kstep, voffB);
    PG8_WAIT_V(6); PG8_BAR;
    for (;;) {
        const bool has_next = S.next(ui + 1, nxt);
        const char* nA = has_next ? (const char*)g.A + (size_t)nxt.pm * tA : cA; const char* nB = has_next ? (const char*)g.Bt + (size_t)nxt.pn * tB : cB;
        for (int t = 0; t < nt; t += 2) {
            const bool last = (t == nt - 2);
            const char* a1 = cA + PG8_AKOFF(t + 1);
            const char* a2 = last ? nA : cA + PG8_AKOFF(t + 2); const char* b2 = last ? nB : cB + (size_t)(t + 2) * kstep;
            const char* a3 = a2 + kstep; const char* b3 = b2 + kstep;
            PG8_LDB(B0, 0, 0); PG8_LDB(B1, 0, 1); PG8_SCHED; PG8_LDA(At, 0, 0); PG8_STAGE(PG8_SA(1, 1), a1 + hA, voffA);
            PG8_WAIT_V(8); PG8_WAIT_L(0); PG8_BAR; PG8_MMA(0, 0, At, B0); PG8_MMA(0, 1, At, B1); PG8_BAR; PG8_SCHED;
            PG8_LDA(At, 0, 1); PG8_STAGE(PG8_SB(0, 0), b2, voffB); PG8_STAGE(PG8_SB(0, 1), b2 + hB, voffB); PG8_STAGE(PG8_SA(0, 0), a2, voffA);
            PG8_WAIT_V(8); PG8_WAIT_L(0); PG8_BAR; PG8_MMA(1, 0, At, B0); PG8_MMA(1, 1, At, B1); PG8_BAR; PG8_SCHED;
            PG8_LDB(B0, 1, 0); PG8_LDB(B1, 1, 1); PG8_SCHED; PG8_LDA(At, 1, 0); PG8_STAGE(PG8_SA(0, 1), a2 + hA, voffA);
            PG8_WAIT_V(8); PG8_WAIT_L(0); PG8_BAR; PG8_MMA(0, 0, At, B0); PG8_MMA(0, 1, At, B1); PG8_BAR; PG8_SCHED;
            PG8_LDA(At, 1, 1); PG8_STAGE(PG8_SB(1, 0), b3, voffB); PG8_STAGE(PG8_SB(1, 1), b3 + hB, voffB); PG8_STAGE(PG8_SA(1, 0), a3, voffA);
            PG8_WAIT_V(8); PG8_WAIT_L(0); PG8_BAR; PG8_MMA(1, 0, At, B0); PG8_MMA(1, 1, At, B1); PG8_BAR; PG8_SCHED;
        }
        if (wr == 0) PG8_BAR;
        E(acc, cur, wr, wc, fr, fq);
        if (!has_next) break;
#pragma unroll
        for (int a = 0; a < 2; ++a)
#pragma unroll
            for (int b = 0; b < 2; ++b)
#pragma unroll
                for (int m = 0; m < 4; ++m)
#pragma unroll
                    for (int n = 0; n < 2; ++n) acc[a][b][m][n] = (f32x4){0.f, 0.f, 0.f, 0.f};
        cur = nxt; cA = nA; cB = nB; ++ui;
        if (wr == 1) PG8_BAR;
    }
    PG8_WAIT_V(0);
    PG8_BAR;
#undef PG8_SA
#undef PG8_AKOFF
#undef PG8_SB
#undef PG8_STAGE
#undef PG8_LDA
#undef PG8_LDB
#undef PG8_MMA
#undef PG8_WAIT_V
#undef PG8_WAIT_L
#undef PG8_BAR
#undef PG8_SCHED
}
}

struct EpiProj {
    static constexpr bool PERM = true;
    bf16_t* proj; float* small; bf16_t* halo;
    DI void operator()(const f32x4 (&acc)[2][2][4][2], const pg8::Unit& u, int wr, int wc, int fr, int fq) const {
        const int row0 = u.pm * 256 + wr * 64 + fr;
        if (u.pn < 26) {
            const int col0 = u.pn * 256 + wc * 32 + 8 * fq;
            const bool conv = (u.pn >= 8 && u.pn < 20);
#pragma unroll
            for (int ai = 0; ai < 2; ++ai)
#pragma unroll
                for (int m = 0; m < 4; ++m) {
                    const int row = row0 + ai * 128 + m * 16;
                    bf16_t* rowp = proj + pidx((size_t)row, col0);
#pragma unroll
                    for (int bj = 0; bj < 2; ++bj) {
                        const f32x4 v0 = acc[ai][bj][m][0], v1 = acc[ai][bj][m][1];
                        u32x4 w; w.x = pk_bf16(v0[0], v0[1]); w.y = pk_bf16(v0[2], v0[3]); w.z = pk_bf16(v1[0], v1[1]); w.w = pk_bf16(v1[2], v1[3]);
                        *(u32x4*)(rowp + bj * 128) = w;
                        if (m == 3 && conv && fr >= 13)
                            *(u32x4*)(halo + ((size_t)(row >> 6) * 3 + (fr - 13)) * 3072 + (col0 + bj * 128 - 2048)) = w;
                    }
                }
        } else if (wc == 0) {
#pragma unroll
            for (int ai = 0; ai < 2; ++ai)
#pragma unroll
                for (int m = 0; m < 4; ++m) {
                    const int row = row0 + ai * 128 + m * 16;
                    float* pp = small + (size_t)row * 32 + 8 * fq;
                    *(f32x4*)pp = acc[ai][0][m][0]; *(f32x4*)(pp + 4) = acc[ai][0][m][1];
                }
        }
    }
};
struct EpiOut {
    static constexpr bool PERM = true;
    bf16_t* O;
    DI void operator()(const f32x4 (&acc)[2][2][4][2], const pg8::Unit& u, int wr, int wc, int fr, int fq) const {
        const int row0 = u.pm * 256 + wr * 64 + fr, col0 = u.pn * 256 + wc * 32 + 8 * fq;
#pragma unroll
        for (int ai = 0; ai < 2; ++ai)
#pragma unroll
            for (int m = 0; m < 4; ++m) {
                bf16_t* rowp = O + pidx((size_t)(row0 + ai * 128 + m * 16), 2048 + col0);
#pragma unroll
                for (int bj = 0; bj < 2; ++bj) {
                    const f32x4 v0 = acc[ai][bj][m][0], v1 = acc[ai][bj][m][1];
                    u32x4 w; w.x = pk_bf16(v0[0], v0[1]); w.y = pk_bf16(v0[2], v0[3]); w.z = pk_bf16(v1[0], v1[1]); w.w = pk_bf16(v1[2], v1[3]);
                    *(u32x4*)(rowp + bj * 128) = w;
                }
            }
    }
};

template <int KSTEPS>
DI f32x4 mma_tile(f32x4 acc, const LAS bf16_t* A, int lda, const LAS bf16_t* B, int ldb, int r, int q) {
#pragma unroll
    for (int k = 0; k < KSTEPS; ++k) {
        const bf16x8 a = *(const LAS bf16x8*)(A + r * lda + k * 32 + q * 8);
        const bf16x8 b = *(const LAS bf16x8*)(B + r * ldb + k * 32 + q * 8);
        acc = __builtin_amdgcn_mfma_f32_16x16x32_bf16(a, b, acc, 0, 0, 0);
    }
    return acc;
}

template <int KS> DI void ldfrag(bf16x8 (&f)[KS], const LAS bf16_t* base, int ld, int r, int q) {
#pragma unroll
    for (int k = 0; k < KS; ++k) f[k] = *(const LAS bf16x8*)(base + r * ld + k * 32 + q * 8);
}
template <int KS> DI f32x4 mmafrag(f32x4 acc, const bf16x8 (&a)[KS], const bf16x8 (&b)[KS]) {
#pragma unroll
    for (int k = 0; k < KS; ++k) acc = __builtin_amdgcn_mfma_f32_16x16x32_bf16(a[k], b[k], acc, 0, 0, 0);
    return acc;
}

DI int orig_col(int n) {
    if (n < 512) return 1536 + n;
    if (n < 1536) return 3592 + (n - 512);
    if (n < 2048) return 6168 + (n - 1536);
    if (n < 3584) return n - 2048;
    if (n < 5120) return 2056 + (n - 3584);
    if (n < 6656) return 4632 + (n - 5120);
    if (n < 6664) return 2048 + (n - 6656);
    if (n < 6680) return 4616 + (n - 6664);
    return -1;
}
__device__ void phase_convert(const P& p) {
    bf16_t* WinT = (bf16_t*)(p.ws + WS_WIN); bf16_t* WoutT = (bf16_t*)(p.ws + WS_WOUT);
    const size_t gsz = (size_t)gridDim.x * blockDim.x, g0 = (size_t)blockIdx.x * blockDim.x + opaque_tid();
    const size_t n1 = (size_t)2 * 128 * NPW;
    for (size_t i = g0; i < n1; i += gsz) {
        const int n = (int)(i % NPW); const int k8 = (int)((i / NPW) % 128); const int l = (int)(i / ((size_t)NPW * 128));
        const int oc = orig_col(n);
        float v[8];
#pragma unroll
        for (int e = 0; e < 8; ++e) v[e] = oc >= 0 ? p.w_in[((size_t)l * 1024 + k8 * 8 + e) * NIN + oc] : 0.f;
        u32x4 w; w.x = pk_bf16(v[0], v[1]); w.y = pk_bf16(v[2], v[3]); w.z = pk_bf16(v[4], v[5]); w.w = pk_bf16(v[6], v[7]);
        *(u32x4*)(WinT + ((size_t)l * NPW + n) * 1024 + k8 * 8) = w;
    }
    const size_t n2 = (size_t)2 * 256 * 1024;
    for (size_t i = g0; i < n2; i += gsz) {
        const int n = (int)(i % 1024); const int k8 = (int)((i / 1024) % 256); const int l = (int)(i / (1024 * 256));
        float v[8];
#pragma unroll
        for (int e = 0; e < 8; ++e) v[e] = p.w_out[((size_t)l * 2048 + k8 * 8 + e) * 1024 + n];
        u32x4 w; w.x = pk_bf16(v[0], v[1]); w.y = pk_bf16(v[2], v[3]); w.z = pk_bf16(v[4], v[5]); w.w = pk_bf16(v[6], v[7]);
        *(u32x4*)(WoutT + ((size_t)l * 1024 + n) * 2048 + k8 * 8) = w;
    }
}
__device__ void phase_rows(const float* xin, const bf16_t* o, int ldo, const float* post, float* xout, const float* pre, bf16_t* h) {
    const int tid_ = opaque_tid(); const int lane = tid_ & 63, wv = tid_ >> 6;
    const int stride = gridDim.x * 8;
    f32x4 xn[4]; u32x2 on[4];
#define R_LOAD(rr) do { _Pragma("unroll") for (int j = 0; j < 4; ++j) { xn[j] = __builtin_nontemporal_load((const f32x4*)(xin + (size_t)(rr) * DM + j * 256 + lane * 4)); \
        if (o) on[j] = __builtin_nontemporal_load((const u32x2*)(o + pidx((size_t)(rr), 2048 + j * 256 + lane * 4))); } } while (0)
    int row = blockIdx.x * 8 + wv;
#pragma unroll
    for (int j = 0; j < 4; ++j) on[j] = (u32x2){0u, 0u};
    if (row < T_TOK) R_LOAD(row);
    for (; row < T_TOK; row += stride) {
        f32x4 xv[4]; u32x2 ow[4];
#pragma unroll
        for (int j = 0; j < 4; ++j) { xv[j] = xn[j]; ow[j] = on[j]; }
        if (row + stride < T_TOK) R_LOAD(row + stride);
        if (o) {
            f32x4 ov[4]; float ss = 0.f;
#pragma unroll
            for (int j = 0; j < 4; ++j) { ov[j] = (f32x4){bf_lo(ow[j].x), bf_hi(ow[j].x), bf_lo(ow[j].y), bf_hi(ow[j].y)}; ss += ov[j][0] * ov[j][0] + ov[j][1] * ov[j][1] + ov[j][2] * ov[j][2] + ov[j][3] * ov[j][3]; }
#pragma unroll
            for (int s = 1; s < 64; s <<= 1) ss += __shfl_xor(ss, s);
            const float rs = rsqrtf(ss * (1.0f / DM) + EPS);
#pragma unroll
            for (int j = 0; j < 4; ++j) { const f32x4 pw = *(const f32x4*)(post + j * 256 + lane * 4); xv[j] += ov[j] * rs * pw;
                *(f32x4*)(xout + (size_t)row * DM + j * 256 + lane * 4) = xv[j]; }
        }
        if (pre) {
            float ss = 0.f;
#pragma unroll
            for (int j = 0; j < 4; ++j) ss += xv[j][0] * xv[j][0] + xv[j][1] * xv[j][1] + xv[j][2] * xv[j][2] + xv[j][3] * xv[j][3];
#pragma unroll
            for (int s = 1; s < 64; s <<= 1) ss += __shfl_xor(ss, s);
            const float rs = rsqrtf(ss * (1.0f / DM) + EPS);
#pragma unroll
            for (int j = 0; j < 4; ++j) { const f32x4 pw = *(const f32x4*)(pre + j * 256 + lane * 4); const f32x4 hv = xv[j] * rs * pw;
                u32x2 w; w.x = pk_bf16(hv[0], hv[1]); w.y = pk_bf16(hv[2], hv[3]); *(u32x2*)(h + (size_t)row * DM + j * 256 + lane * 4) = w; }
        }
    }
#undef R_LOAD
}

__device__ void phaseB_gdn(LAS unsigned char* lds, const P& p, int layer, int chunkg, int h) {
    const int tid = opaque_tid(), lane = tid & 63, wid = tid >> 6, r = lane & 15, q = lane >> 4;
    const int c = chunkg & 127;
    const size_t t0 = (size_t)chunkg * 64;
    bf16_t* proj = (bf16_t*)(p.ws + WS_PROJ); const bf16_t* halo = (const bf16_t*)(p.ws + WS_HALO);
    const float* small = (const float*)(p.ws + WS_SMALL);
    LAS bf16_t* kb = (LAS bf16_t*)lds;
    LAS float* rhs = (LAS float*)(lds + 17408);
    LAS float* Am = (LAS float*)(lds + 17408 + 65536);
    LAS float* gS = (LAS float*)(lds + 17408 + 65536 + 16384);
    const float* cw = p.gdn_conv + (size_t)layer * 4 * 1536;
    LAS float* cwS = (LAS float*)(lds + 17408 + 65536 + 16384 + 512);
    float braw = 0.f, araw = 0.f;
    if (wid == 0) { braw = small[(t0 + lane) * 32 + h]; araw = small[(t0 + lane) * 32 + 4 + h]; }
    float wl[3];
#pragma unroll
    for (int k = 0; k < 3; ++k) { const int rem = tid; wl[k] = cw[(rem >> 7) * 1536 + k * 512 + h * 128 + (rem & 127)]; }
    u32x4 xr[3][2][4];
#pragma unroll
    for (int s = 0; s < 3; ++s)
#pragma unroll
        for (int pass = 0; pass < 2; ++pass) {
            const int tok = pass * 32 + (tid >> 4), seg = tid & 15, col = C_GQ + s * 512 + h * 128 + seg * 8;
#pragma unroll
            for (int d = 0; d < 4; ++d) {
                const int tt = tok - 3 + d;
                u32x4 v = (u32x4){0u, 0u, 0u, 0u};
                if (tt >= 0) v = *(const u32x4*)(proj + pidx(t0 + tt, col));
                else if (c > 0) v = *(const u32x4*)(halo + ((size_t)(chunkg - 1) * 3 + (tt + 3)) * 3072 + (col - 2048));
                xr[s][pass][d] = v;
            }
        }
#pragma unroll
    for (int k = 0; k < 3; ++k) cwS[k * 512 + tid] = wl[k];
    if (wid == 0) {
        const float beta = 1.0f / (1.0f + __expf(-braw));
        const float g = -__expf(p.gdn_A_log[layer * 4 + h]) * softplusf(araw + p.gdn_dt_bias[layer * 4 + h]);
        const float gc = wave_scan_incl(g, lane);
        gS[lane] = gc; gS[64 + lane] = beta;
        ((float*)(p.ws + WS_GCUM))[(t0 + lane) * 4 + h] = gc;
    }
    __syncthreads();
    u32x4 qpk[2];
#pragma unroll
    for (int s = 0; s < 3; ++s) {
#pragma unroll
        for (int pass = 0; pass < 2; ++pass) {
            const int tok = pass * 32 + (tid >> 4), seg = tid & 15;
            f32x2 v2[4];
#pragma unroll
            for (int k = 0; k < 4; ++k) v2[k] = (f32x2){0.f, 0.f};
#pragma unroll
            for (int d = 0; d < 4; ++d) {
                f32x2 x2[4]; unpack8(xr[s][pass][d], x2);
                const f32x4 w0 = *(const LAS f32x4*)(cwS + s * 512 + d * 128 + seg * 8), w1 = *(const LAS f32x4*)(cwS + s * 512 + d * 128 + seg * 8 + 4);
                v2[0] = __builtin_elementwise_fma((f32x2){w0[0], w0[1]}, x2[0], v2[0]); v2[1] = __builtin_elementwise_fma((f32x2){w0[2], w0[3]}, x2[1], v2[1]);
                v2[2] = __builtin_elementwise_fma((f32x2){w1[0], w1[1]}, x2[2], v2[2]); v2[3] = __builtin_elementwise_fma((f32x2){w1[2], w1[3]}, x2[3], v2[3]);
            }
            f32x2 ss2 = (f32x2){0.f, 0.f};
#pragma unroll
            for (int k = 0; k < 4; ++k) { v2[k] = silu2(v2[k]); ss2 = __builtin_elementwise_fma(v2[k], v2[k], ss2); }
            float ss = ss2[0] + ss2[1];
            if (s < 2) {
                ss += __shfl_xor(ss, 1); ss += __shfl_xor(ss, 2); ss += __shfl_xor(ss, 4); ss += __shfl_xor(ss, 8);
                const float rn = rsqrtf(ss + EPS) * (s == 0 ? 0.08838834764831845f : 1.0f);
#pragma unroll
                for (int k = 0; k < 4; ++k) v2[k] *= rn;
            }
            const float val[8] = {v2[0][0], v2[0][1], v2[1][0], v2[1][1], v2[2][0], v2[2][1], v2[3][0], v2[3][1]};
            if (s == 0) {
                u32x4 w; w.x = pk_bf16(val[0], val[1]); w.y = pk_bf16(val[2], val[3]); w.z = pk_bf16(val[4], val[5]); w.w = pk_bf16(val[6], val[7]);
                qpk[pass] = w;
            } else if (s == 1) {
                u32x4 w; w.x = pk_bf16(val[0], val[1]); w.y = pk_bf16(val[2], val[3]); w.z = pk_bf16(val[4], val[5]); w.w = pk_bf16(val[6], val[7]);
                *(LAS u32x4*)(kb + tok * 136 + seg * 8) = w;
                const float f = gS[64 + tok] * __expf(gS[tok]);
                *(LAS f32x4*)(rhs + tok * 256 + 128 + seg * 8) = (f32x4){f * val[0], f * val[1], f * val[2], f * val[3]};
                *(LAS f32x4*)(rhs + tok * 256 + 128 + seg * 8 + 4) = (f32x4){f * val[4], f * val[5], f * val[6], f * val[7]};
            } else {
                const float f = gS[64 + tok];
                *(LAS f32x4*)(rhs + tok * 256 + seg * 8) = (f32x4){f * val[0], f * val[1], f * val[2], f * val[3]};
                *(LAS f32x4*)(rhs + tok * 256 + seg * 8 + 4) = (f32x4){f * val[4], f * val[5], f * val[6], f * val[7]};
            }
        }
    }
    __syncthreads();
#pragma unroll
    for (int pass = 0; pass < 2; ++pass) {
        const int item = pass * 512 + tid, tok = item >> 4, seg = item & 15;
        *(u32x4*)(proj + pidx(t0 + tok, C_GQ + h * 128 + seg * 8)) = qpk[pass];
    }
#pragma unroll
    for (int tt = 0; tt < 2; ++tt) {
        const int id = wid * 2 + tt, mt = id >> 2, nt = id & 3;
        f32x4 acc = (f32x4){0.f, 0.f, 0.f, 0.f};
        acc = mma_tile<4>(acc, kb + mt * 16 * 136, 136, kb + nt * 16 * 136, 136, r, q);
        const int j = nt * 16 + r; const float gj = gS[j];
        f32x4 av;
#pragma unroll
        for (int jj = 0; jj < 4; ++jj) {
            const int i = mt * 16 + q * 4 + jj;
            av[jj] = (j < i) ? -(gS[64 + i] * acc[jj] * __expf(gS[i] - gj)) : 0.f;
        }
        *(LAS f32x4*)(Am + j * 64 + mt * 16 + q * 4) = av;
    }
    __syncthreads();
    if (tid < 256) {
        float xs[64];
        int zoff; asm volatile("v_mov_b32 %0, 0" : "=v"(zoff));
        const LAS float* Az = Am + zoff;
        {
            f32x2 x2[32];
#pragma unroll
            for (int k = 0; k < 32; ++k) x2[k] = (f32x2){rhs[(2 * k) * 256 + tid], rhs[(2 * k + 1) * 256 + tid]};
            f32x4 an[16], ac[16];
#pragma unroll
            for (int k = 0; k < 16; ++k) an[k] = *(const LAS f32x4*)(Az + 4 * k);
#pragma unroll
            for (int j = 0; j < 63; ++j) {
#pragma unroll
                for (int k = 0; k < 16; ++k) ac[k] = an[k];
                if (j + 1 < 63) {
#pragma unroll
                    for (int k = (j + 2) / 4; k < 16; ++k) an[k] = *(const LAS f32x4*)(Az + (j + 1) * 64 + 4 * k);
                }
                __builtin_amdgcn_sched_barrier(0);
                const float xj = x2[j >> 1][j & 1];
                const f32x2 xj2 = (f32x2){xj, xj};
#pragma unroll
                for (int k = (j + 1) >> 1; k < 32; ++k) {
                    const f32x2 a2 = (k & 1) ? (f32x2){ac[k >> 1][2], ac[k >> 1][3]} : (f32x2){ac[k >> 1][0], ac[k >> 1][1]};
                    x2[k] = __builtin_elementwise_fma(a2, xj2, x2[k]);
                }
                __builtin_amdgcn_sched_barrier(0);
            }
#pragma unroll
            for (int k = 0; k < 32; ++k) { xs[2 * k] = x2[k][0]; xs[2 * k + 1] = x2[k][1]; }
        }
        if (tid < 128) {
            const int e = tid >> 6, dvl = tid & 63;
            bf16_t* dst = proj + pidx(t0 + dvl, C_GV + h * 128 + e * 64);
#pragma unroll
            for (int k = 0; k < 8; ++k) {
                u32x4 w; w.x = pk_bf16(xs[8 * k], xs[8 * k + 1]); w.y = pk_bf16(xs[8 * k + 2], xs[8 * k + 3]); w.z = pk_bf16(xs[8 * k + 4], xs[8 * k + 5]); w.w = pk_bf16(xs[8 * k + 6], xs[8 * k + 7]);
                *(u32x4*)(dst + 8 * k) = w;
            }
        } else {
            bf16_t* wb = (bf16_t*)(p.ws + WS_WBUF) + t0 * 512 + h * 128 + (tid - 128);
#pragma unroll
            for (int i = 0; i < 64; ++i) wb[(size_t)i * 512] = (bf16_t)(pk_bf16(xs[i], 0.f) & 0xffffu);
        }
    }
#pragma unroll
    for (int pass = 0; pass < 2; ++pass) {
        const int item = pass * 512 + tid, tok = item >> 4, seg = item & 15;
        *(u32x4*)(proj + pidx(t0 + tok, C_GK + h * 128 + seg * 8)) = *(const LAS u32x4*)(kb + tok * 136 + seg * 8);
    }
    __syncthreads();
}
__device__ void phaseB_ssd(const P& p, int layer, int chunkg) {
    const int tid = opaque_tid(), lane = tid & 63, wid = tid >> 6;
    const int c = chunkg & 127;
    const size_t t0 = (size_t)chunkg * 64;
    bf16_t* proj = (bf16_t*)(p.ws + WS_PROJ); const bf16_t* halo = (const bf16_t*)(p.ws + WS_HALO);
    const float* small = (const float*)(p.ws + WS_SMALL);
#pragma unroll
    for (int k = 0; k < 2; ++k) {
        const int hd = wid * 2 + k;
        const float dt = softplusf(small[(t0 + lane) * 32 + 8 + hd] + p.ssd_dt_bias[layer * 16 + hd]);
        const float a = -__expf(p.ssd_A_log[layer * 16 + hd]) * dt;
        const float ac = wave_scan_incl(a, lane);
        { ((float*)(p.ws + WS_DT))[(t0 + lane) * 16 + hd] = dt;
        ((float*)(p.ws + WS_ACUM))[(t0 + lane) * 16 + hd] = ac; }
    }
    const int seg = tid % 192, half = tid / 192;
    const int col = C_SX + seg * 8, ch = seg * 8;
    const bool act = tid < 384;
    u32x4 win[3];
    win[0] = win[1] = win[2] = (u32x4){0u, 0u, 0u, 0u};
    u32x4 rows[32];
    f32x2 wg2[4][4], bias2[4];
    if (act) {
        if (half == 1) {
#pragma unroll
            for (int d = 0; d < 3; ++d) win[d] = *(const u32x4*)(proj + pidx(t0 + 29 + d, col));
        } else if (c > 0) {
#pragma unroll
            for (int d = 0; d < 3; ++d) win[d] = *(const u32x4*)(halo + ((size_t)(chunkg - 1) * 3 + d) * 3072 + (col - 2048));
        }
#pragma unroll
        for (int k = 0; k < 32; ++k) rows[k] = *(const u32x4*)(proj + pidx(t0 + half * 32 + k, col));
        const float* cw = p.ssd_conv + (size_t)layer * 4 * 1536; const float* cb = p.ssd_conv_b + (size_t)layer * 1536;
#pragma unroll
        for (int d = 0; d < 4; ++d) {
            const f32x4 a = *(const f32x4*)(cw + d * 1536 + ch), bq = *(const f32x4*)(cw + d * 1536 + ch + 4);
            wg2[d][0] = (f32x2){a[0], a[1]}; wg2[d][1] = (f32x2){a[2], a[3]}; wg2[d][2] = (f32x2){bq[0], bq[1]}; wg2[d][3] = (f32x2){bq[2], bq[3]};
        }
        { const f32x4 a = *(const f32x4*)(cb + ch), bq = *(const f32x4*)(cb + ch + 4);
          bias2[0] = (f32x2){a[0], a[1]}; bias2[1] = (f32x2){a[2], a[3]}; bias2[2] = (f32x2){bq[0], bq[1]}; bias2[3] = (f32x2){bq[2], bq[3]}; }
    }
    __syncthreads();
    if (act) {
        f32x2 w0[4], w1[4], w2[4];
        unpack8(win[0], w0); unpack8(win[1], w1); unpack8(win[2], w2);
#pragma unroll
        for (int k = 0; k < 32; ++k) {
            f32x2 x3[4]; unpack8(rows[k], x3);
            f32x2 v2[4];
#pragma unroll
            for (int e = 0; e < 4; ++e) {
                f32x2 a = __builtin_elementwise_fma(wg2[0][e], w0[e], bias2[e]);
                a = __builtin_elementwise_fma(wg2[1][e], w1[e], a);
                a = __builtin_elementwise_fma(wg2[2][e], w2[e], a);
                a = __builtin_elementwise_fma(wg2[3][e], x3[e], a);
                v2[e] = silu2(a);
                w0[e] = w1[e]; w1[e] = w2[e]; w2[e] = x3[e];
            }
            u32x4 w; w.x = pk_bf16(v2[0][0], v2[0][1]); w.y = pk_bf16(v2[1][0], v2[1][1]); w.z = pk_bf16(v2[2][0], v2[2][1]); w.w = pk_bf16(v2[3][0], v2[3][1]);
            *(u32x4*)(proj + pidx(t0 + half * 32 + k, col)) = w;
        }
    }
}
__device__ void phaseB_ret(const P& p, int chunkg) {
    const int tid = opaque_tid();
    const int c = chunkg & 127;
    const size_t t0 = (size_t)chunkg * 64;
    bf16_t* proj = (bf16_t*)(p.ws + WS_PROJ);
    const int tok = tid >> 3, pg = tid & 7;
    const float pos = (float)(c * 64 + tok);
    float cs[8], sn[8];
#pragma unroll
    for (int e = 0; e < 8; ++e) {
        const float inv = exp2f(-(float)(pg * 8 + e) * (13.287712379549449f / 64.0f));
        const float ang = pos * inv;
        const float n = rintf(ang * 0.15915494309189535f);
        float rr = fmaf(-n, 6.28125f, ang); rr = fmaf(-n, 0.0019353071795864769f, rr);
        cs[e] = __cosf(rr); sn[e] = __sinf(rr);
    }
    u32x4 ra[4][2], rb[4][2];
#pragma unroll
    for (int hh = 0; hh < 4; ++hh)
#pragma unroll
        for (int s = 0; s < 2; ++s) {
            const bf16_t* base = proj + pidx(t0 + tok, (s == 0 ? C_RQ : C_RK) + hh * 128 + pg * 8);
            ra[hh][s] = *(const u32x4*)base; rb[hh][s] = *(const u32x4*)(base + 64);
        }
#pragma unroll
    for (int hh = 0; hh < 4; ++hh)
#pragma unroll
        for (int s = 0; s < 2; ++s) {
            bf16_t* base = proj + pidx(t0 + tok, (s == 0 ? C_RQ : C_RK) + hh * 128 + pg * 8);
            const float sc = s == 0 ? 1.0f : 0.08838834764831845f;
            const u32x4 a = ra[hh][s], b = rb[hh][s];
            const float t1[8] = {bf_lo(a.x), bf_hi(a.x), bf_lo(a.y), bf_hi(a.y), bf_lo(a.z), bf_hi(a.z), bf_lo(a.w), bf_hi(a.w)};
            const float t2[8] = {bf_lo(b.x), bf_hi(b.x), bf_lo(b.y), bf_hi(b.y), bf_lo(b.z), bf_hi(b.z), bf_lo(b.w), bf_hi(b.w)};
            float o1[8], o2[8];
#pragma unroll
            for (int e = 0; e < 8; ++e) { o1[e] = (t1[e] * cs[e] - t2[e] * sn[e]) * sc; o2[e] = (t1[e] * sn[e] + t2[e] * cs[e]) * sc; }
            u32x4 w1, w2;
            w1.x = pk_bf16(o1[0], o1[1]); w1.y = pk_bf16(o1[2], o1[3]); w1.z = pk_bf16(o1[4], o1[5]); w1.w = pk_bf16(o1[6], o1[7]);
            w2.x = pk_bf16(o2[0], o2[1]); w2.y = pk_bf16(o2[2], o2[3]); w2.z = pk_bf16(o2[4], o2[5]); w2.w = pk_bf16(o2[6], o2[7]);
            { *(u32x4*)base = w1; *(u32x4*)(base + 64) = w2; }
        }
}

constexpr int L_QS = 0, L_KS = 17408, L_WS = 34816, L_ST = 52224, L_VT = 69632, L_VST = 78848, L_AT = 88064, L_UT = 97280, L_CUM = 106496, L_DT = 106752;
constexpr int L_ALT = 107008;
constexpr int D_KS = L_ALT - L_KS, D_ST = L_ALT + 17408 - L_ST, D_VT = L_ALT + 34816 - L_VT, D_VST = L_ALT + 44032 - L_VST, D_CUM = L_ALT + 53248 - L_CUM;
typedef short s16x4 __attribute__((ext_vector_type(4)));
DI bf16x8 ldfrag_tr(const LAS bf16_t* X, int ld, int k0, int m0, int r, int q) {
    const LAS bf16_t* a = X + (k0 + q * 8 + (r >> 2)) * ld + m0 + 4 * (r & 3);
    const s16x4 lo = __builtin_amdgcn_ds_read_tr16_b64_v4i16((LAS s16x4*)a);
    const s16x4 hi = __builtin_amdgcn_ds_read_tr16_b64_v4i16((LAS s16x4*)(a + 4 * ld));
    return __builtin_shufflevector(lo, hi, 0, 1, 2, 3, 4, 5, 6, 7);
}
template <int KIND>
__device__ void phaseC_item(LAS unsigned char* lds, const P& p, int layer, int sub) {
    const int tid = opaque_tid(), lane = tid & 63, wid = __builtin_amdgcn_readfirstlane(tid >> 6), r = lane & 15, q = lane >> 4;
    bf16_t* proj = (bf16_t*)(p.ws + WS_PROJ);
    int b, qcol, kcol, vcol, hidx; float Dval = 0.f, lg = 0.f;
    if (KIND == 0) { b = sub >> 3; const int h = (sub >> 1) & 3, e = sub & 1; hidx = h; qcol = C_GQ + h * 128; kcol = C_GK + h * 128; vcol = C_GV + h * 128 + e * 64; }
    else if (KIND == 1) { b = sub >> 4; const int hd = sub & 15, grp = hd >> 3; hidx = hd; qcol = C_SC + grp * 128; kcol = C_SB + grp * 128; vcol = C_SX + hd * 64; Dval = p.ssd_D[layer * 16 + hd]; }
    else { b = sub >> 3; const int h = (sub >> 1) & 3, e = sub & 1; hidx = h; qcol = C_RQ + h * 128; kcol = C_RK + h * 128; vcol = C_RV + h * 128 + e * 64; lg = logf(1.0f - exp2f(-5.0f - (float)h)); }
    LAS bf16_t* Qs = (LAS bf16_t*)(lds + L_QS); LAS bf16_t* Ws = (LAS bf16_t*)(lds + L_WS);
    LAS bf16_t* AT = (LAS bf16_t*)(lds + L_AT); LAS bf16_t* UT = (LAS bf16_t*)(lds + L_UT);
    const bf16_t* Wbuf = (const bf16_t*)(p.ws + WS_WBUF);
    const float* gate = KIND == 0 ? (const float*)(p.ws + WS_GCUM) : (const float*)(p.ws + WS_ACUM);
    const float* gdt = (const float*)(p.ws + WS_DT);
    const int gstride = KIND == 0 ? 4 : 16;
    for (int i = tid; i < 17408 / 16; i += 512) *(LAS u32x4*)(lds + L_ST + i * 16) = (u32x4){0u, 0u, 0u, 0u};
    f32x4 Sacc[4];
#pragma unroll
    for (int n = 0; n < 4; ++n) Sacc[n] = (f32x4){0.f, 0.f, 0.f, 0.f};
    u32x4 pq[2], pk[2], pw[2], pv; float pcum = 0.f, pcl = 0.f, pdt = 1.f, pcum2 = 0.f, pdt2 = 1.f;
    const int mt = wid >> 1, nt0 = (wid & 1) * 2;
    u32x2 pz0 = (u32x2){0u, 0u}, pz1 = pz0, cz0 = pz0, cz1 = pz0;
    const int zcol = C_SZ + (vcol - C_SX);
    const int mytok = tid & 63, vtok = tid >> 3, vseg = tid & 7;
#define PREFETCH(cc) do { const size_t t0_ = ((size_t)b * NCHUNK + (cc)) * 64; \
        _Pragma("unroll") for (int it = 0; it < 2; ++it) { const int pp = tid + 512 * it; \
            pq[it] = *(const u32x4*)(proj + pidx(t0_ + (pp >> 4), qcol + (pp & 15) * 8)); \
            pk[it] = *(const u32x4*)(proj + pidx(t0_ + (pp >> 4), kcol + (pp & 15) * 8)); \
            if (KIND == 0) pw[it] = *(const u32x4*)(Wbuf + (t0_ + (pp >> 4)) * 512 + hidx * 128 + (pp & 15) * 8); } \
        pv = *(const u32x4*)(proj + pidx(t0_ + vtok, vcol + vseg * 8)); \
        if (KIND != 2) { pcum = gate[(t0_ + mytok) * gstride + hidx]; pcl = gate[(t0_ + 63) * gstride + hidx]; } \
        else { pcum = (float)(mytok + 1) * lg; pcl = 64.0f * lg; } \
        if (KIND == 1) { pdt = gdt[(t0_ + mytok) * 16 + hidx]; pdt2 = gdt[(t0_ + vtok) * 16 + hidx]; pcum2 = gate[(t0_ + vtok) * gstride + hidx]; } \
        if (KIND == 2) pcum2 = (float)(vtok + 1) * lg; \
        if (KIND == 1) { pz0 = *(const u32x2*)(proj + pidx(t0_ + nt0 * 16 + r, zcol + mt * 16 + q * 4)); pz1 = *(const u32x2*)(proj + pidx(t0_ + (nt0 + 1) * 16 + r, zcol + mt * 16 + q * 4)); } } while (0)
    PREFETCH(0);
    u32x2 ow0 = (u32x2){0u, 0u}, ow1 = ow0;
    for (int c = 0; c < NCHUNK; ++c) {
        const size_t t0 = ((size_t)b * NCHUNK + c) * 64;
        const int par = c & 1;
        LAS bf16_t* Ks = (LAS bf16_t*)(lds + L_KS + par * D_KS); LAS bf16_t* ST = (LAS bf16_t*)(lds + L_ST + par * D_ST); LAS bf16_t* STn = (LAS bf16_t*)(lds + L_ST + (par ^ 1) * D_ST);
        LAS bf16_t* VT = (LAS bf16_t*)(lds + L_VT + par * D_VT);
        LAS bf16_t* VST = (LAS bf16_t*)(lds + L_VST + par * D_VST);
        LAS float* cumS = (LAS float*)(lds + L_CUM + par * D_CUM); LAS float* dtS = cumS + 64;
#pragma unroll
        for (int it = 0; it < 2; ++it) {
            const int pp = tid + 512 * it;
            *(LAS u32x4*)(Qs + (pp >> 4) * 136 + (pp & 15) * 8) = pq[it];
            *(LAS u32x4*)(Ks + (pp >> 4) * 136 + (pp & 15) * 8) = pk[it];
            if (KIND == 0) *(LAS u32x4*)(Ws + (pp >> 4) * 136 + (pp & 15) * 8) = pw[it];
        }
        if (KIND == 0) {
            *(LAS u32x4*)(UT + vtok * 72 + vseg * 8) = pv;
        } else {
            const float sa = KIND == 1 ? pdt2 : 1.0f, sb = sa * __expf(pcl - pcum2);
            const float v0 = bf_lo(pv.x), v1 = bf_hi(pv.x), v2 = bf_lo(pv.y), v3 = bf_hi(pv.y), v4 = bf_lo(pv.z), v5 = bf_hi(pv.z), v6 = bf_lo(pv.w), v7 = bf_hi(pv.w);
            u32x4 wa = pv;
            if (KIND == 1) { wa.x = pk_bf16(v0 * sa, v1 * sa); wa.y = pk_bf16(v2 * sa, v3 * sa); wa.z = pk_bf16(v4 * sa, v5 * sa); wa.w = pk_bf16(v6 * sa, v7 * sa); }
            u32x4 wb; wb.x = pk_bf16(v0 * sb, v1 * sb); wb.y = pk_bf16(v2 * sb, v3 * sb); wb.z = pk_bf16(v4 * sb, v5 * sb); wb.w = pk_bf16(v6 * sb, v7 * sb);
            *(LAS u32x4*)(VT + vtok * 72 + vseg * 8) = wa;
            *(LAS u32x4*)(VST + vtok * 72 + vseg * 8) = wb;
        }
        if (tid < 64) { cumS[tid] = pcum; if (KIND == 1) dtS[tid] = pdt; }
        if (KIND == 1) { cz0 = pz0; cz1 = pz1; }
        if (c > 0) {
            *(u32x2*)(proj + pidx(t0 - 64 + nt0 * 16 + r, vcol + mt * 16 + q * 4)) = ow0;
            *(u32x2*)(proj + pidx(t0 - 64 + (nt0 + 1) * 16 + r, vcol + mt * 16 + q * 4)) = ow1;
        }
        __syncthreads();
        if (c + 1 < NCHUNK) PREFETCH(c + 1);
        const float cl = cumS[63];
        bf16x8 gb[2][4];
        {
            bf16x8 fa[4], fb[2][4], ga[4];
            if (KIND == 0) { ldfrag<4>(fa, Ws + mt * 16 * 136, 136, r, q); ldfrag<4>(fb[0], ST + nt0 * 16 * 136, 136, r, q); ldfrag<4>(fb[1], ST + (nt0 + 1) * 16 * 136, 136, r, q); }
            ldfrag<4>(ga, Ks + mt * 16 * 136, 136, r, q); ldfrag<4>(gb[0], Qs + nt0 * 16 * 136, 136, r, q); ldfrag<4>(gb[1], Qs + (nt0 + 1) * 16 * 136, 136, r, q);
            const f32x4 cj = *(const LAS f32x4*)(cumS + mt * 16 + q * 4);
            u32x2 uu[2]; float ci[2], dti[2];
#pragma unroll
            for (int tt = 0; tt < 2; ++tt) {
                if (KIND == 0) uu[tt] = *(const LAS u32x2*)(UT + ((nt0 + tt) * 16 + r) * 72 + mt * 16 + q * 4);
                ci[tt] = cumS[(nt0 + tt) * 16 + r];
                if (KIND == 1) dti[tt] = dtS[(nt0 + tt) * 16 + r];
            }
            __builtin_amdgcn_sched_barrier(0);
            if (KIND == 0) {
                f32x4 a0 = (f32x4){0.f, 0.f, 0.f, 0.f}, a1 = a0;
                a0 = mmafrag<4>(a0, fa, fb[0]); a1 = mmafrag<4>(a1, fa, fb[1]);
                const float e0 = __expf(cl - cj[0]), e1 = __expf(cl - cj[1]), e2 = __expf(cl - cj[2]), e3 = __expf(cl - cj[3]);
#pragma unroll
                for (int tt = 0; tt < 2; ++tt) {
                    const f32x4 acc = tt ? a1 : a0;
                    const float v0 = bf_lo(uu[tt].x) - acc[0], v1 = bf_hi(uu[tt].x) - acc[1], v2 = bf_lo(uu[tt].y) - acc[2], v3 = bf_hi(uu[tt].y) - acc[3];
                    u32x2 w; w.x = pk_bf16(v0, v1); w.y = pk_bf16(v2, v3);
                    *(LAS u32x2*)(VT + ((nt0 + tt) * 16 + r) * 72 + mt * 16 + q * 4) = w;
                    u32x2 ws; ws.x = pk_bf16(v0 * e0, v1 * e1); ws.y = pk_bf16(v2 * e2, v3 * e3);
                    *(LAS u32x2*)(VST + ((nt0 + tt) * 16 + r) * 72 + mt * 16 + q * 4) = ws;
                }
            }
            {
                f32x4 a0 = (f32x4){0.f, 0.f, 0.f, 0.f}, a1 = a0;
                a0 = mmafrag<4>(a0, ga, gb[0]); a1 = mmafrag<4>(a1, ga, gb[1]);
#pragma unroll
                for (int tt = 0; tt < 2; ++tt) {
                    const f32x4 acc = tt ? a1 : a0;
                    const int i = (nt0 + tt) * 16 + r;
                    float f[4];
#pragma unroll
                    for (int jj = 0; jj < 4; ++jj) {
                        const int j = mt * 16 + q * 4 + jj;
                        float v = (j <= i) ? acc[jj] * __expf(ci[tt] - cj[jj]) : 0.f;
                        if (KIND == 1 && j == i) v += Dval * __builtin_amdgcn_rcpf(dti[tt]);
                        f[jj] = v;
                    }
                    u32x2 w; w.x = pk_bf16(f[0], f[1]); w.y = pk_bf16(f[2], f[3]);
                    *(LAS u32x2*)(AT + i * 72 + mt * 16 + q * 4) = w;
                }
            }
        }
        __syncthreads();
        {
            bf16x8 sa[4], va[2], ab[2][2], ka[2], vb[4][2];
            ldfrag<4>(sa, ST + mt * 16 * 136, 136, r, q);
            ldfrag<2>(ab[0], AT + nt0 * 16 * 72, 72, r, q); ldfrag<2>(ab[1], AT + (nt0 + 1) * 16 * 72, 72, r, q);
            if (KIND == 0) {
                ldfrag<2>(va, VT + mt * 16 * 72, 72, r, q);
#pragma unroll
                for (int n = 0; n < 4; ++n) ldfrag<2>(vb[n], VST + n * 16 * 72, 72, r, q);
            } else {
#pragma unroll
                for (int ks = 0; ks < 2; ++ks) {
                    va[ks] = ldfrag_tr(VT, 72, ks * 32, mt * 16, r, q);
#pragma unroll
                    for (int n = 0; n < 4; ++n) vb[n][ks] = ldfrag_tr(VST, 72, ks * 32, n * 16, r, q);
                }
            }
#pragma unroll
            for (int ks = 0; ks < 2; ++ks) ka[ks] = ldfrag_tr(Ks, 136, ks * 32, wid * 16, r, q);
            const float ei0 = __expf(cumS[nt0 * 16 + r]), ei1 = __expf(cumS[(nt0 + 1) * 16 + r]);
            const float dl = __expf(cl);
            __builtin_amdgcn_sched_barrier(0);
            f32x4 o0 = (f32x4){0.f, 0.f, 0.f, 0.f}, o1 = o0;
            o0 = mmafrag<4>(o0, sa, gb[0]); o1 = mmafrag<4>(o1, sa, gb[1]);
            o0 *= ei0; o1 *= ei1;
            o0 = mmafrag<2>(o0, va, ab[0]); o1 = mmafrag<2>(o1, va, ab[1]);
#pragma unroll
            for (int n = 0; n < 4; ++n) { Sacc[n] *= dl; Sacc[n] = mmafrag<2>(Sacc[n], ka, vb[n]); }
            if (KIND == 1) {
                o0[0] *= siluf(bf_lo(cz0.x)); o0[1] *= siluf(bf_hi(cz0.x)); o0[2] *= siluf(bf_lo(cz0.y)); o0[3] *= siluf(bf_hi(cz0.y));
                o1[0] *= siluf(bf_lo(cz1.x)); o1[1] *= siluf(bf_hi(cz1.x)); o1[2] *= siluf(bf_lo(cz1.y)); o1[3] *= siluf(bf_hi(cz1.y));
            }
            ow0.x = pk_bf16(o0[0], o0[1]); ow0.y = pk_bf16(o0[2], o0[3]);
            ow1.x = pk_bf16(o1[0], o1[1]); ow1.y = pk_bf16(o1[2], o1[3]);
        }
#pragma unroll
        for (int n = 0; n < 4; ++n) {
            u32x2 w; w.x = pk_bf16(Sacc[n][0], Sacc[n][1]); w.y = pk_bf16(Sacc[n][2], Sacc[n][3]);
            *(LAS u32x2*)(STn + (n * 16 + r) * 136 + wid * 16 + q * 4) = w;
        }
    }
    {
        const size_t tl = ((size_t)b * NCHUNK + NCHUNK - 1) * 64;
        *(u32x2*)(proj + pidx(tl + nt0 * 16 + r, vcol + mt * 16 + q * 4)) = ow0;
        *(u32x2*)(proj + pidx(tl + (nt0 + 1) * 16 + r, vcol + mt * 16 + q * 4)) = ow1;
    }
    __syncthreads();
#undef PREFETCH
}

__device__ void phaseD(const P& p, int layer) {
    const int tid_ = opaque_tid(); const int lane = tid_ & 63, wv = tid_ >> 6;
    bf16_t* proj = (bf16_t*)(p.ws + WS_PROJ);
    const float* gw = p.gdn_norm + layer * 128; const float* rw = p.ret_norm + layer * 128; const float* sw = p.ssd_norm + layer * 1024;
    const int stride = gridDim.x * 8;
    u32x4 cur[8], nxt[8];
#define D_LOAD(dst, rr) do { const size_t rr_ = (size_t)(rr); \
        dst[0] = __builtin_nontemporal_load((const u32x4*)(proj + pidx(rr_, C_GV + lane * 8))); dst[1] = __builtin_nontemporal_load((const u32x4*)(proj + pidx(rr_, C_GZ + lane * 8))); \
        dst[2] = __builtin_nontemporal_load((const u32x4*)(proj + pidx(rr_, C_RV + lane * 8))); dst[3] = __builtin_nontemporal_load((const u32x4*)(proj + pidx(rr_, C_RG + lane * 8))); \
        dst[4] = __builtin_nontemporal_load((const u32x4*)(proj + pidx(rr_, C_SX + lane * 16))); dst[5] = (u32x4){0u, 0u, 0u, 0u}; \
        dst[6] = __builtin_nontemporal_load((const u32x4*)(proj + pidx(rr_, C_SX + lane * 16 + 8))); dst[7] = (u32x4){0u, 0u, 0u, 0u}; } while (0)
    int row = blockIdx.x * 8 + wv;
    if (row < T_TOK) D_LOAD(nxt, row);
    for (; row < T_TOK; row += stride) {
#pragma unroll
        for (int k = 0; k < 8; ++k) cur[k] = nxt[k];
        if (row + stride < T_TOK) D_LOAD(nxt, row + stride);
#pragma unroll
        for (int s = 0; s < 2; ++s) {
            const int zc = (s == 0 ? C_GZ : C_RG) + lane * 8;
            const float* nw = (s == 0 ? gw : rw) + (lane & 15) * 8;
            const u32x4 o = cur[2 * s], z = cur[2 * s + 1];
            float ov[8] = {bf_lo(o.x), bf_hi(o.x), bf_lo(o.y), bf_hi(o.y), bf_lo(o.z), bf_hi(o.z), bf_lo(o.w), bf_hi(o.w)};
            const float zv[8] = {bf_lo(z.x), bf_hi(z.x), bf_lo(z.y), bf_hi(z.y), bf_lo(z.z), bf_hi(z.z), bf_lo(z.w), bf_hi(z.w)};
            float ss = 0.f;
#pragma unroll
            for (int e = 0; e < 8; ++e) ss += ov[e] * ov[e];
            ss += __shfl_xor(ss, 1); ss += __shfl_xor(ss, 2); ss += __shfl_xor(ss, 4); ss += __shfl_xor(ss, 8);
            const float rs = rsqrtf(ss * (1.0f / 128.0f) + EPS);
#pragma unroll
            for (int e = 0; e < 8; ++e) ov[e] = ov[e] * rs * nw[e] * siluf(zv[e]);
            u32x4 w; w.x = pk_bf16(ov[0], ov[1]); w.y = pk_bf16(ov[2], ov[3]); w.z = pk_bf16(ov[4], ov[5]); w.w = pk_bf16(ov[6], ov[7]);
            *(u32x4*)(proj + pidx((size_t)row, zc)) = w;
        }
        {
            float yv[16];
#pragma unroll
            for (int k = 0; k < 2; ++k) {
                const u32x4 o = cur[4 + 2 * k], z = cur[5 + 2 * k];
                const float ov[8] = {bf_lo(o.x), bf_hi(o.x), bf_lo(o.y), bf_hi(o.y), bf_lo(o.z), bf_hi(o.z), bf_lo(o.w), bf_hi(o.w)};
                const float zv[8] = {bf_lo(z.x), bf_hi(z.x), bf_lo(z.y), bf_hi(z.y), bf_lo(z.z), bf_hi(z.z), bf_lo(z.w), bf_hi(z.w)};
#pragma unroll
                for (int e = 0; e < 8; ++e) yv[k * 8 + e] = ov[e];
            }
            float ss = 0.f;
#pragma unroll
            for (int e = 0; e < 16; ++e) ss += yv[e] * yv[e];
            ss += __shfl_xor(ss, 1); ss += __shfl_xor(ss, 2); ss += __shfl_xor(ss, 4); ss += __shfl_xor(ss, 8); ss += __shfl_xor(ss, 16);
            const float rs = rsqrtf(ss * (1.0f / 512.0f) + EPS);
#pragma unroll
            for (int k = 0; k < 2; ++k) {
                const float* nw = sw + lane * 16 + k * 8;
                u32x4 w; w.x = pk_bf16(yv[k * 8] * rs * nw[0], yv[k * 8 + 1] * rs * nw[1]); w.y = pk_bf16(yv[k * 8 + 2] * rs * nw[2], yv[k * 8 + 3] * rs * nw[3]);
                w.z = pk_bf16(yv[k * 8 + 4] * rs * nw[4], yv[k * 8 + 5] * rs * nw[5]); w.w = pk_bf16(yv[k * 8 + 6] * rs * nw[6], yv[k * 8 + 7] * rs * nw[7]);
                *(u32x4*)(proj + pidx((size_t)row, C_SZ + lane * 16 + k * 8)) = w;
            }
        }
    }
#undef D_LOAD
}

__global__ void __launch_bounds__(512, 2) hybrid_fwd(P p) {
    extern __shared__ __attribute__((aligned(16))) unsigned char lds_raw[];
    LAS unsigned char* lds = (LAS unsigned char*)lds_raw;
    cg::grid_group grid = cg::this_grid();
    const int G = gridDim.x, bx = blockIdx.x;
    bf16_t* proj = (bf16_t*)(p.ws + WS_PROJ);
    bf16_t* hbuf = (bf16_t*)(p.ws + WS_H);
    if (threadIdx.x == 0) *(LAS u32x4*)(lds + LDS_BAR_OFF) = (u32x4){0u, 0u, 0u, 0u};
    __syncthreads();
    XcdBarrier xb = xcd_barrier_post((unsigned*)(p.ws + WS_BAR), (volatile LAS unsigned*)(lds + LDS_BAR_OFF));
    int nsync = 0;
    for (int ph = p.ph_lo; ph < p.ph_hi; ++ph) {
        if (ph > p.ph_lo) { if (nsync == 0) grid.sync(); else xcd_barrier(xb); ++nsync; }
        const int layer = ph >= 7 ? 1 : 0, sub = ph == 0 ? 0 : (ph - 1) % 6 + 1;
        if (sub == 0) {
            phase_convert(p);
            phase_rows(p.x, nullptr, 0, nullptr, nullptr, p.pre_norm, hbuf);
        } else if (sub == 1) {
            pg8::Gemm g; g.A = hbuf; g.Bt = (const bf16_t*)(p.ws + WS_WIN) + (size_t)layer * NPW * DM; g.M = T_TOK; g.N = NPW; g.K = DM; g.lda = DM; g.atiled = 0;
            pg8::StaticOrder S; S.init(g.M, g.N, G, bx);
            EpiProj E; E.proj = proj; E.small = (float*)(p.ws + WS_SMALL); E.halo = (bf16_t*)(p.ws + WS_HALO);
            pg8::gemm_phase<EpiProj>(lds, g, S, E);
        } else if (sub == 2) {
            for (int it = bx; it < 1024 * 6; it += G) {
                const int chunkg = it & 1023, kind = it >> 10;
                if (kind < 4) phaseB_gdn(lds, p, layer, chunkg, kind);
                else if (kind == 4) phaseB_ssd(p, layer, chunkg);
                else phaseB_ret(p, chunkg);
            }
        } else if (sub == 3) {
            for (int it = bx; it < 256; it += G) {
                int kind, sub;
                if (G == 256) {
                    const int xcd = it & 7, s = it >> 3;
                    if (s < 8) { kind = 0; sub = (xcd + 8 * (s >> 1)) * 2 + (s & 1); }
                    else if (s < 24) { const int s2 = s - 8, g = xcd + 8 * (s2 >> 3); kind = 1; sub = (g >> 1) * 16 + (g & 1) * 8 + (s2 & 7); }
                    else { const int s2 = s - 24; kind = 2; sub = (xcd + 8 * (s2 >> 1)) * 2 + (s2 & 1); }
                } else { kind = it < 64 ? 0 : (it < 192 ? 1 : 2); sub = it < 64 ? it : (it < 192 ? it - 64 : it - 192); }
                if (kind == 0) phaseC_item<0>(lds, p, layer, sub);
                else if (kind == 1) phaseC_item<1>(lds, p, layer, sub);
                else phaseC_item<2>(lds, p, layer, sub);
            }
        } else if (sub == 4) {
            phaseD(p, layer);
        } else if (sub == 5) {
            pg8::Gemm g; g.A = proj; g.Bt = (const bf16_t*)(p.ws + WS_WOUT) + (size_t)layer * 1024 * 2048; g.M = T_TOK; g.N = 1024; g.K = 2048; g.lda = 256; g.atiled = 1;
            pg8::StaticOrder S; S.init(g.M, g.N, G, bx);
            EpiOut E; E.O = proj;
            pg8::gemm_phase<EpiOut>(lds, g, S, E);
        } else {
            phase_rows(layer == 0 ? p.x : p.out, proj, NP, p.post_norm + layer * DM, p.out,
                       layer == 0 ? p.pre_norm + DM : nullptr, hbuf);
        }
    }
}

extern "C" void kernel_launch(void* const* d_in, const int* in_sizes, int n_in, void* d_out, int out_size, void* d_ws, size_t ws_size, hipStream_t stream) {
    static int grid_blocks = 0;
    if (grid_blocks == 0) {
        if (n_in != 16 || in_sizes[0] != T_TOK * DM || out_size != T_TOK * DM || ws_size < WS_TOTAL) {
            fprintf(stderr, "kernel_launch: unexpected shapes / workspace (%d inputs, in0 %d, out %d, ws %zu, need %zu)\n", n_in, n_in > 0 ? in_sizes[0] : -1, out_size, ws_size, (size_t)WS_TOTAL);
            grid_blocks = -1; return;
        }
        int dev = 0, cus = 0, per_cu = 0;
        hipGetDevice(&dev);
        hipDeviceGetAttribute(&cus, hipDeviceAttributeMultiprocessorCount, dev);
        if (hipFuncSetAttribute((const void*)hybrid_fwd, hipFuncAttributeMaxDynamicSharedMemorySize, LDS_BYTES) != hipSuccess) { fprintf(stderr, "hipFuncSetAttribute failed\n"); grid_blocks = -1; return; }
        hipOccupancyMaxActiveBlocksPerMultiprocessor(&per_cu, (const void*)hybrid_fwd, 512, LDS_BYTES);
        if (per_cu < 1) { fprintf(stderr, "occupancy query returned %d\n", per_cu); grid_blocks = -1; return; }
        grid_blocks = cus;
    }
    if (grid_blocks < 0) return;
    P p{};
    p.x = (const float*)d_in[0]; p.pre_norm = (const float*)d_in[1]; p.post_norm = (const float*)d_in[2]; p.w_in = (const float*)d_in[3];
    p.gdn_conv = (const float*)d_in[4]; p.gdn_A_log = (const float*)d_in[5]; p.gdn_dt_bias = (const float*)d_in[6]; p.gdn_norm = (const float*)d_in[7];
    p.ssd_conv = (const float*)d_in[8]; p.ssd_conv_b = (const float*)d_in[9]; p.ssd_A_log = (const float*)d_in[10]; p.ssd_dt_bias = (const float*)d_in[11];
    p.ssd_D = (const float*)d_in[12]; p.ssd_norm = (const float*)d_in[13]; p.ret_norm = (const float*)d_in[14]; p.w_out = (const float*)d_in[15];
    p.out = (float*)d_out; p.ws = (unsigned char*)d_ws;
    p.ph_lo = 0; p.ph_hi = 13;
    hipError_t me = hipMemsetAsync((unsigned char*)d_ws + WS_BAR, 0, XCD_BAR_WORDS * sizeof(unsigned), stream);
    if (me != hipSuccess) fprintf(stderr, "barrier memset failed: %s\n", hipGetErrorString(me));
    void* args[] = {&p};
    hipError_t e = hipLaunchCooperativeKernel((const void*)hybrid_fwd, dim3(grid_blocks), dim3(512), args, LDS_BYTES, stream);
    if (e != hipSuccess) fprintf(stderr, "cooperative launch failed: %s (grid %d)\n", hipGetErrorString(e), grid_blocks);
}
```

```cpp
#include <hip/hip_runtime.h>
#include <hip/hip_cooperative_groups.h>
#include <cstdio>
namespace cg = cooperative_groups;

#define LAS __attribute__((address_space(3)))
#define DI __device__ __forceinline__
typedef unsigned short bf16_t;
typedef short bf16x8 __attribute__((ext_vector_type(8)));
typedef float f32x4 __attribute__((ext_vector_type(4)));
typedef unsigned u32x4 __attribute__((ext_vector_type(4)));
typedef unsigned u32x2 __attribute__((ext_vector_type(2)));

constexpr int T_TOK = 65536, DM = 1024, NCHUNK = 128, NB = 8;
constexpr int NP = 6656;
constexpr int NPW = 6912;
constexpr int NIN = 6680;
constexpr int C_GZ = 0, C_SZ = 512, C_RG = 1536, C_GQ = 2048, C_GK = 2560, C_GV = 3072, C_SX = 3584, C_SB = 4608, C_SC = 4864,
              C_RQ = 5120, C_RK = 5632, C_RV = 6144;
constexpr float EPS = 1e-6f;
__device__ __forceinline__ size_t pidx(size_t row, int col) { return ((row >> 8) * 26 + (size_t)(col >> 8)) * 65536 + (row & 255) * 256 + (size_t)(col & 255); }
constexpr size_t WS_PROJ = 0;
constexpr size_t WS_H = (size_t)T_TOK * NP * 2;
constexpr size_t WS_WBUF = WS_H;
constexpr size_t WS_GCUM = WS_H + (size_t)T_TOK * 512 * 2;
constexpr size_t WS_DT = WS_GCUM + (size_t)T_TOK * 4 * 4;
constexpr size_t WS_ACUM = WS_DT + (size_t)T_TOK * 16 * 4;
constexpr size_t WS_WIN = WS_H + (size_t)T_TOK * DM * 2;
constexpr size_t WS_WOUT = WS_WIN + (size_t)2 * NPW * DM * 2;
constexpr size_t WS_SMALL = WS_WOUT + (size_t)2 * 1024 * 2048 * 2;
constexpr size_t WS_HALO = WS_SMALL + (size_t)T_TOK * 32 * 4;
constexpr size_t WS_END = WS_HALO + (size_t)1024 * 3 * 3072 * 2;
constexpr size_t WS_BAR = WS_END;
constexpr size_t WS_TOTAL = WS_END + 16384;
constexpr int LDS_BAR_OFF = 160768;
constexpr int LDS_BYTES = 160768 + 16;

struct P {
    const float* x; const float* pre_norm; const float* post_norm; const float* w_in; const float* gdn_conv; const float* gdn_A_log;
    const float* gdn_dt_bias; const float* gdn_norm; const float* ssd_conv; const float* ssd_conv_b; const float* ssd_A_log;
    const float* ssd_dt_bias; const float* ssd_D; const float* ssd_norm; const float* ret_norm; const float* w_out;
    float* out; unsigned char* ws; int ph_lo, ph_hi;
};

DI int opaque_tid() { int t = threadIdx.x; asm volatile("" : "+v"(t)); return t; }
typedef float f32x2 __attribute__((ext_vector_type(2)));
typedef __bf16 bf16x2_t __attribute__((ext_vector_type(2)));
DI unsigned pk_bf16(float lo, float hi) { const f32x2 v = {lo, hi}; const bf16x2_t b = __builtin_convertvector(v, bf16x2_t); return __builtin_bit_cast(unsigned, b); }
DI float bf_lo(unsigned w) { return __uint_as_float(w << 16); }
DI float bf_hi(unsigned w) { return __uint_as_float(w & 0xffff0000u); }
DI float siluf(float v) { return v * __builtin_amdgcn_rcpf(1.0f + __expf(-v)); }
DI void unpack8(const u32x4 w, f32x2 (&o)[4]) { o[0] = (f32x2){bf_lo(w.x), bf_hi(w.x)}; o[1] = (f32x2){bf_lo(w.y), bf_hi(w.y)}; o[2] = (f32x2){bf_lo(w.z), bf_hi(w.z)}; o[3] = (f32x2){bf_lo(w.w), bf_hi(w.w)}; }
DI f32x2 silu2(f32x2 v) { const f32x2 e = (f32x2){__expf(-v[0]), __expf(-v[1])}; const f32x2 d = e + 1.0f; const f32x2 rr = (f32x2){__builtin_amdgcn_rcpf(d[0]), __builtin_amdgcn_rcpf(d[1])}; return v * rr; }
DI float softplusf(float v) { return v > 20.f ? v : log1pf(__expf(v)); }
DI float wave_scan_incl(float v, int lane) {
#pragma unroll
    for (int o = 1; o < 64; o <<= 1) { float t = __shfl_up(v, o); if (lane >= o) v += t; }
    return v;
}

#define XB_TMO      128
#define XB_XCNT(j)  (256  + 64 * (j))
#define XB_XSUB(j)  (1280 + 64 * (j))
#define XB_XGEN(j)  (2304 + 64 * (j))
#define XB_TOP      3328
#define XB_TOPGEN   3392
#define XCD_BAR_WORDS 3456
#define XB_SPIN_CAP (1u << 18)

__device__ __forceinline__ unsigned xb_ld(unsigned* p)              { return __hip_atomic_load(p, __ATOMIC_RELAXED, __HIP_MEMORY_SCOPE_AGENT); }
__device__ __forceinline__ unsigned xb_add(unsigned* p, unsigned v) { return __hip_atomic_fetch_add(p, v, __ATOMIC_RELAXED, __HIP_MEMORY_SCOPE_AGENT); }
__device__ __forceinline__ unsigned xb_xcc_id() { return (unsigned)__builtin_amdgcn_s_getreg((3 << 11) | 20) & 0xFu; }
#define XB_SPIN(cond, bar) do { unsigned _sp = 0; while (cond) { __builtin_amdgcn_s_sleep(1); \
    if ((++_sp & 255u) == 0u) { if (xb_ld(&(bar)[XB_TMO])) break; if (_sp > XB_SPIN_CAP) { atomicAdd(&(bar)[XB_TMO], 1u); break; } } } } while (0)

struct XcdBarrier {
    unsigned* bar; unsigned x;
    volatile LAS unsigned* st;
};

__device__ __forceinline__ XcdBarrier xcd_barrier_post(unsigned* bar, volatile LAS unsigned* st) {
    XcdBarrier b; b.bar = bar; b.x = xb_xcc_id(); b.st = st;
    if (threadIdx.x == 0) (void)xb_add(&bar[XB_XCNT(b.x)], 1u);
    return b;
}
__device__ __forceinline__ void xcd_barrier_complete(unsigned* bar, unsigned x, unsigned& nloc, unsigned& nx) {
    const unsigned G = gridDim.x * gridDim.y * gridDim.z;
    unsigned sum, cnt, mine, sp = 0u;
    for (;;) {
        sum = 0u; cnt = 0u; mine = 0u;
#pragma unroll
        for (unsigned j = 0; j < 16; ++j) { const unsigned c = xb_ld(&bar[XB_XCNT(j)]); sum += c; cnt += (c > 0u) ? 1u : 0u; mine = (j == x) ? c : mine; }
        if (sum == G) break;
        __builtin_amdgcn_s_sleep(1);
        if ((++sp & 255u) == 0u) { if (xb_ld(&bar[XB_TMO])) break; if (sp > XB_SPIN_CAP) { atomicAdd(&bar[XB_TMO], 1u); break; } }
    }
    nloc = mine > 0u ? mine : 1u; nx = cnt > 0u ? cnt : 1u;
}

__device__ __forceinline__ void xcd_barrier(const XcdBarrier& b) {
    asm volatile("s_waitcnt vmcnt(0)" ::: "memory");
    __syncthreads();
    if (threadIdx.x == 0) {
        unsigned* bar = b.bar;
        __builtin_amdgcn_s_waitcnt(0);
        unsigned nloc = b.st[0], nx = b.st[1];
        if (nloc == 0u) { xcd_barrier_complete(bar, b.x, nloc, nx); b.st[0] = nloc; b.st[1] = nx; }
        const unsigned old = xb_add(&bar[XB_XSUB(b.x)], 1u);
        const unsigned gen = old / nloc;
        if (old + 1u == (gen + 1u) * nloc) {
            __builtin_amdgcn_fence(__ATOMIC_RELEASE, "agent");
            asm volatile("s_waitcnt vmcnt(0)" ::: "memory");
            const unsigned og = xb_add(&bar[XB_TOP], 1u);
            const unsigned tg = og / nx;
            if (og + 1u == (tg + 1u) * nx) xb_add(&bar[XB_TOPGEN], 1u);
            else XB_SPIN(xb_ld(&bar[XB_TOPGEN]) == tg, bar);
            __builtin_amdgcn_fence(__ATOMIC_ACQUIRE, "agent");
            xb_add(&bar[XB_XGEN(b.x)], 1u);
            asm volatile("s_waitcnt vmcnt(0)" ::: "memory");
        } else {
            XB_SPIN(xb_ld(&bar[XB_XGEN(b.x)]) == gen, bar);
            __builtin_amdgcn_fence(__ATOMIC_ACQUIRE, "agent");
            asm volatile("s_waitcnt vmcnt(0)" ::: "memory");
        }
    }
    __syncthreads();
}


namespace pg8 {
constexpr int BM = 256, BK = 64, HALF = 128, HTB = HALF * BK * 2, NXCD = 8, WGM = 4;
DI int lds_byte(int r, int c) { const int st = (r >> 4) * 2 + (c >> 5), rr = r & 15, cc = c & 31, ob = rr * 64 + cc * 2; return st * 1024 + (ob ^ (((ob >> 9) & 1) << 5)); }
DI void stage_rc(int b, int& R, int& C) { const int st = b / 1024, sb = b % 1024, swz = sb ^ (((sb >> 9) & 1) << 5); R = (st >> 1) * 16 + swz / 64; C = (st & 1) * 32 + (swz % 64) / 2; }
DI int perm32(int rho) { const int n = rho >> 4, i = rho & 15; return 8 * (i >> 2) + 4 * n + (i & 3); }
struct Unit { int pm, pn; };
struct Gemm { const bf16_t* A; const bf16_t* Bt; int M, N, K, lda, atiled; };
struct StaticOrder {
    int nM, nN, nwg, G, c;
    DI void init(int M, int N, int G_, int c_) { nM = M / BM; nN = N / BM; nwg = nM * nN; G = G_; c = c_; }
    DI bool next(int i, Unit& u) const {
        const long L = (long)i * G + c; if (L >= nwg) return false;
        int wgid = (int)L; { const int q = nwg / NXCD, r = nwg % NXCD, xcd = wgid % NXCD, off = wgid / NXCD; wgid = (xcd < r ? xcd * (q + 1) : r * (q + 1) + (xcd - r) * q) + off; }
        const int nig = WGM * nN, gid = wgid / nig, fm = gid * WGM, gsz = (nM - fm) < WGM ? (nM - fm) : WGM;
        u.pm = fm + ((wgid % nig) % gsz); u.pn = (wgid % nig) / gsz; return true;
    }
};

template <class Epi>
DI void gemm_phase(LAS unsigned char* lds, const Gemm g, const StaticOrder& S, const Epi& E) {
    const int tid = opaque_tid(), wid = __builtin_amdgcn_readfirstlane(tid >> 6), lane = tid & 63, wr = wid >> 2, wc = wid & 3, fr = lane & 15, fq = lane >> 4;
    const int K = g.K, nt = K / BK, lda = g.lda;
    unsigned voffA[2], voffB[2];
#pragma unroll
    for (int i = 0; i < 2; ++i) { int R, C; stage_rc(tid * 16 + i * 8192, R, C); const int Rb = Epi::PERM ? ((R & ~31) + perm32(R & 31)) : R;
        voffA[i] = (unsigned)(R * lda + C) * 2u; voffB[i] = (unsigned)(Rb * K + C) * 2u; }
    const size_t kstep = (size_t)(BK * 2);
    const size_t hA = (size_t)HALF * lda * 2, hB = (size_t)HALF * K * 2;
    const size_t tA = g.atiled ? (size_t)26 * 131072 : 2 * hA, tB = 2 * hB;
    const int atiled = g.atiled;
#define PG8_AKOFF(t) (atiled ? ((size_t)((t) >> 2) * 131072 + (size_t)((t) & 3) * 128) : (size_t)(t) * kstep)
    const unsigned ldsw = (unsigned)wid * 1024u;
    const int aoff = lds_byte(wr * 64 + fr, fq * 8), boff = lds_byte(wc * 32 + fr, fq * 8);
#define PG8_SA(b, h) (((b) * 2 + (h)) * HTB)
#define PG8_SB(b, h) ((4 + (b) * 2 + (h)) * HTB)
#define PG8_STAGE(bufoff, gbase, voff) do { _Pragma("unroll") for (int _i = 0; _i < 2; ++_i) \
        __builtin_amdgcn_global_load_lds((const unsigned*)((const char*)(gbase) + (voff)[_i]), (LAS unsigned*)(lds + (bufoff) + ldsw + _i * 8192), 16, 0, 0); } while (0)
#define PG8_LDA(dst, b, h) do { _Pragma("unroll") for (int m = 0; m < 4; ++m) _Pragma("unroll") for (int k = 0; k < 2; ++k) dst[m][k] = *(const LAS bf16x8*)(lds + PG8_SA(b, h) + aoff + m * 2048 + k * 1024); } while (0)
#define PG8_LDB(dst, b, h) do { _Pragma("unroll") for (int n = 0; n < 2; ++n) _Pragma("unroll") for (int k = 0; k < 2; ++k) dst[n][k] = *(const LAS bf16x8*)(lds + PG8_SB(b, h) + boff + n * 2048 + k * 1024); } while (0)
#define PG8_MMA(ai, bj, At, Bt) do { __builtin_amdgcn_s_setprio(1); _Pragma("unroll") for (int m = 0; m < 4; ++m) _Pragma("unroll") for (int n = 0; n < 2; ++n) _Pragma("unroll") for (int k = 0; k < 2; ++k) \
        acc[ai][bj][m][n] = __builtin_amdgcn_mfma_f32_16x16x32_bf16(Bt[n][k], At[m][k], acc[ai][bj][m][n], 0, 0, 0); __builtin_amdgcn_s_setprio(0); } while (0)
#define PG8_WAIT_V(n) asm volatile("s_waitcnt vmcnt(" #n ")" ::: "memory")
#define PG8_WAIT_L(n) asm volatile("s_waitcnt lgkmcnt(" #n ")" ::: "memory")
#define PG8_BAR __builtin_amdgcn_s_barrier()
#define PG8_SCHED __builtin_amdgcn_sched_barrier(0)
    Unit cur, nxt; int ui = 0;
    if (!S.next(0, cur)) return;
    f32x4 acc[2][2][4][2];
#pragma unroll
    for (int a = 0; a < 2; ++a)
#pragma unroll
        for (int b = 0; b < 2; ++b)
#pragma unroll
            for (int m = 0; m < 4; ++m)
#pragma unroll
                for (int n = 0; n < 2; ++n) acc[a][b][m][n] = (f32x4){0.f, 0.f, 0.f, 0.f};
    bf16x8 At[4][2], B0[2][2], B1[2][2];
    const char* cA = (const char*)g.A + (size_t)cur.pm * tA; const char* cB = (const char*)g.Bt + (size_t)cur.pn * tB;
    PG8_STAGE(PG8_SB(0, 0), cB, voffB); PG8_STAGE(PG8_SB(0, 1), cB + hB, voffB); PG8_STAGE(PG8_SA(0, 0), cA, voffA); PG8_STAGE(PG8_SA(0, 1), cA + hA, voffA);
    if (wr == 1) PG8_BAR;
    PG8_WAIT_V(2); PG8_BAR;
    PG8_STAGE(PG8_SB(1, 0), cB + kstep, voffB); PG8_STAGE(PG8_SA(1, 0), cA + kstep, voffA); PG8_STAGE(PG8_SB(1, 1), cB + hB + kstep, voffB);
    PG8_WAIT_V(6); PG8_BAR;
    for (;;) {
        const bool has_next = S.next(ui + 1, nxt);
        const char* nA = has_next ? (const char*)g.A + (size_t)nxt.pm * tA : cA; const char* nB = has_next ? (const char*)g.Bt + (size_t)nxt.pn * tB : cB;
        for (int t = 0; t < nt; t += 2) {
            const bool last = (t == nt - 2);
            const char* a1 = cA + PG8_AKOFF(t + 1);
            const char* a2 = last ? nA : cA + PG8_AKOFF(t + 2); const char* b2 = last ? nB : cB + (size_t)(t + 2) * kstep;
            const char* a3 = a2 + kstep; const char* b3 = b2 + kstep;
            PG8_LDB(B0, 0, 0); PG8_LDB(B1, 0, 1); PG8_SCHED; PG8_LDA(At, 0, 0); PG8_STAGE(PG8_SA(1, 1), a1 + hA, voffA);
            PG8_WAIT_V(8); PG8_WAIT_L(0); PG8_BAR; PG8_MMA(0, 0, At, B0); PG8_MMA(0, 1, At, B1); PG8_BAR; PG8_SCHED;
            PG8_LDA(At, 0, 1); PG8_STAGE(PG8_SB(0, 0), b2, voffB); PG8_STAGE(PG8_SB(0, 1), b2 + hB, voffB); PG8_STAGE(PG8_SA(0, 0), a2, voffA);
            PG8_WAIT_V(8); PG8_WAIT_L(0); PG8_BAR; PG8_MMA(1, 0, At, B0); PG8_MMA(1, 1, At, B1); PG8_BAR; PG8_SCHED;
            PG8_LDB(B0, 1, 0); PG8_LDB(B1, 1, 1); PG8_SCHED; PG8_LDA(At, 1, 0); PG8_STAGE(PG8_SA(0, 1), a2 + hA, voffA);
            PG8_WAIT_V(8); PG8_WAIT_L(0); PG8_BAR; PG8_MMA(0, 0, At, B0); PG8_MMA(0, 1, At, B1); PG8_BAR; PG8_SCHED;
            PG8_LDA(At, 1, 1); PG8_STAGE(PG8_SB(1, 0), b3, voffB); PG8_STAGE(PG8_SB(1, 1), b3 + hB, voffB); PG8_STAGE(PG8_SA(1, 0), a3, voffA);
            PG8_WAIT_V(8); PG8_WAIT_L(0); PG8_BAR; PG8_MMA(1, 0, At, B0); PG8_MMA(1, 1, At, B1); PG8_BAR; PG8_SCHED;
        }
        if (wr == 0) PG8_BAR;
        E(acc, cur, wr, wc, fr, fq);
        if (!has_next) break;
#pragma unroll
        for (int a = 0; a < 2; ++a)
#pragma unroll
            for (int b = 0; b < 2; ++b)
#pragma unroll
                for (int m = 0; m < 4; ++m)
#pragma unroll
                    for (int n = 0; n < 2; ++n) acc[a][b][m][n] = (f32x4){0.f, 0.f, 0.f, 0.f};
        cur = nxt; cA = nA; cB = nB; ++ui;
        if (wr == 1) PG8_BAR;
    }
    PG8_WAIT_V(0);
    PG8_BAR;
#undef PG8_SA
#undef PG8_AKOFF
#undef PG8_SB
#undef PG8_STAGE
#undef PG8_LDA
#undef PG8_LDB
#undef PG8_MMA
#undef PG8_WAIT_V
#undef PG8_WAIT_L
#undef PG8_BAR
#undef PG8_SCHED
}
}

struct EpiProj {
    static constexpr bool PERM = true;
    bf16_t* proj; float* small; bf16_t* halo;
    DI void operator()(const f32x4 (&acc)[2][2][4][2], const pg8::Unit& u, int wr, int wc, int fr, int fq) const {
        const int row0 = u.pm * 256 + wr * 64 + fr;
        if (u.pn < 26) {
            const int col0 = u.pn * 256 + wc * 32 + 8 * fq;
            const bool conv = (u.pn >= 8 && u.pn < 20);
#pragma unroll
            for (int ai = 0; ai < 2; ++ai)
#pragma unroll
                for (int m = 0; m < 4; ++m) {
                    const int row = row0 + ai * 128 + m * 16;
                    bf16_t* rowp = proj + pidx((size_t)row, col0);
#pragma unroll
                    for (int bj = 0; bj < 2; ++bj) {
                        const f32x4 v0 = acc[ai][bj][m][0], v1 = acc[ai][bj][m][1];
                        u32x4 w; w.x = pk_bf16(v0[0], v0[1]); w.y = pk_bf16(v0[2], v0[3]); w.z = pk_bf16(v1[0], v1[1]); w.w = pk_bf16(v1[2], v1[3]);
                        *(u32x4*)(rowp + bj * 128) = w;
                        if (m == 3 && conv && fr >= 13)
                            *(u32x4*)(halo + ((size_t)(row >> 6) * 3 + (fr - 13)) * 3072 + (col0 + bj * 128 - 2048)) = w;
                    }
                }
        } else if (wc == 0) {
#pragma unroll
            for (int ai = 0; ai < 2; ++ai)
#pragma unroll
                for (int m = 0; m < 4; ++m) {
                    const int row = row0 + ai * 128 + m * 16;
                    float* pp = small + (size_t)row * 32 + 8 * fq;
                    *(f32x4*)pp = acc[ai][0][m][0]; *(f32x4*)(pp + 4) = acc[ai][0][m][1];
                }
        }
    }
};
struct EpiOut {
    static constexpr bool PERM = true;
    bf16_t* O;
    DI void operator()(const f32x4 (&acc)[2][2][4][2], const pg8::Unit& u, int wr, int wc, int fr, int fq) const {
        const int row0 = u.pm * 256 + wr * 64 + fr, col0 = u.pn * 256 + wc * 32 + 8 * fq;
#pragma unroll
        for (int ai = 0; ai < 2; ++ai)
#pragma unroll
            for (int m = 0; m < 4; ++m) {
                bf16_t* rowp = O + pidx((size_t)(row0 + ai * 128 + m * 16), 2048 + col0);
#pragma unroll
                for (int bj = 0; bj < 2; ++bj) {
                    const f32x4 v0 = acc[ai][bj][m][0], v1 = acc[ai][bj][m][1];
                    u32x4 w; w.x = pk_bf16(v0[0], v0[1]); w.y = pk_bf16(v0[2], v0[3]); w.z = pk_bf16(v1[0], v1[1]); w.w = pk_bf16(v1[2], v1[3]);
                    *(u32x4*)(rowp + bj * 128) = w;
                }
            }
    }
};

template <int KSTEPS>
DI f32x4 mma_tile(f32x4 acc, const LAS bf16_t* A, int lda, const LAS bf16_t* B, int ldb, int r, int q) {
#pragma unroll
    for (int k = 0; k < KSTEPS; ++k) {
        const bf16x8 a = *(const LAS bf16x8*)(A + r * lda + k * 32 + q * 8);
        const bf16x8 b = *(const LAS bf16x8*)(B + r * ldb + k * 32 + q * 8);
        acc = __builtin_amdgcn_mfma_f32_16x16x32_bf16(a, b, acc, 0, 0, 0);
    }
    return acc;
}

template <int KS> DI void ldfrag(bf16x8 (&f)[KS], const LAS bf16_t* base, int ld, int r, int q) {
#pragma unroll
    for (int k = 0; k < KS; ++k) f[k] = *(const LAS bf16x8*)(base + r * ld + k * 32 + q * 8);
}
template <int KS> DI f32x4 mmafrag(f32x4 acc, const bf16x8 (&a)[KS], const bf16x8 (&b)[KS]) {
#pragma unroll
    for (int k = 0; k < KS; ++k) acc = __builtin_amdgcn_mfma_f32_16x16x32_bf16(a[k], b[k], acc, 0, 0, 0);
    return acc;
}

DI int orig_col(int n) {
    if (n < 512) return 1536 + n;
    if (n < 1536) return 3592 + (n - 512);
    if (n < 2048) return 6168 + (n - 1536);
    if (n < 3584) return n - 2048;
    if (n < 5120) return 2056 + (n - 3584);
    if (n < 6656) return 4632 + (n - 5120);
    if (n < 6664) return 2048 + (n - 6656);
    if (n < 6680) return 4616 + (n - 6664);
    return -1;
}
__device__ void phase_convert(const P& p) {
    bf16_t* WinT = (bf16_t*)(p.ws + WS_WIN); bf16_t* WoutT = (bf16_t*)(p.ws + WS_WOUT);
    const size_t gsz = (size_t)gridDim.x * blockDim.x, g0 = (size_t)blockIdx.x * blockDim.x + opaque_tid();
    const size_t n1 = (size_t)2 * 128 * NPW;
    for (size_t i = g0; i < n1; i += gsz) {
        const int n = (int)(i % NPW); const int k8 = (int)((i / NPW) % 128); const int l = (int)(i / ((size_t)NPW * 128));
        const int oc = orig_col(n);
        float v[8];
#pragma unroll
        for (int e = 0; e < 8; ++e) v[e] = oc >= 0 ? p.w_in[((size_t)l * 1024 + k8 * 8 + e) * NIN + oc] : 0.f;
        u32x4 w; w.x = pk_bf16(v[0], v[1]); w.y = pk_bf16(v[2], v[3]); w.z = pk_bf16(v[4], v[5]); w.w = pk_bf16(v[6], v[7]);
        *(u32x4*)(WinT + ((size_t)l * NPW + n) * 1024 + k8 * 8) = w;
    }
    const size_t n2 = (size_t)2 * 256 * 1024;
    for (size_t i = g0; i < n2; i += gsz) {
        const int n = (int)(i % 1024); const int k8 = (int)((i / 1024) % 256); const int l = (int)(i / (1024 * 256));
        float v[8];
#pragma unroll
        for (int e = 0; e < 8; ++e) v[e] = p.w_out[((size_t)l * 2048 + k8 * 8 + e) * 1024 + n];
        u32x4 w; w.x = pk_bf16(v[0], v[1]); w.y = pk_bf16(v[2], v[3]); w.z = pk_bf16(v[4], v[5]); w.w = pk_bf16(v[6], v[7]);
        *(u32x4*)(WoutT + ((size_t)l * 1024 + n) * 2048 + k8 * 8) = w;
    }
}
__device__ void phase_rows(const float* xin, const bf16_t* o, int ldo, const float* post, float* xout, const float* pre, bf16_t* h) {
    const int tid_ = opaque_tid(); const int lane = tid_ & 63, wv = tid_ >> 6;
    const int stride = gridDim.x * 8;
    f32x4 xn[4]; u32x2 on[4];
#define R_LOAD(rr) do { _Pragma("unroll") for (int j = 0; j < 4; ++j) { xn[j] = __builtin_nontemporal_load((const f32x4*)(xin + (size_t)(rr) * DM + j * 256 + lane * 4)); \
        if (o) on[j] = __builtin_nontemporal_load((const u32x2*)(o + pidx((size_t)(rr), 2048 + j * 256 + lane * 4))); } } while (0)
    int row = blockIdx.x * 8 + wv;
#pragma unroll
    for (int j = 0; j < 4; ++j) on[j] = (u32x2){0u, 0u};
    if (row < T_TOK) R_LOAD(row);
    for (; row < T_TOK; row += stride) {
        f32x4 xv[4]; u32x2 ow[4];
#pragma unroll
        for (int j = 0; j < 4; ++j) { xv[j] = xn[j]; ow[j] = on[j]; }
        if (row + stride < T_TOK) R_LOAD(row + stride);
        if (o) {
            f32x4 ov[4]; float ss = 0.f;
#pragma unroll
            for (int j = 0; j < 4; ++j) { ov[j] = (f32x4){bf_lo(ow[j].x), bf_hi(ow[j].x), bf_lo(ow[j].y), bf_hi(ow[j].y)}; ss += ov[j][0] * ov[j][0] + ov[j][1] * ov[j][1] + ov[j][2] * ov[j][2] + ov[j][3] * ov[j][3]; }
#pragma unroll
            for (int s = 1; s < 64; s <<= 1) ss += __shfl_xor(ss, s);
            const float rs = rsqrtf(ss * (1.0f / DM) + EPS);
#pragma unroll
            for (int j = 0; j < 4; ++j) { const f32x4 pw = *(const f32x4*)(post + j * 256 + lane * 4); xv[j] += ov[j] * rs * pw;
                *(f32x4*)(xout + (size_t)row * DM + j * 256 + lane * 4) = xv[j]; }
        }
        if (pre) {
            float ss = 0.f;
#pragma unroll
            for (int j = 0; j < 4; ++j) ss += xv[j][0] * xv[j][0] + xv[j][1] * xv[j][1] + xv[j][2] * xv[j][2] + xv[j][3] * xv[j][3];
#pragma unroll
            for (int s = 1; s < 64; s <<= 1) ss += __shfl_xor(ss, s);
            const float rs = rsqrtf(ss * (1.0f / DM) + EPS);
#pragma unroll
            for (int j = 0; j < 4; ++j) { const f32x4 pw = *(const f32x4*)(pre + j * 256 + lane * 4); const f32x4 hv = xv[j] * rs * pw;
                u32x2 w; w.x = pk_bf16(hv[0], hv[1]); w.y = pk_bf16(hv[2], hv[3]); *(u32x2*)(h + (size_t)row * DM + j * 256 + lane * 4) = w; }
        }
    }
#undef R_LOAD
}

__device__ void phaseB_gdn(LAS unsigned char* lds, const P& p, int layer, int chunkg, int h) {
    const int tid = opaque_tid(), lane = tid & 63, wid = tid >> 6, r = lane & 15, q = lane >> 4;
    const int c = chunkg & 127;
    const size_t t0 = (size_t)chunkg * 64;
    bf16_t* proj = (bf16_t*)(p.ws + WS_PROJ); const bf16_t* halo = (const bf16_t*)(p.ws + WS_HALO);
    const float* small = (const float*)(p.ws + WS_SMALL);
    LAS bf16_t* kb = (LAS bf16_t*)lds;
    LAS float* rhs = (LAS float*)(lds + 17408);
    LAS float* Am = (LAS float*)(lds + 17408 + 65536);
    LAS float* gS = (LAS float*)(lds + 17408 + 65536 + 16384);
    const float* cw = p.gdn_conv + (size_t)layer * 4 * 1536;
    LAS float* cwS = (LAS float*)(lds + 17408 + 65536 + 16384 + 512);
    float braw = 0.f, araw = 0.f;
    if (wid == 0) { braw = small[(t0 + lane) * 32 + h]; araw = small[(t0 + lane) * 32 + 4 + h]; }
    float wl[3];
#pragma unroll
    for (int k = 0; k < 3; ++k) { const int rem = tid; wl[k] = cw[(rem >> 7) * 1536 + k * 512 + h * 128 + (rem & 127)]; }
    u32x4 xr[3][2][4];
#pragma unroll
    for (int s = 0; s < 3; ++s)
#pragma unroll
        for (int pass = 0; pass < 2; ++pass) {
            const int tok = pass * 32 + (tid >> 4), seg = tid & 15, col = C_GQ + s * 512 + h * 128 + seg * 8;
#pragma unroll
            for (int d = 0; d < 4; ++d) {
                const int tt = tok - 3 + d;
                u32x4 v = (u32x4){0u, 0u, 0u, 0u};
                if (tt >= 0) v = *(const u32x4*)(proj + pidx(t0 + tt, col));
                else if (c > 0) v = *(const u32x4*)(halo + ((size_t)(chunkg - 1) * 3 + (tt + 3)) * 3072 + (col - 2048));
                xr[s][pass][d] = v;
            }
        }
#pragma unroll
    for (int k = 0; k < 3; ++k) cwS[k * 512 + tid] = wl[k];
    if (wid == 0) {
        const float beta = 1.0f / (1.0f + __expf(-braw));
        const float g = -__expf(p.gdn_A_log[layer * 4 + h]) * softplusf(araw + p.gdn_dt_bias[layer * 4 + h]);
        const float gc = wave_scan_incl(g, lane);
        gS[lane] = gc; gS[64 + lane] = beta;
        ((float*)(p.ws + WS_GCUM))[(t0 + lane) * 4 + h] = gc;
    }
    __syncthreads();
    u32x4 qpk[2];
#pragma unroll
    for (int s = 0; s < 3; ++s) {
#pragma unroll
        for (int pass = 0; pass < 2; ++pass) {
            const int tok = pass * 32 + (tid >> 4), seg = tid & 15;
            f32x2 v2[4];
#pragma unroll
            for (int k = 0; k < 4; ++k) v2[k] = (f32x2){0.f, 0.f};
#pragma unroll
            for (int d = 0; d < 4; ++d) {
                f32x2 x2[4]; unpack8(xr[s][pass][d], x2);
                const f32x4 w0 = *(const LAS f32x4*)(cwS + s * 512 + d * 128 + seg * 8), w1 = *(const LAS f32x4*)(cwS + s * 512 + d * 128 + seg * 8 + 4);
                v2[0] = __builtin_elementwise_fma((f32x2){w0[0], w0[1]}, x2[0], v2[0]); v2[1] = __builtin_elementwise_fma((f32x2){w0[2], w0[3]}, x2[1], v2[1]);
                v2[2] = __builtin_elementwise_fma((f32x2){w1[0], w1[1]}, x2[2], v2[2]); v2[3] = __builtin_elementwise_fma((f32x2){w1[2], w1[3]}, x2[3], v2[3]);
            }
            f32x2 ss2 = (f32x2){0.f, 0.f};
#pragma unroll
            for (int k = 0; k < 4; ++k) { v2[k] = silu2(v2[k]); ss2 = __builtin_elementwise_fma(v2[k], v2[k], ss2); }
            float ss = ss2[0] + ss2[1];
            if (s < 2) {
                ss += __shfl_xor(ss, 1); ss += __shfl_xor(ss, 2); ss += __shfl_xor(ss, 4); ss += __shfl_xor(ss, 8);
                const float rn = rsqrtf(ss + EPS) * (s == 0 ? 0.08838834764831845f : 1.0f);
#pragma unroll
                for (int k = 0; k < 4; ++k) v2[k] *= rn;
            }
            const float val[8] = {v2[0][0], v2[0][1], v2[1][0], v2[1][1], v2[2][0], v2[2][1], v2[3][0], v2[3][1]};
            if (s == 0) {
                u32x4 w; w.x = pk_bf16(val[0], val[1]); w.y = pk_bf16(val[2], val[3]); w.z = pk_bf16(val[4], val[5]); w.w = pk_bf16(val[6], val[7]);
                qpk[pass] = w;
            } else if (s == 1) {
                u32x4 w; w.x = pk_bf16(val[0], val[1]); w.y = pk_bf16(val[2], val[3]); w.z = pk_bf16(val[4], val[5]); w.w = pk_bf16(val[6], val[7]);
                *(LAS u32x4*)(kb + tok * 136 + seg * 8) = w;
                const float f = gS[64 + tok] * __expf(gS[tok]);
                *(LAS f32x4*)(rhs + tok * 256 + 128 + seg * 8) = (f32x4){f * val[0], f * val[1], f * val[2], f * val[3]};
                *(LAS f32x4*)(rhs + tok * 256 + 128 + seg * 8 + 4) = (f32x4){f * val[4], f * val[5], f * val[6], f * val[7]};
            } else {
                const float f = gS[64 + tok];
                *(LAS f32x4*)(rhs + tok * 256 + seg * 8) = (f32x4){f * val[0], f * val[1], f * val[2], f * val[3]};
                *(LAS f32x4*)(rhs + tok * 256 + seg * 8 + 4) = (f32x4){f * val[4], f * val[5], f * val[6], f * val[7]};
            }
        }
    }
    __syncthreads();
#pragma unroll
    for (int pass = 0; pass < 2; ++pass) {
        const int item = pass * 512 + tid, tok = item >> 4, seg = item & 15;
        *(u32x4*)(proj + pidx(t0 + tok, C_GQ + h * 128 + seg * 8)) = qpk[pass];
    }
#pragma unroll
    for (int tt = 0; tt < 2; ++tt) {
        const int id = wid * 2 + tt, mt = id >> 2, nt = id & 3;
        f32x4 acc = (f32x4){0.f, 0.f, 0.f, 0.f};
        acc = mma_tile<4>(acc, kb + mt * 16 * 136, 136, kb + nt * 16 * 136, 136, r, q);
        const int j = nt * 16 + r; const float gj = gS[j];
        f32x4 av;
#pragma unroll
        for (int jj = 0; jj < 4; ++jj) {
            const int i = mt * 16 + q * 4 + jj;
            av[jj] = (j < i) ? -(gS[64 + i] * acc[jj] * __expf(gS[i] - gj)) : 0.f;
        }
        *(LAS f32x4*)(Am + j * 64 + mt * 16 + q * 4) = av;
    }
    __syncthreads();
    if (tid < 256) {
        float xs[64];
        int zoff; asm volatile("v_mov_b32 %0, 0" : "=v"(zoff));
        const LAS float* Az = Am + zoff;
        {
            f32x2 x2[32];
#pragma unroll
            for (int k = 0; k < 32; ++k) x2[k] = (f32x2){rhs[(2 * k) * 256 + tid], rhs[(2 * k + 1) * 256 + tid]};
            f32x4 an[16], ac[16];
#pragma unroll
            for (int k = 0; k < 16; ++k) an[k] = *(const LAS f32x4*)(Az + 4 * k);
#pragma unroll
            for (int j = 0; j < 63; ++j) {
#pragma unroll
                for (int k = 0; k < 16; ++k) ac[k] = an[k];
                if (j + 1 < 63) {
#pragma unroll
                    for (int k = (j + 2) / 4; k < 16; ++k) an[k] = *(const LAS f32x4*)(Az + (j + 1) * 64 + 4 * k);
                }
                __builtin_amdgcn_sched_barrier(0);
                const float xj = x2[j >> 1][j & 1];
                const f32x2 xj2 = (f32x2){xj, xj};
#pragma unroll
                for (int k = (j + 1) >> 1; k < 32; ++k) {
                    const f32x2 a2 = (k & 1) ? (f32x2){ac[k >> 1][2], ac[k >> 1][3]} : (f32x2){ac[k >> 1][0], ac[k >> 1][1]};
                    x2[k] = __builtin_elementwise_fma(a2, xj2, x2[k]);
                }
                __builtin_amdgcn_sched_barrier(0);
            }
#pragma unroll
            for (int k = 0; k < 32; ++k) { xs[2 * k] = x2[k][0]; xs[2 * k + 1] = x2[k][1]; }
        }
        if (tid < 128) {
            const int e = tid >> 6, dvl = tid & 63;
            bf16_t* dst = proj + pidx(t0 + dvl, C_GV + h * 128 + e * 64);
#pragma unroll
            for (int k = 0; k < 8; ++k) {
                u32x4 w; w.x = pk_bf16(xs[8 * k], xs[8 * k + 1]); w.y = pk_bf16(xs[8 * k + 2], xs[8 * k + 3]); w.z = pk_bf16(xs[8 * k + 4], xs[8 * k + 5]); w.w = pk_bf16(xs[8 * k + 6], xs[8 * k + 7]);
                *(u32x4*)(dst + 8 * k) = w;
            }
        } else {
            bf16_t* wb = (bf16_t*)(p.ws + WS_WBUF) + t0 * 512 + h * 128 + (tid - 128);
#pragma unroll
            for (int i = 0; i < 64; ++i) wb[(size_t)i * 512] = (bf16_t)(pk_bf16(xs[i], 0.f) & 0xffffu);
        }
    }
#pragma unroll
    for (int pass = 0; pass < 2; ++pass) {
        const int item = pass * 512 + tid, tok = item >> 4, seg = item & 15;
        *(u32x4*)(proj + pidx(t0 + tok, C_GK + h * 128 + seg * 8)) = *(const LAS u32x4*)(kb + tok * 136 + seg * 8);
    }
    __syncthreads();
}
__device__ void phaseB_ssd(const P& p, int layer, int chunkg) {
    const int tid = opaque_tid(), lane = tid & 63, wid = tid >> 6;
    const int c = chunkg & 127;
    const size_t t0 = (size_t)chunkg * 64;
    bf16_t* proj = (bf16_t*)(p.ws + WS_PROJ); const bf16_t* halo = (const bf16_t*)(p.ws + WS_HALO);
    const float* small = (const float*)(p.ws + WS_SMALL);
#pragma unroll
    for (int k = 0; k < 2; ++k) {
        const int hd = wid * 2 + k;
        const float dt = softplusf(small[(t0 + lane) * 32 + 8 + hd] + p.ssd_dt_bias[layer * 16 + hd]);
        const float a = -__expf(p.ssd_A_log[layer * 16 + hd]) * dt;
        const float ac = wave_scan_incl(a, lane);
        { ((float*)(p.ws + WS_DT))[(t0 + lane) * 16 + hd] = dt;
        ((float*)(p.ws + WS_ACUM))[(t0 + lane) * 16 + hd] = ac; }
    }
    const int seg = tid % 192, half = tid / 192;
    const int col = C_SX + seg * 8, ch = seg * 8;
    const bool act = tid < 384;
    u32x4 win[3];
    win[0] = win[1] = win[2] = (u32x4){0u, 0u, 0u, 0u};
    u32x4 rows[32];
    f32x2 wg2[4][4], bias2[4];
    if (act) {
        if (half == 1) {
#pragma unroll
            for (int d = 0; d < 3; ++d) win[d] = *(const u32x4*)(proj + pidx(t0 + 29 + d, col));
        } else if (c > 0) {
#pragma unroll
            for (int d = 0; d < 3; ++d) win[d] = *(const u32x4*)(halo + ((size_t)(chunkg - 1) * 3 + d) * 3072 + (col - 2048));
        }
#pragma unroll
        for (int k = 0; k < 32; ++k) rows[k] = __builtin_nontemporal_load((const u32x4*)(proj + pidx(t0 + half * 32 + k, col)));
        const float* cw = p.ssd_conv + (size_t)layer * 4 * 1536; const float* cb = p.ssd_conv_b + (size_t)layer * 1536;
#pragma unroll
        for (int d = 0; d < 4; ++d) {
            const f32x4 a = *(const f32x4*)(cw + d * 1536 + ch), bq = *(const f32x4*)(cw + d * 1536 + ch + 4);
            wg2[d][0] = (f32x2){a[0], a[1]}; wg2[d][1] = (f32x2){a[2], a[3]}; wg2[d][2] = (f32x2){bq[0], bq[1]}; wg2[d][3] = (f32x2){bq[2], bq[3]};
        }
        { const f32x4 a = *(const f32x4*)(cb + ch), bq = *(const f32x4*)(cb + ch + 4);
          bias2[0] = (f32x2){a[0], a[1]}; bias2[1] = (f32x2){a[2], a[3]}; bias2[2] = (f32x2){bq[0], bq[1]}; bias2[3] = (f32x2){bq[2], bq[3]}; }
    }
    __syncthreads();
    if (act) {
        f32x2 w0[4], w1[4], w2[4];
        unpack8(win[0], w0); unpack8(win[1], w1); unpack8(win[2], w2);
#pragma unroll
        for (int k = 0; k < 32; ++k) {
            f32x2 x3[4]; unpack8(rows[k], x3);
            f32x2 v2[4];
#pragma unroll
            for (int e = 0; e < 4; ++e) {
                f32x2 a = __builtin_elementwise_fma(wg2[0][e], w0[e], bias2[e]);
                a = __builtin_elementwise_fma(wg2[1][e], w1[e], a);
                a = __builtin_elementwise_fma(wg2[2][e], w2[e], a);
                a = __builtin_elementwise_fma(wg2[3][e], x3[e], a);
                v2[e] = silu2(a);
                w0[e] = w1[e]; w1[e] = w2[e]; w2[e] = x3[e];
            }
            u32x4 w; w.x = pk_bf16(v2[0][0], v2[0][1]); w.y = pk_bf16(v2[1][0], v2[1][1]); w.z = pk_bf16(v2[2][0], v2[2][1]); w.w = pk_bf16(v2[3][0], v2[3][1]);
            *(u32x4*)(proj + pidx(t0 + half * 32 + k, col)) = w;
        }
    }
}
__device__ void phaseB_ret(const P& p, int chunkg) {
    const int tid = opaque_tid();
    const int c = chunkg & 127;
    const size_t t0 = (size_t)chunkg * 64;
    bf16_t* proj = (bf16_t*)(p.ws + WS_PROJ);
    const int tok = tid >> 3, pg = tid & 7;
    const float pos = (float)(c * 64 + tok);
    float cs[8], sn[8];
#pragma unroll
    for (int e = 0; e < 8; ++e) {
        const float inv = exp2f(-(float)(pg * 8 + e) * (13.287712379549449f / 64.0f));
        const float ang = pos * inv;
        const float n = rintf(ang * 0.15915494309189535f);
        float rr = fmaf(-n, 6.28125f, ang); rr = fmaf(-n, 0.0019353071795864769f, rr);
        cs[e] = __cosf(rr); sn[e] = __sinf(rr);
    }
    u32x4 ra[4][2], rb[4][2];
#pragma unroll
    for (int hh = 0; hh < 4; ++hh)
#pragma unroll
        for (int s = 0; s < 2; ++s) {
            const bf16_t* base = proj + pidx(t0 + tok, (s == 0 ? C_RQ : C_RK) + hh * 128 + pg * 8);
            ra[hh][s] = __builtin_nontemporal_load((const u32x4*)base); rb[hh][s] = __builtin_nontemporal_load((const u32x4*)(base + 64));
        }
#pragma unroll
    for (int hh = 0; hh < 4; ++hh)
#pragma unroll
        for (int s = 0; s < 2; ++s) {
            bf16_t* base = proj + pidx(t0 + tok, (s == 0 ? C_RQ : C_RK) + hh * 128 + pg * 8);
            const float sc = s == 0 ? 1.0f : 0.08838834764831845f;
            const u32x4 a = ra[hh][s], b = rb[hh][s];
            const float t1[8] = {bf_lo(a.x), bf_hi(a.x), bf_lo(a.y), bf_hi(a.y), bf_lo(a.z), bf_hi(a.z), bf_lo(a.w), bf_hi(a.w)};
            const float t2[8] = {bf_lo(b.x), bf_hi(b.x), bf_lo(b.y), bf_hi(b.y), bf_lo(b.z), bf_hi(b.z), bf_lo(b.w), bf_hi(b.w)};
            float o1[8], o2[8];
#pragma unroll
            for (int e = 0; e < 8; ++e) { o1[e] = (t1[e] * cs[e] - t2[e] * sn[e]) * sc; o2[e] = (t1[e] * sn[e] + t2[e] * cs[e]) * sc; }
            u32x4 w1, w2;
            w1.x = pk_bf16(o1[0], o1[1]); w1.y = pk_bf16(o1[2], o1[3]); w1.z = pk_bf16(o1[4], o1[5]); w1.w = pk_bf16(o1[6], o1[7]);
            w2.x = pk_bf16(o2[0], o2[1]); w2.y = pk_bf16(o2[2], o2[3]); w2.z = pk_bf16(o2[4], o2[5]); w2.w = pk_bf16(o2[6], o2[7]);
            { *(u32x4*)base = w1; *(u32x4*)(base + 64) = w2; }
        }
}

constexpr int L_QS = 0, L_KS = 17408, L_WS = 34816, L_ST = 52224, L_VT = 69632, L_VST = 78848, L_AT = 88064, L_UT = 97280, L_CUM = 106496, L_DT = 106752;
constexpr int L_ALT = 107008;
constexpr int D_KS = L_ALT - L_KS, D_ST = L_ALT + 17408 - L_ST, D_VT = L_ALT + 34816 - L_VT, D_VST = L_ALT + 44032 - L_VST, D_CUM = L_ALT + 53248 - L_CUM;
typedef short s16x4 __attribute__((ext_vector_type(4)));
DI bf16x8 ldfrag_tr(const LAS bf16_t* X, int ld, int k0, int m0, int r, int q) {
    const LAS bf16_t* a = X + (k0 + q * 8 + (r >> 2)) * ld + m0 + 4 * (r & 3);
    const s16x4 lo = __builtin_amdgcn_ds_read_tr16_b64_v4i16((LAS s16x4*)a);
    const s16x4 hi = __builtin_amdgcn_ds_read_tr16_b64_v4i16((LAS s16x4*)(a + 4 * ld));
    return __builtin_shufflevector(lo, hi, 0, 1, 2, 3, 4, 5, 6, 7);
}
template <int KIND>
__device__ void phaseC_item(LAS unsigned char* lds, const P& p, int layer, int sub) {
    const int tid = opaque_tid(), lane = tid & 63, wid = __builtin_amdgcn_readfirstlane(tid >> 6), r = lane & 15, q = lane >> 4;
    bf16_t* proj = (bf16_t*)(p.ws + WS_PROJ);
    int b, qcol, kcol, vcol, hidx; float Dval = 0.f, lg = 0.f;
    if (KIND == 0) { b = sub >> 3; const int h = (sub >> 1) & 3, e = sub & 1; hidx = h; qcol = C_GQ + h * 128; kcol = C_GK + h * 128; vcol = C_GV + h * 128 + e * 64; }
    else if (KIND == 1) { b = sub >> 4; const int hd = sub & 15, grp = hd >> 3; hidx = hd; qcol = C_SC + grp * 128; kcol = C_SB + grp * 128; vcol = C_SX + hd * 64; Dval = p.ssd_D[layer * 16 + hd]; }
    else { b = sub >> 3; const int h = (sub >> 1) & 3, e = sub & 1; hidx = h; qcol = C_RQ + h * 128; kcol = C_RK + h * 128; vcol = C_RV + h * 128 + e * 64; lg = logf(1.0f - exp2f(-5.0f - (float)h)); }
    LAS bf16_t* Qs = (LAS bf16_t*)(lds + L_QS); LAS bf16_t* Ws = (LAS bf16_t*)(lds + L_WS);
    LAS bf16_t* AT = (LAS bf16_t*)(lds + L_AT); LAS bf16_t* UT = (LAS bf16_t*)(lds + L_UT);
    const bf16_t* Wbuf = (const bf16_t*)(p.ws + WS_WBUF);
    const float* gate = KIND == 0 ? (const float*)(p.ws + WS_GCUM) : (const float*)(p.ws + WS_ACUM);
    const float* gdt = (const float*)(p.ws + WS_DT);
    const int gstride = KIND == 0 ? 4 : 16;
    for (int i = tid; i < 17408 / 16; i += 512) *(LAS u32x4*)(lds + L_ST + i * 16) = (u32x4){0u, 0u, 0u, 0u};
    f32x4 Sacc[4];
#pragma unroll
    for (int n = 0; n < 4; ++n) Sacc[n] = (f32x4){0.f, 0.f, 0.f, 0.f};
    u32x4 pq[2], pk[2], pw[2], pv; float pcum = 0.f, pcl = 0.f, pdt = 1.f, pcum2 = 0.f, pdt2 = 1.f;
    const int mt = wid >> 1, nt0 = (wid & 1) * 2;
    u32x2 pz0 = (u32x2){0u, 0u}, pz1 = pz0, cz0 = pz0, cz1 = pz0;
    const int zcol = C_SZ + (vcol - C_SX);
    const int mytok = tid & 63, vtok = tid >> 3, vseg = tid & 7;
    const int loQ0 = (tid >> 4) * 256 + (qcol & 255) + (tid & 15) * 8, loK0 = (tid >> 4) * 256 + (kcol & 255) + (tid & 15) * 8;
    const int loV = vtok * 256 + (vcol & 255) + vseg * 8;
    const int loO = (nt0 * 16 + r) * 256 + (vcol & 255) + mt * 16 + q * 4, loZ = (nt0 * 16 + r) * 256 + (zcol & 255) + mt * 16 + q * 4;
#define TBASE(cc, col) ((((((size_t)b * NCHUNK + (cc)) >> 2) * 26 + (size_t)((col) >> 8)) * 65536) + ((((size_t)b * NCHUNK + (cc)) & 3) * 16384))
#define PREFETCH(cc) do { const size_t t0_ = ((size_t)b * NCHUNK + (cc)) * 64; \
        const bf16_t* tq_ = proj + TBASE(cc, qcol); const bf16_t* tk_ = proj + TBASE(cc, kcol); const bf16_t* tv_ = proj + TBASE(cc, vcol); \
        _Pragma("unroll") for (int it = 0; it < 2; ++it) { const int pp = tid + 512 * it; \
            pq[it] = *(const u32x4*)(tq_ + loQ0 + it * 8192); \
            pk[it] = *(const u32x4*)(tk_ + loK0 + it * 8192); \
            if (KIND == 0) pw[it] = *(const u32x4*)(Wbuf + (t0_ + (pp >> 4)) * 512 + hidx * 128 + (pp & 15) * 8); } \
        pv = *(const u32x4*)(tv_ + loV); \
        if (KIND != 2) { pcum = gate[(t0_ + mytok) * gstride + hidx]; pcl = gate[(t0_ + 63) * gstride + hidx]; } \
        else { pcum = (float)(mytok + 1) * lg; pcl = 64.0f * lg; } \
        if (KIND == 1) { pdt = gdt[(t0_ + mytok) * 16 + hidx]; pdt2 = gdt[(t0_ + vtok) * 16 + hidx]; pcum2 = gate[(t0_ + vtok) * gstride + hidx]; } \
        if (KIND == 2) pcum2 = (float)(vtok + 1) * lg; \
        if (KIND == 1) { const bf16_t* tz_ = proj + TBASE(cc, zcol); pz0 = *(const u32x2*)(tz_ + loZ); pz1 = *(const u32x2*)(tz_ + loZ + 4096); } } while (0)
    PREFETCH(0);
    u32x2 ow0 = (u32x2){0u, 0u}, ow1 = ow0;
    for (int c = 0; c < NCHUNK; ++c) {
        const size_t t0 = ((size_t)b * NCHUNK + c) * 64;
        const int par = c & 1;
        LAS bf16_t* Ks = (LAS bf16_t*)(lds + L_KS + par * D_KS); LAS bf16_t* ST = (LAS bf16_t*)(lds + L_ST + par * D_ST); LAS bf16_t* STn = (LAS bf16_t*)(lds + L_ST + (par ^ 1) * D_ST);
        LAS bf16_t* VT = (LAS bf16_t*)(lds + L_VT + par * D_VT);
        LAS bf16_t* VST = (LAS bf16_t*)(lds + L_VST + par * D_VST);
        LAS float* cumS = (LAS float*)(lds + L_CUM + par * D_CUM); LAS float* dtS = cumS + 64;
#pragma unroll
        for (int it = 0; it < 2; ++it) {
            const int pp = tid + 512 * it;
            *(LAS u32x4*)(Qs + (pp >> 4) * 136 + (pp & 15) * 8) = pq[it];
            *(LAS u32x4*)(Ks + (pp >> 4) * 136 + (pp & 15) * 8) = pk[it];
            if (KIND == 0) *(LAS u32x4*)(Ws + (pp >> 4) * 136 + (pp & 15) * 8) = pw[it];
        }
        if (KIND == 0) {
            *(LAS u32x4*)(UT + vtok * 72 + vseg * 8) = pv;
        } else {
            const float sa = KIND == 1 ? pdt2 : 1.0f, sb = sa * __expf(pcl - pcum2);
            const float v0 = bf_lo(pv.x), v1 = bf_hi(pv.x), v2 = bf_lo(pv.y), v3 = bf_hi(pv.y), v4 = bf_lo(pv.z), v5 = bf_hi(pv.z), v6 = bf_lo(pv.w), v7 = bf_hi(pv.w);
            u32x4 wa = pv;
            if (KIND == 1) { wa.x = pk_bf16(v0 * sa, v1 * sa); wa.y = pk_bf16(v2 * sa, v3 * sa); wa.z = pk_bf16(v4 * sa, v5 * sa); wa.w = pk_bf16(v6 * sa, v7 * sa); }
            u32x4 wb; wb.x = pk_bf16(v0 * sb, v1 * sb); wb.y = pk_bf16(v2 * sb, v3 * sb); wb.z = pk_bf16(v4 * sb, v5 * sb); wb.w = pk_bf16(v6 * sb, v7 * sb);
            *(LAS u32x4*)(VT + vtok * 72 + vseg * 8) = wa;
            *(LAS u32x4*)(VST + vtok * 72 + vseg * 8) = wb;
        }
        if (tid < 64) { cumS[tid] = pcum; if (KIND == 1) dtS[tid] = pdt; }
        if (KIND == 1) { cz0 = pz0; cz1 = pz1; }
        if (c > 0) {
            bf16_t* to_ = proj + TBASE(c - 1, vcol);
            *(u32x2*)(to_ + loO) = ow0;
            *(u32x2*)(to_ + loO + 4096) = ow1;
        }
        __syncthreads();
        if (c + 1 < NCHUNK) PREFETCH(c + 1);
        const float cl = cumS[63];
        bf16x8 gb[2][4];
        {
            bf16x8 fa[4], fb[2][4], ga[4];
            if (KIND == 0) { ldfrag<4>(fa, Ws + mt * 16 * 136, 136, r, q); ldfrag<4>(fb[0], ST + nt0 * 16 * 136, 136, r, q); ldfrag<4>(fb[1], ST + (nt0 + 1) * 16 * 136, 136, r, q); }
            ldfrag<4>(ga, Ks + mt * 16 * 136, 136, r, q); ldfrag<4>(gb[0], Qs + nt0 * 16 * 136, 136, r, q); ldfrag<4>(gb[1], Qs + (nt0 + 1) * 16 * 136, 136, r, q);
            const f32x4 cj = *(const LAS f32x4*)(cumS + mt * 16 + q * 4);
            u32x2 uu[2]; float ci[2], dti[2];
#pragma unroll
            for (int tt = 0; tt < 2; ++tt) {
                if (KIND == 0) uu[tt] = *(const LAS u32x2*)(UT + ((nt0 + tt) * 16 + r) * 72 + mt * 16 + q * 4);
                ci[tt] = cumS[(nt0 + tt) * 16 + r];
                if (KIND == 1) dti[tt] = dtS[(nt0 + tt) * 16 + r];
            }
            __builtin_amdgcn_sched_barrier(0);
            if (KIND == 0) {
                f32x4 a0 = (f32x4){0.f, 0.f, 0.f, 0.f}, a1 = a0;
                a0 = mmafrag<4>(a0, fa, fb[0]); a1 = mmafrag<4>(a1, fa, fb[1]);
                const float e0 = __expf(cl - cj[0]), e1 = __expf(cl - cj[1]), e2 = __expf(cl - cj[2]), e3 = __expf(cl - cj[3]);
#pragma unroll
                for (int tt = 0; tt < 2; ++tt) {
                    const f32x4 acc = tt ? a1 : a0;
                    const float v0 = bf_lo(uu[tt].x) - acc[0], v1 = bf_hi(uu[tt].x) - acc[1], v2 = bf_lo(uu[tt].y) - acc[2], v3 = bf_hi(uu[tt].y) - acc[3];
                    u32x2 w; w.x = pk_bf16(v0, v1); w.y = pk_bf16(v2, v3);
                    *(LAS u32x2*)(VT + ((nt0 + tt) * 16 + r) * 72 + mt * 16 + q * 4) = w;
                    u32x2 ws; ws.x = pk_bf16(v0 * e0, v1 * e1); ws.y = pk_bf16(v2 * e2, v3 * e3);
                    *(LAS u32x2*)(VST + ((nt0 + tt) * 16 + r) * 72 + mt * 16 + q * 4) = ws;
                }
            }
            {
                f32x4 a0 = (f32x4){0.f, 0.f, 0.f, 0.f}, a1 = a0;
                a0 = mmafrag<4>(a0, ga, gb[0]); a1 = mmafrag<4>(a1, ga, gb[1]);
#pragma unroll
                for (int tt = 0; tt < 2; ++tt) {
                    const f32x4 acc = tt ? a1 : a0;
                    const int i = (nt0 + tt) * 16 + r;
                    float f[4];
#pragma unroll
                    for (int jj = 0; jj < 4; ++jj) {
                        const int j = mt * 16 + q * 4 + jj;
                        float v = (j <= i) ? acc[jj] * __expf(ci[tt] - cj[jj]) : 0.f;
                        if (KIND == 1 && j == i) v += Dval * __builtin_amdgcn_rcpf(dti[tt]);
                        f[jj] = v;
                    }
                    u32x2 w; w.x = pk_bf16(f[0], f[1]); w.y = pk_bf16(f[2], f[3]);
                    *(LAS u32x2*)(AT + i * 72 + mt * 16 + q * 4) = w;
                }
            }
        }
        __syncthreads();
        {
            bf16x8 sa[4], va[2], ab[2][2], ka[2], vb[4][2];
            ldfrag<4>(sa, ST + mt * 16 * 136, 136, r, q);
            ldfrag<2>(ab[0], AT + nt0 * 16 * 72, 72, r, q); ldfrag<2>(ab[1], AT + (nt0 + 1) * 16 * 72, 72, r, q);
            if (KIND == 0) {
                ldfrag<2>(va, VT + mt * 16 * 72, 72, r, q);
#pragma unroll
                for (int n = 0; n < 4; ++n) ldfrag<2>(vb[n], VST + n * 16 * 72, 72, r, q);
            } else {
#pragma unroll
                for (int ks = 0; ks < 2; ++ks) {
                    va[ks] = ldfrag_tr(VT, 72, ks * 32, mt * 16, r, q);
#pragma unroll
                    for (int n = 0; n < 4; ++n) vb[n][ks] = ldfrag_tr(VST, 72, ks * 32, n * 16, r, q);
                }
            }
#pragma unroll
            for (int ks = 0; ks < 2; ++ks) ka[ks] = ldfrag_tr(Ks, 136, ks * 32, wid * 16, r, q);
            const float ei0 = __expf(cumS[nt0 * 16 + r]), ei1 = __expf(cumS[(nt0 + 1) * 16 + r]);
            const float dl = __expf(cl);
            __builtin_amdgcn_sched_barrier(0);
            f32x4 o0 = (f32x4){0.f, 0.f, 0.f, 0.f}, o1 = o0;
            o0 = mmafrag<4>(o0, sa, gb[0]); o1 = mmafrag<4>(o1, sa, gb[1]);
            o0 *= ei0; o1 *= ei1;
            o0 = mmafrag<2>(o0, va, ab[0]); o1 = mmafrag<2>(o1, va, ab[1]);
#pragma unroll
            for (int n = 0; n < 4; ++n) { Sacc[n] *= dl; Sacc[n] = mmafrag<2>(Sacc[n], ka, vb[n]); }
            if (KIND == 1) {
                o0[0] *= siluf(bf_lo(cz0.x)); o0[1] *= siluf(bf_hi(cz0.x)); o0[2] *= siluf(bf_lo(cz0.y)); o0[3] *= siluf(bf_hi(cz0.y));
                o1[0] *= siluf(bf_lo(cz1.x)); o1[1] *= siluf(bf_hi(cz1.x)); o1[2] *= siluf(bf_lo(cz1.y)); o1[3] *= siluf(bf_hi(cz1.y));
            }
            ow0.x = pk_bf16(o0[0], o0[1]); ow0.y = pk_bf16(o0[2], o0[3]);
            ow1.x = pk_bf16(o1[0], o1[1]); ow1.y = pk_bf16(o1[2], o1[3]);
        }
#pragma unroll
        for (int n = 0; n < 4; ++n) {
            u32x2 w; w.x = pk_bf16(Sacc[n][0], Sacc[n][1]); w.y = pk_bf16(Sacc[n][2], Sacc[n][3]);
            *(LAS u32x2*)(STn + (n * 16 + r) * 136 + wid * 16 + q * 4) = w;
        }
    }
    {
        const size_t tl = ((size_t)b * NCHUNK + NCHUNK - 1) * 64;
        bf16_t* to_ = proj + TBASE(NCHUNK - 1, vcol);
        *(u32x2*)(to_ + loO) = ow0;
        *(u32x2*)(to_ + loO + 4096) = ow1;
    }
    __syncthreads();
#undef PREFETCH
#undef TBASE
}

__device__ void phaseD(const P& p, int layer) {
    const int tid_ = opaque_tid(); const int lane = tid_ & 63, wv = tid_ >> 6;
    bf16_t* proj = (bf16_t*)(p.ws + WS_PROJ);
    const float* gw = p.gdn_norm + layer * 128; const float* rw = p.ret_norm + layer * 128; const float* sw = p.ssd_norm + layer * 1024;
    const int stride = gridDim.x * 8;
    u32x4 cur[8], nxt[8];
#define D_LOAD(dst, rr) do { const size_t rr_ = (size_t)(rr); \
        dst[0] = __builtin_nontemporal_load((const u32x4*)(proj + pidx(rr_, C_GV + lane * 8))); dst[1] = __builtin_nontemporal_load((const u32x4*)(proj + pidx(rr_, C_GZ + lane * 8))); \
        dst[2] = __builtin_nontemporal_load((const u32x4*)(proj + pidx(rr_, C_RV + lane * 8))); dst[3] = __builtin_nontemporal_load((const u32x4*)(proj + pidx(rr_, C_RG + lane * 8))); \
        dst[4] = __builtin_nontemporal_load((const u32x4*)(proj + pidx(rr_, C_SX + lane * 16))); dst[5] = (u32x4){0u, 0u, 0u, 0u}; \
        dst[6] = __builtin_nontemporal_load((const u32x4*)(proj + pidx(rr_, C_SX + lane * 16 + 8))); dst[7] = (u32x4){0u, 0u, 0u, 0u}; } while (0)
    int row = blockIdx.x * 8 + wv;
    if (row < T_TOK) D_LOAD(nxt, row);
    for (; row < T_TOK; row += stride) {
#pragma unroll
        for (int k = 0; k < 8; ++k) cur[k] = nxt[k];
        if (row + stride < T_TOK) D_LOAD(nxt, row + stride);
#pragma unroll
        for (int s = 0; s < 2; ++s) {
            const int zc = (s == 0 ? C_GZ : C_RG) + lane * 8;
            const float* nw = (s == 0 ? gw : rw) + (lane & 15) * 8;
            const u32x4 o = cur[2 * s], z = cur[2 * s + 1];
            float ov[8] = {bf_lo(o.x), bf_hi(o.x), bf_lo(o.y), bf_hi(o.y), bf_lo(o.z), bf_hi(o.z), bf_lo(o.w), bf_hi(o.w)};
            const float zv[8] = {bf_lo(z.x), bf_hi(z.x), bf_lo(z.y), bf_hi(z.y), bf_lo(z.z), bf_hi(z.z), bf_lo(z.w), bf_hi(z.w)};
            float ss = 0.f;
#pragma unroll
            for (int e = 0; e < 8; ++e) ss += ov[e] * ov[e];
            ss += __shfl_xor(ss, 1); ss += __shfl_xor(ss, 2); ss += __shfl_xor(ss, 4); ss += __shfl_xor(ss, 8);
            const float rs = rsqrtf(ss * (1.0f / 128.0f) + EPS);
#pragma unroll
            for (int e = 0; e < 8; ++e) ov[e] = ov[e] * rs * nw[e] * siluf(zv[e]);
            u32x4 w; w.x = pk_bf16(ov[0], ov[1]); w.y = pk_bf16(ov[2], ov[3]); w.z = pk_bf16(ov[4], ov[5]); w.w = pk_bf16(ov[6], ov[7]);
            *(u32x4*)(proj + pidx((size_t)row, zc)) = w;
        }
        {
            float yv[16];
#pragma unroll
            for (int k = 0; k < 2; ++k) {
                const u32x4 o = cur[4 + 2 * k], z = cur[5 + 2 * k];
                const float ov[8] = {bf_lo(o.x), bf_hi(o.x), bf_lo(o.y), bf_hi(o.y), bf_lo(o.z), bf_hi(o.z), bf_lo(o.w), bf_hi(o.w)};
                const float zv[8] = {bf_lo(z.x), bf_hi(z.x), bf_lo(z.y), bf_hi(z.y), bf_lo(z.z), bf_hi(z.z), bf_lo(z.w), bf_hi(z.w)};
#pragma unroll
                for (int e = 0; e < 8; ++e) yv[k * 8 + e] = ov[e];
            }
            float ss = 0.f;
#pragma unroll
            for (int e = 0; e < 16; ++e) ss += yv[e] * yv[e];
            ss += __shfl_xor(ss, 1); ss += __shfl_xor(ss, 2); ss += __shfl_xor(ss, 4); ss += __shfl_xor(ss, 8); ss += __shfl_xor(ss, 16);
            const float rs = rsqrtf(ss * (1.0f / 512.0f) + EPS);
#pragma unroll
            for (int k = 0; k < 2; ++k) {
                const float* nw = sw + lane * 16 + k * 8;
                u32x4 w; w.x = pk_bf16(yv[k * 8] * rs * nw[0], yv[k * 8 + 1] * rs * nw[1]); w.y = pk_bf16(yv[k * 8 + 2] * rs * nw[2], yv[k * 8 + 3] * rs * nw[3]);
                w.z = pk_bf16(yv[k * 8 + 4] * rs * nw[4], yv[k * 8 + 5] * rs * nw[5]); w.w = pk_bf16(yv[k * 8 + 6] * rs * nw[6], yv[k * 8 + 7] * rs * nw[7]);
                *(u32x4*)(proj + pidx((size_t)row, C_SZ + lane * 16 + k * 8)) = w;
            }
        }
    }
#undef D_LOAD
}

__global__ void __launch_bounds__(512, 2) hybrid_fwd(P p) {
    extern __shared__ __attribute__((aligned(16))) unsigned char lds_raw[];
    LAS unsigned char* lds = (LAS unsigned char*)lds_raw;
    cg::grid_group grid = cg::this_grid();
    const int G = gridDim.x, bx = blockIdx.x;
    bf16_t* proj = (bf16_t*)(p.ws + WS_PROJ);
    bf16_t* hbuf = (bf16_t*)(p.ws + WS_H);
    if (threadIdx.x == 0) *(LAS u32x4*)(lds + LDS_BAR_OFF) = (u32x4){0u, 0u, 0u, 0u};
    __syncthreads();
    XcdBarrier xb = xcd_barrier_post((unsigned*)(p.ws + WS_BAR), (volatile LAS unsigned*)(lds + LDS_BAR_OFF));
    int nsync = 0;
    for (int ph = p.ph_lo; ph < p.ph_hi; ++ph) {
        if (ph > p.ph_lo) { if (nsync == 0) grid.sync(); else xcd_barrier(xb); ++nsync; }
        const int layer = ph >= 7 ? 1 : 0, sub = ph == 0 ? 0 : (ph - 1) % 6 + 1;
        if (sub == 0) {
            phase_convert(p);
            phase_rows(p.x, nullptr, 0, nullptr, nullptr, p.pre_norm, hbuf);
        } else if (sub == 1) {
            pg8::Gemm g; g.A = hbuf; g.Bt = (const bf16_t*)(p.ws + WS_WIN) + (size_t)layer * NPW * DM; g.M = T_TOK; g.N = NPW; g.K = DM; g.lda = DM; g.atiled = 0;
            pg8::StaticOrder S; S.init(g.M, g.N, G, bx);
            EpiProj E; E.proj = proj; E.small = (float*)(p.ws + WS_SMALL); E.halo = (bf16_t*)(p.ws + WS_HALO);
            pg8::gemm_phase<EpiProj>(lds, g, S, E);
        } else if (sub == 2) {
            for (int it = bx; it < 1024 * 6; it += G) {
                const int chunkg = it & 1023, kind = it >> 10;
                if (kind < 4) phaseB_gdn(lds, p, layer, chunkg, kind);
                else if (kind == 4) phaseB_ssd(p, layer, chunkg);
                else phaseB_ret(p, chunkg);
            }
        } else if (sub == 3) {
            for (int it = bx; it < 256; it += G) {
                int kind, sub;
                if (G == 256) {
                    const int xcd = it & 7, s = it >> 3;
                    if (s < 8) { kind = 0; sub = (xcd + 8 * (s >> 1)) * 2 + (s & 1); }
                    else if (s < 24) { const int s2 = s - 8, g = xcd + 8 * (s2 >> 3); kind = 1; sub = (g >> 1) * 16 + (g & 1) * 8 + (s2 & 7); }
                    else { const int s2 = s - 24; kind = 2; sub = (xcd + 8 * (s2 >> 1)) * 2 + (s2 & 1); }
                } else { kind = it < 64 ? 0 : (it < 192 ? 1 : 2); sub = it < 64 ? it : (it < 192 ? it - 64 : it - 192); }
                if (kind == 0) phaseC_item<0>(lds, p, layer, sub);
                else if (kind == 1) phaseC_item<1>(lds, p, layer, sub);
                else phaseC_item<2>(lds, p, layer, sub);
            }
        } else if (sub == 4) {
            phaseD(p, layer);
        } else if (sub == 5) {
            pg8::Gemm g; g.A = proj; g.Bt = (const bf16_t*)(p.ws + WS_WOUT) + (size_t)layer * 1024 * 2048; g.M = T_TOK; g.N = 1024; g.K = 2048; g.lda = 256; g.atiled = 1;
            pg8::StaticOrder S; S.init(g.M, g.N, G, bx);
            EpiOut E; E.O = proj;
            pg8::gemm_phase<EpiOut>(lds, g, S, E);
        } else {
            phase_rows(layer == 0 ? p.x : p.out, proj, NP, p.post_norm + layer * DM, p.out,
                       layer == 0 ? p.pre_norm + DM : nullptr, hbuf);
        }
    }
}

extern "C" void kernel_launch(void* const* d_in, const int* in_sizes, int n_in, void* d_out, int out_size, void* d_ws, size_t ws_size, hipStream_t stream) {
    static int grid_blocks = 0;
    if (grid_blocks == 0) {
        if (n_in != 16 || in_sizes[0] != T_TOK * DM || out_size != T_TOK * DM || ws_size < WS_TOTAL) {
            fprintf(stderr, "kernel_launch: unexpected shapes / workspace (%d inputs, in0 %d, out %d, ws %zu, need %zu)\n", n_in, n_in > 0 ? in_sizes[0] : -1, out_size, ws_size, (size_t)WS_TOTAL);
            grid_blocks = -1; return;
        }
        int dev = 0, cus = 0, per_cu = 0;
        hipGetDevice(&dev);
        hipDeviceGetAttribute(&cus, hipDeviceAttributeMultiprocessorCount, dev);
        if (hipFuncSetAttribute((const void*)hybrid_fwd, hipFuncAttributeMaxDynamicSharedMemorySize, LDS_BYTES) != hipSuccess) { fprintf(stderr, "hipFuncSetAttribute failed\n"); grid_blocks = -1; return; }
        hipOccupancyMaxActiveBlocksPerMultiprocessor(&per_cu, (const void*)hybrid_fwd, 512, LDS_BYTES);
        if (per_cu < 1) { fprintf(stderr, "occupancy query returned %d\n", per_cu); grid_blocks = -1; return; }
        grid_blocks = cus;
    }
    if (grid_blocks < 0) return;
    P p{};
    p.x = (const float*)d_in[0]; p.pre_norm = (const float*)d_in[1]; p.post_norm = (const float*)d_in[2]; p.w_in = (const float*)d_in[3];
    p.gdn_conv = (const float*)d_in[4]; p.gdn_A_log = (const float*)d_in[5]; p.gdn_dt_bias = (const float*)d_in[6]; p.gdn_norm = (const float*)d_in[7];
    p.ssd_conv = (const float*)d_in[8]; p.ssd_conv_b = (const float*)d_in[9]; p.ssd_A_log = (const float*)d_in[10]; p.ssd_dt_bias = (const float*)d_in[11];
    p.ssd_D = (const float*)d_in[12]; p.ssd_norm = (const float*)d_in[13]; p.ret_norm = (const float*)d_in[14]; p.w_out = (const float*)d_in[15];
    p.out = (float*)d_out; p.ws = (unsigned char*)d_ws;
    p.ph_lo = 0; p.ph_hi = 13;
    hipError_t me = hipMemsetAsync((unsigned char*)d_ws + WS_BAR, 0, XCD_BAR_WORDS * sizeof(unsigned), stream);
    if (me != hipSuccess) fprintf(stderr, "barrier memset failed: %s\n", hipGetErrorString(me));
    void* args[] = {&p};
    hipError_t e = hipLaunchCooperativeKernel((const void*)hybrid_fwd, dim3(grid_blocks), dim3(512), args, LDS_BYTES, stream);
    if (e != hipSuccess) fprintf(stderr, "cooperative launch failed: %s (grid %d)\n", hipGetErrorString(e), grid_blocks);
}
```

```cpp
#include <hip/hip_runtime.h>
#include <hip/hip_cooperative_groups.h>
#include <cstdio>
namespace cg = cooperative_groups;

#define LAS __attribute__((address_space(3)))
#define DI __device__ __forceinline__
typedef unsigned short bf16_t;
typedef short bf16x8 __attribute__((ext_vector_type(8)));
typedef float f32x4 __attribute__((ext_vector_type(4)));
typedef unsigned u32x4 __attribute__((ext_vector_type(4)));
typedef unsigned u32x2 __attribute__((ext_vector_type(2)));

constexpr int T_TOK = 65536, DM = 1024, NCHUNK = 128, NB = 8;
constexpr int NP = 6656;
constexpr int NPW = 6912;
constexpr int NIN = 6680;
constexpr int C_GZ = 0, C_SZ = 512, C_RG = 1536, C_GQ = 2048, C_GK = 2560, C_GV = 3072, C_SX = 3584, C_SB = 4608, C_SC = 4864,
              C_RQ = 5120, C_RK = 5632, C_RV = 6144;
constexpr float EPS = 1e-6f;
__device__ __forceinline__ size_t pidx(size_t row, int col) { return ((row >> 8) * 26 + (size_t)(col >> 8)) * 65536 + (row & 255) * 256 + (size_t)(col & 255); }
constexpr size_t WS_PROJ = 0;
constexpr size_t WS_H = (size_t)T_TOK * NP * 2;
constexpr size_t WS_WBUF = WS_H;
constexpr size_t WS_GCUM = WS_H + (size_t)T_TOK * 512 * 2;
constexpr size_t WS_DT = WS_GCUM + (size_t)T_TOK * 4 * 4;
constexpr size_t WS_ACUM = WS_DT + (size_t)T_TOK * 16 * 4;
constexpr size_t WS_WIN = WS_H + (size_t)T_TOK * DM * 2;
constexpr size_t WS_WOUT = WS_WIN + (size_t)2 * NPW * DM * 2;
constexpr size_t WS_SMALL = WS_WOUT + (size_t)2 * 1024 * 2048 * 2;
constexpr size_t WS_HALO = WS_SMALL + (size_t)T_TOK * 32 * 4;
constexpr size_t WS_END = WS_HALO + (size_t)1024 * 3 * 3072 * 2;
constexpr size_t WS_BAR = WS_END;
constexpr size_t WS_TOTAL = WS_END + 16384;
constexpr int LDS_BAR_OFF = 160768;
constexpr int LDS_BYTES = 160768 + 16;

struct P {
    const float* x; const float* pre_norm; const float* post_norm; const float* w_in; const float* gdn_conv; const float* gdn_A_log;
    const float* gdn_dt_bias; const float* gdn_norm; const float* ssd_conv; const float* ssd_conv_b; const float* ssd_A_log;
    const float* ssd_dt_bias; const float* ssd_D; const float* ssd_norm; const float* ret_norm; const float* w_out;
    float* out; unsigned char* ws; int ph_lo, ph_hi;
};

DI int opaque_tid() { int t = threadIdx.x; asm volatile("" : "+v"(t)); return t; }
typedef float f32x2 __attribute__((ext_vector_type(2)));
typedef __bf16 bf16x2_t __attribute__((ext_vector_type(2)));
DI unsigned pk_bf16(float lo, float hi) { const f32x2 v = {lo, hi}; const bf16x2_t b = __builtin_convertvector(v, bf16x2_t); return __builtin_bit_cast(unsigned, b); }
DI float bf_lo(unsigned w) { return __uint_as_float(w << 16); }
DI float bf_hi(unsigned w) { return __uint_as_float(w & 0xffff0000u); }
DI float siluf(float v) { return v * __builtin_amdgcn_rcpf(1.0f + __expf(-v)); }
DI void unpack8(const u32x4 w, f32x2 (&o)[4]) { o[0] = (f32x2){bf_lo(w.x), bf_hi(w.x)}; o[1] = (f32x2){bf_lo(w.y), bf_hi(w.y)}; o[2] = (f32x2){bf_lo(w.z), bf_hi(w.z)}; o[3] = (f32x2){bf_lo(w.w), bf_hi(w.w)}; }
DI f32x2 silu2(f32x2 v) { const f32x2 e = (f32x2){__expf(-v[0]), __expf(-v[1])}; const f32x2 d = e + 1.0f; const f32x2 rr = (f32x2){__builtin_amdgcn_rcpf(d[0]), __builtin_amdgcn_rcpf(d[1])}; return v * rr; }
DI float softplusf(float v) { return v > 20.f ? v : log1pf(__expf(v)); }
DI float wave_scan_incl(float v, int lane) {
#pragma unroll
    for (int o = 1; o < 64; o <<= 1) { float t = __shfl_up(v, o); if (lane >= o) v += t; }
    return v;
}

#define XB_TMO      128
#define XB_XCNT(j)  (256  + 64 * (j))
#define XB_XSUB(j)  (1280 + 64 * (j))
#define XB_XGEN(j)  (2304 + 64 * (j))
#define XB_TOP      3328
#define XB_TOPGEN   3392
#define XCD_BAR_WORDS 3456
#define XB_SPIN_CAP (1u << 18)

__device__ __forceinline__ unsigned xb_ld(unsigned* p)              { return __hip_atomic_load(p, __ATOMIC_RELAXED, __HIP_MEMORY_SCOPE_AGENT); }
__device__ __forceinline__ unsigned xb_add(unsigned* p, unsigned v) { return __hip_atomic_fetch_add(p, v, __ATOMIC_RELAXED, __HIP_MEMORY_SCOPE_AGENT); }
__device__ __forceinline__ unsigned xb_xcc_id() { return (unsigned)__builtin_amdgcn_s_getreg((3 << 11) | 20) & 0xFu; }
#define XB_SPIN(cond, bar) do { unsigned _sp = 0; while (cond) { __builtin_amdgcn_s_sleep(1); \
    if ((++_sp & 255u) == 0u) { if (xb_ld(&(bar)[XB_TMO])) break; if (_sp > XB_SPIN_CAP) { atomicAdd(&(bar)[XB_TMO], 1u); break; } } } } while (0)

struct XcdBarrier {
    unsigned* bar; unsigned x;
    volatile LAS unsigned* st;
};

__device__ __forceinline__ XcdBarrier xcd_barrier_post(unsigned* bar, volatile LAS unsigned* st) {
    XcdBarrier b; b.bar = bar; b.x = xb_xcc_id(); b.st = st;
    if (threadIdx.x == 0) (void)xb_add(&bar[XB_XCNT(b.x)], 1u);
    return b;
}
__device__ __forceinline__ void xcd_barrier_complete(unsigned* bar, unsigned x, unsigned& nloc, unsigned& nx) {
    const unsigned G = gridDim.x * gridDim.y * gridDim.z;
    unsigned sum, cnt, mine, sp = 0u;
    for (;;) {
        sum = 0u; cnt = 0u; mine = 0u;
#pragma unroll
        for (unsigned j = 0; j < 16; ++j) { const unsigned c = xb_ld(&bar[XB_XCNT(j)]); sum += c; cnt += (c > 0u) ? 1u : 0u; mine = (j == x) ? c : mine; }
        if (sum == G) break;
        __builtin_amdgcn_s_sleep(1);
        if ((++sp & 255u) == 0u) { if (xb_ld(&bar[XB_TMO])) break; if (sp > XB_SPIN_CAP) { atomicAdd(&bar[XB_TMO], 1u); break; } }
    }
    nloc = mine > 0u ? mine : 1u; nx = cnt > 0u ? cnt : 1u;
}

__device__ __forceinline__ void xcd_barrier(const XcdBarrier& b) {
    asm volatile("s_waitcnt vmcnt(0)" ::: "memory");
    __syncthreads();
    if (threadIdx.x == 0) {
        unsigned* bar = b.bar;
        __builtin_amdgcn_s_waitcnt(0);
        unsigned nloc = b.st[0], nx = b.st[1];
        if (nloc == 0u) { xcd_barrier_complete(bar, b.x, nloc, nx); b.st[0] = nloc; b.st[1] = nx; }
        const unsigned old = xb_add(&bar[XB_XSUB(b.x)], 1u);
        const unsigned gen = old / nloc;
        if (old + 1u == (gen + 1u) * nloc) {
            __builtin_amdgcn_fence(__ATOMIC_RELEASE, "agent");
            asm volatile("s_waitcnt vmcnt(0)" ::: "memory");
            const unsigned og = xb_add(&bar[XB_TOP], 1u);
            const unsigned tg = og / nx;
            if (og + 1u == (tg + 1u) * nx) xb_add(&bar[XB_TOPGEN], 1u);
            else XB_SPIN(xb_ld(&bar[XB_TOPGEN]) == tg, bar);
            __builtin_amdgcn_fence(__ATOMIC_ACQUIRE, "agent");
            xb_add(&bar[XB_XGEN(b.x)], 1u);
            asm volatile("s_waitcnt vmcnt(0)" ::: "memory");
        } else {
            XB_SPIN(xb_ld(&bar[XB_XGEN(b.x)]) == gen, bar);
            __builtin_amdgcn_fence(__ATOMIC_ACQUIRE, "agent");
            asm volatile("s_waitcnt vmcnt(0)" ::: "memory");
        }
    }
    __syncthreads();
}


namespace pg8 {
constexpr int BM = 256, BK = 64, HALF = 128, HTB = HALF * BK * 2, NXCD = 8, WGM = 4;
DI int lds_byte(int r, int c) { const int st = (r >> 4) * 2 + (c >> 5), rr = r & 15, cc = c & 31, ob = rr * 64 + cc * 2; return st * 1024 + (ob ^ (((ob >> 9) & 1) << 5)); }
DI void stage_rc(int b, int& R, int& C) { const int st = b / 1024, sb = b % 1024, swz = sb ^ (((sb >> 9) & 1) << 5); R = (st >> 1) * 16 + swz / 64; C = (st & 1) * 32 + (swz % 64) / 2; }
DI int perm32(int rho) { const int n = rho >> 4, i = rho & 15; return 8 * (i >> 2) + 4 * n + (i & 3); }
struct Unit { int pm, pn; };
struct Gemm { const bf16_t* A; const bf16_t* Bt; int M, N, K, lda, atiled; };
struct StaticOrder {
    int nM, nN, nwg, G, c;
    DI void init(int M, int N, int G_, int c_) { nM = M / BM; nN = N / BM; nwg = nM * nN; G = G_; c = c_; }
    DI bool next(int i, Unit& u) const {
        const long L = (long)i * G + c; if (L >= nwg) return false;
        int wgid = (int)L; { const int q = nwg / NXCD, r = nwg % NXCD, xcd = wgid % NXCD, off = wgid / NXCD; wgid = (xcd < r ? xcd * (q + 1) : r * (q + 1) + (xcd - r) * q) + off; }
        const int nig = WGM * nN, gid = wgid / nig, fm = gid * WGM, gsz = (nM - fm) < WGM ? (nM - fm) : WGM;
        u.pm = fm + ((wgid % nig) % gsz); u.pn = (wgid % nig) / gsz; return true;
    }
};

template <class Epi>
DI void gemm_phase(LAS unsigned char* lds, const Gemm g, const StaticOrder& S, const Epi& E) {
    const int tid = opaque_tid(), wid = __builtin_amdgcn_readfirstlane(tid >> 6), lane = tid & 63, wr = wid >> 2, wc = wid & 3, fr = lane & 15, fq = lane >> 4;
    const int K = g.K, nt = K / BK, lda = g.lda;
    unsigned voffA[2], voffB[2];
#pragma unroll
    for (int i = 0; i < 2; ++i) { int R, C; stage_rc(tid * 16 + i * 8192, R, C); const int Rb = Epi::PERM ? ((R & ~31) + perm32(R & 31)) : R;
        voffA[i] = (unsigned)(R * lda + C) * 2u; voffB[i] = (unsigned)(Rb * K + C) * 2u; }
    const size_t kstep = (size_t)(BK * 2);
    const size_t hA = (size_t)HALF * lda * 2, hB = (size_t)HALF * K * 2;
    const size_t tA = g.atiled ? (size_t)26 * 131072 : 2 * hA, tB = 2 * hB;
    const int atiled = g.atiled;
#define PG8_AKOFF(t) (atiled ? ((size_t)((t) >> 2) * 131072 + (size_t)((t) & 3) * 128) : (size_t)(t) * kstep)
    const unsigned ldsw = (unsigned)wid * 1024u;
    const int aoff = lds_byte(wr * 64 + fr, fq * 8), boff = lds_byte(wc * 32 + fr, fq * 8);
#define PG8_SA(b, h) (((b) * 2 + (h)) * HTB)
#define PG8_SB(b, h) ((4 + (b) * 2 + (h)) * HTB)
#define PG8_STAGE(bufoff, gbase, voff) do { _Pragma("unroll") for (int _i = 0; _i < 2; ++_i) \
        __builtin_amdgcn_global_load_lds((const unsigned*)((const char*)(gbase) + (voff)[_i]), (LAS unsigned*)(lds + (bufoff) + ldsw + _i * 8192), 16, 0, 0); } while (0)
#define PG8_LDA(dst, b, h) do { _Pragma("unroll") for (int m = 0; m < 4; ++m) _Pragma("unroll") for (int k = 0; k < 2; ++k) dst[m][k] = *(const LAS bf16x8*)(lds + PG8_SA(b, h) + aoff + m * 2048 + k * 1024); } while (0)
#define PG8_LDB(dst, b, h) do { _Pragma("unroll") for (int n = 0; n < 2; ++n) _Pragma("unroll") for (int k = 0; k < 2; ++k) dst[n][k] = *(const LAS bf16x8*)(lds + PG8_SB(b, h) + boff + n * 2048 + k * 1024); } while (0)
#define PG8_MMA(ai, bj, At, Bt) do { __builtin_amdgcn_s_setprio(1); _Pragma("unroll") for (int m = 0; m < 4; ++m) _Pragma("unroll") for (int n = 0; n < 2; ++n) _Pragma("unroll") for (int k = 0; k < 2; ++k) \
        acc[ai][bj][m][n] = __builtin_amdgcn_mfma_f32_16x16x32_bf16(Bt[n][k], At[m][k], acc[ai][bj][m][n], 0, 0, 0); __builtin_amdgcn_s_setprio(0); } while (0)
#define PG8_WAIT_V(n) asm volatile("s_waitcnt vmcnt(" #n ")" ::: "memory")
#define PG8_WAIT_L(n) asm volatile("s_waitcnt lgkmcnt(" #n ")" ::: "memory")
#define PG8_BAR __builtin_amdgcn_s_barrier()
#define PG8_SCHED __builtin_amdgcn_sched_barrier(0)
    Unit cur, nxt; int ui = 0;
    if (!S.next(0, cur)) return;
    f32x4 acc[2][2][4][2];
#pragma unroll
    for (int a = 0; a < 2; ++a)
#pragma unroll
        for (int b = 0; b < 2; ++b)
#pragma unroll
            for (int m = 0; m < 4; ++m)
#pragma unroll
                for (int n = 0; n < 2; ++n) acc[a][b][m][n] = (f32x4){0.f, 0.f, 0.f, 0.f};
    bf16x8 At[4][2], B0[2][2], B1[2][2];
    const char* cA = (const char*)g.A + (size_t)cur.pm * tA; const char* cB = (const char*)g.Bt + (size_t)cur.pn * tB;
    PG8_STAGE(PG8_SB(0, 0), cB, voffB); PG8_STAGE(PG8_SB(0, 1), cB + hB, voffB); PG8_STAGE(PG8_SA(0, 0), cA, voffA); PG8_STAGE(PG8_SA(0, 1), cA + hA, voffA);
    if (wr == 1) PG8_BAR;
    PG8_WAIT_V(2); PG8_BAR;
    PG8_STAGE(PG8_SB(1, 0), cB + kstep, voffB); PG8_STAGE(PG8_SA(1, 0), cA + kstep, voffA); PG8_STAGE(PG8_SB(1, 1), cB + hB + kstep, voffB);
    PG8_WAIT_V(6); PG8_BAR;
    for (;;) {
        const bool has_next = S.next(ui + 1, nxt);
        const char* nA = has_next ? (const char*)g.A + (size_t)nxt.pm * tA : cA; const char* nB = has_next ? (const char*)g.Bt + (size_t)nxt.pn * tB : cB;
        for (int t = 0; t < nt; t += 2) {
            const bool last = (t == nt - 2);
            const char* a1 = cA + PG8_AKOFF(t + 1);
            const char* a2 = last ? nA : cA + PG8_AKOFF(t + 2); const char* b2 = last ? nB : cB + (size_t)(t + 2) * kstep;
            const char* a3 = a2 + kstep; const char* b3 = b2 + kstep;
            PG8_LDB(B0, 0, 0); PG8_LDB(B1, 0, 1); PG8_SCHED; PG8_LDA(At, 0, 0); PG8_STAGE(PG8_SA(1, 1), a1 + hA, voffA);
            PG8_WAIT_V(8); PG8_WAIT_L(0); PG8_BAR; PG8_MMA(0, 0, At, B0); PG8_MMA(0, 1, At, B1); PG8_BAR; PG8_SCHED;
            PG8_LDA(At, 0, 1); PG8_STAGE(PG8_SB(0, 0), b2, voffB); PG8_STAGE(PG8_SB(0, 1), b2 + hB, voffB); PG8_STAGE(PG8_SA(0, 0), a2, voffA);
            PG8_WAIT_V(8); PG8_WAIT_L(0); PG8_BAR; PG8_MMA(1, 0, At, B0); PG8_MMA(1, 1, At, B1); PG8_BAR; PG8_SCHED;
            PG8_LDB(B0, 1, 0); PG8_LDB(B1, 1, 1); PG8_SCHED; PG8_LDA(At, 1, 0); PG8_STAGE(PG8_SA(0, 1), a2 + hA, voffA);
            PG8_WAIT_V(8); PG8_WAIT_L(0); PG8_BAR; PG8_MMA(0, 0, At, B0); PG8_MMA(0, 1, At, B1); PG8_BAR; PG8_SCHED;
            PG8_LDA(At, 1, 1); PG8_STAGE(PG8_SB(1, 0), b3, voffB); PG8_STAGE(PG8_SB(1, 1), b3 + hB, voffB); PG8_STAGE(PG8_SA(1, 0), a3, voffA);
            PG8_WAIT_V(8); PG8_WAIT_L(0); PG8_BAR; PG8_MMA(1, 0, At, B0); PG8_MMA(1, 1, At, B1); PG8_BAR; PG8_SCHED;
        }
        if (wr == 0) PG8_BAR;
        E(acc, cur, wr, wc, fr, fq);
        if (!has_next) break;
#pragma unroll
        for (int a = 0; a < 2; ++a)
#pragma unroll
            for (int b = 0; b < 2; ++b)
#pragma unroll
                for (int m = 0; m < 4; ++m)
#pragma unroll
                    for (int n = 0; n < 2; ++n) acc[a][b][m][n] = (f32x4){0.f, 0.f, 0.f, 0.f};
        cur = nxt; cA = nA; cB = nB; ++ui;
        if (wr == 1) PG8_BAR;
    }
    PG8_WAIT_V(0);
    PG8_BAR;
#undef PG8_SA
#undef PG8_AKOFF
#undef PG8_SB
#undef PG8_STAGE
#undef PG8_LDA
#undef PG8_LDB
#undef PG8_MMA
#undef PG8_WAIT_V
#undef PG8_WAIT_L
#undef PG8_BAR
#undef PG8_SCHED
}
}

struct EpiProj {
    static constexpr bool PERM = true;
    bf16_t* proj; float* small; bf16_t* halo;
    DI void operator()(const f32x4 (&acc)[2][2][4][2], const pg8::Unit& u, int wr, int wc, int fr, int fq) const {
        const int row0 = u.pm * 256 + wr * 64 + fr;
        if (u.pn < 26) {
            const int col0 = u.pn * 256 + wc * 32 + 8 * fq;
            const bool conv = (u.pn >= 8 && u.pn < 20);
#pragma unroll
            for (int ai = 0; ai < 2; ++ai)
#pragma unroll
                for (int m = 0; m < 4; ++m) {
                    const int row = row0 + ai * 128 + m * 16;
                    bf16_t* rowp = proj + pidx((size_t)row, col0);
#pragma unroll
                    for (int bj = 0; bj < 2; ++bj) {
                        const f32x4 v0 = acc[ai][bj][m][0], v1 = acc[ai][bj][m][1];
                        u32x4 w; w.x = pk_bf16(v0[0], v0[1]); w.y = pk_bf16(v0[2], v0[3]); w.z = pk_bf16(v1[0], v1[1]); w.w = pk_bf16(v1[2], v1[3]);
                        *(u32x4*)(rowp + bj * 128) = w;
                        if (m == 3 && conv && fr >= 13)
                            *(u32x4*)(halo + ((size_t)(row >> 6) * 3 + (fr - 13)) * 3072 + (col0 + bj * 128 - 2048)) = w;
                    }
                }
        } else if (wc == 0) {
#pragma unroll
            for (int ai = 0; ai < 2; ++ai)
#pragma unroll
                for (int m = 0; m < 4; ++m) {
                    const int row = row0 + ai * 128 + m * 16;
                    float* pp = small + (size_t)row * 32 + 8 * fq;
                    *(f32x4*)pp = acc[ai][0][m][0]; *(f32x4*)(pp + 4) = acc[ai][0][m][1];
                }
        }
    }
};
struct EpiOut {
    static constexpr bool PERM = true;
    bf16_t* O;
    DI void operator()(const f32x4 (&acc)[2][2][4][2], const pg8::Unit& u, int wr, int wc, int fr, int fq) const {
        const int row0 = u.pm * 256 + wr * 64 + fr, col0 = u.pn * 256 + wc * 32 + 8 * fq;
#pragma unroll
        for (int ai = 0; ai < 2; ++ai)
#pragma unroll
            for (int m = 0; m < 4; ++m) {
                bf16_t* rowp = O + pidx((size_t)(row0 + ai * 128 + m * 16), 2048 + col0);
#pragma unroll
                for (int bj = 0; bj < 2; ++bj) {
                    const f32x4 v0 = acc[ai][bj][m][0], v1 = acc[ai][bj][m][1];
                    u32x4 w; w.x = pk_bf16(v0[0], v0[1]); w.y = pk_bf16(v0[2], v0[3]); w.z = pk_bf16(v1[0], v1[1]); w.w = pk_bf16(v1[2], v1[3]);
                    *(u32x4*)(rowp + bj * 128) = w;
                }
            }
    }
};

template <int KSTEPS>
DI f32x4 mma_tile(f32x4 acc, const LAS bf16_t* A, int lda, const LAS bf16_t* B, int ldb, int r, int q) {
#pragma unroll
    for (int k = 0; k < KSTEPS; ++k) {
        const bf16x8 a = *(const LAS bf16x8*)(A + r * lda + k * 32 + q * 8);
        const bf16x8 b = *(const LAS bf16x8*)(B + r * ldb + k * 32 + q * 8);
        acc = __builtin_amdgcn_mfma_f32_16x16x32_bf16(a, b, acc, 0, 0, 0);
    }
    return acc;
}

template <int KS> DI void ldfrag(bf16x8 (&f)[KS], const LAS bf16_t* base, int ld, int r, int q) {
#pragma unroll
    for (int k = 0; k < KS; ++k) f[k] = *(const LAS bf16x8*)(base + r * ld + k * 32 + q * 8);
}
template <int KS> DI f32x4 mmafrag(f32x4 acc, const bf16x8 (&a)[KS], const bf16x8 (&b)[KS]) {
#pragma unroll
    for (int k = 0; k < KS; ++k) acc = __builtin_amdgcn_mfma_f32_16x16x32_bf16(a[k], b[k], acc, 0, 0, 0);
    return acc;
}

DI int orig_col(int n) {
    if (n < 512) return 1536 + n;
    if (n < 1536) return 3592 + (n - 512);
    if (n < 2048) return 6168 + (n - 1536);
    if (n < 3584) return n - 2048;
    if (n < 5120) return 2056 + (n - 3584);
    if (n < 6656) return 4632 + (n - 5120);
    if (n < 6664) return 2048 + (n - 6656);
    if (n < 6680) return 4616 + (n - 6664);
    return -1;
}
__device__ void phase_convert(const P& p) {
    bf16_t* WinT = (bf16_t*)(p.ws + WS_WIN); bf16_t* WoutT = (bf16_t*)(p.ws + WS_WOUT);
    const size_t gsz = (size_t)gridDim.x * blockDim.x, g0 = (size_t)blockIdx.x * blockDim.x + opaque_tid();
    const size_t n1 = (size_t)2 * 128 * NPW;
    for (size_t i = g0; i < n1; i += gsz) {
        const int n = (int)(i % NPW); const int k8 = (int)((i / NPW) % 128); const int l = (int)(i / ((size_t)NPW * 128));
        const int oc = orig_col(n);
        float v[8];
#pragma unroll
        for (int e = 0; e < 8; ++e) v[e] = oc >= 0 ? p.w_in[((size_t)l * 1024 + k8 * 8 + e) * NIN + oc] : 0.f;
        u32x4 w; w.x = pk_bf16(v[0], v[1]); w.y = pk_bf16(v[2], v[3]); w.z = pk_bf16(v[4], v[5]); w.w = pk_bf16(v[6], v[7]);
        *(u32x4*)(WinT + ((size_t)l * NPW + n) * 1024 + k8 * 8) = w;
    }
    const size_t n2 = (size_t)2 * 256 * 1024;
    for (size_t i = g0; i < n2; i += gsz) {
        const int n = (int)(i % 1024); const int k8 = (int)((i / 1024) % 256); const int l = (int)(i / (1024 * 256));
        float v[8];
#pragma unroll
        for (int e = 0; e < 8; ++e) v[e] = p.w_out[((size_t)l * 2048 + k8 * 8 + e) * 1024 + n];
        u32x4 w; w.x = pk_bf16(v[0], v[1]); w.y = pk_bf16(v[2], v[3]); w.z = pk_bf16(v[4], v[5]); w.w = pk_bf16(v[6], v[7]);
        *(u32x4*)(WoutT + ((size_t)l * 1024 + n) * 2048 + k8 * 8) = w;
    }
}
__device__ void phase_rows(const float* xin, const bf16_t* o, int ldo, const float* post, float* xout, const float* pre, bf16_t* h) {
    const int tid_ = opaque_tid(); const int lane = tid_ & 63, wv = tid_ >> 6;
    const int stride = gridDim.x * 8;
    f32x4 xn[4]; u32x2 on[4];
#define R_LOAD(rr) do { _Pragma("unroll") for (int j = 0; j < 4; ++j) { xn[j] = __builtin_nontemporal_load((const f32x4*)(xin + (size_t)(rr) * DM + j * 256 + lane * 4)); \
        if (o) on[j] = __builtin_nontemporal_load((const u32x2*)(o + pidx((size_t)(rr), 2048 + j * 256 + lane * 4))); } } while (0)
    int row = blockIdx.x * 8 + wv;
#pragma unroll
    for (int j = 0; j < 4; ++j) on[j] = (u32x2){0u, 0u};
    if (row < T_TOK) R_LOAD(row);
    for (; row < T_TOK; row += stride) {
        f32x4 xv[4]; u32x2 ow[4];
#pragma unroll
        for (int j = 0; j < 4; ++j) { xv[j] = xn[j]; ow[j] = on[j]; }
        if (row + stride < T_TOK) R_LOAD(row + stride);
        if (o) {
            f32x4 ov[4]; float ss = 0.f;
#pragma unroll
            for (int j = 0; j < 4; ++j) { ov[j] = (f32x4){bf_lo(ow[j].x), bf_hi(ow[j].x), bf_lo(ow[j].y), bf_hi(ow[j].y)}; ss += ov[j][0] * ov[j][0] + ov[j][1] * ov[j][1] + ov[j][2] * ov[j][2] + ov[j][3] * ov[j][3]; }
#pragma unroll
            for (int s = 1; s < 64; s <<= 1) ss += __shfl_xor(ss, s);
            const float rs = rsqrtf(ss * (1.0f / DM) + EPS);
#pragma unroll
            for (int j = 0; j < 4; ++j) { const f32x4 pw = *(const f32x4*)(post + j * 256 + lane * 4); xv[j] += ov[j] * rs * pw;
                *(f32x4*)(xout + (size_t)row * DM + j * 256 + lane * 4) = xv[j]; }
        }
        if (pre) {
            float ss = 0.f;
#pragma unroll
            for (int j = 0; j < 4; ++j) ss += xv[j][0] * xv[j][0] + xv[j][1] * xv[j][1] + xv[j][2] * xv[j][2] + xv[j][3] * xv[j][3];
#pragma unroll
            for (int s = 1; s < 64; s <<= 1) ss += __shfl_xor(ss, s);
            const float rs = rsqrtf(ss * (1.0f / DM) + EPS);
#pragma unroll
            for (int j = 0; j < 4; ++j) { const f32x4 pw = *(const f32x4*)(pre + j * 256 + lane * 4); const f32x4 hv = xv[j] * rs * pw;
                u32x2 w; w.x = pk_bf16(hv[0], hv[1]); w.y = pk_bf16(hv[2], hv[3]); *(u32x2*)(h + (size_t)row * DM + j * 256 + lane * 4) = w; }
        }
    }
#undef R_LOAD
}

__device__ void phaseB_gdn(LAS unsigned char* lds, const P& p, int layer, int chunkg, int h) {
    const int tid = opaque_tid(), lane = tid & 63, wid = tid >> 6, r = lane & 15, q = lane >> 4;
    const int c = chunkg & 127;
    const size_t t0 = (size_t)chunkg * 64;
    bf16_t* proj = (bf16_t*)(p.ws + WS_PROJ); const bf16_t* halo = (const bf16_t*)(p.ws + WS_HALO);
    const float* small = (const float*)(p.ws + WS_SMALL);
    LAS bf16_t* kb = (LAS bf16_t*)lds;
    LAS float* rhs = (LAS float*)(lds + 17408);
    LAS float* Am = (LAS float*)(lds + 17408 + 65536);
    LAS float* gS = (LAS float*)(lds + 17408 + 65536 + 16384);
    const float* cw = p.gdn_conv + (size_t)layer * 4 * 1536;
    LAS float* cwS = (LAS float*)(lds + 17408 + 65536 + 16384 + 512);
    float braw = 0.f, araw = 0.f;
    if (wid == 0) { braw = small[(t0 + lane) * 32 + h]; araw = small[(t0 + lane) * 32 + 4 + h]; }
    float wl[3];
#pragma unroll
    for (int k = 0; k < 3; ++k) { const int rem = tid; wl[k] = cw[(rem >> 7) * 1536 + k * 512 + h * 128 + (rem & 127)]; }
    u32x4 xr[3][2][4];
#pragma unroll
    for (int s = 0; s < 3; ++s)
#pragma unroll
        for (int pass = 0; pass < 2; ++pass) {
            const int tok = pass * 32 + (tid >> 4), seg = tid & 15, col0u = C_GQ + s * 512 + h * 128, col = col0u + seg * 8;
#pragma unroll
            for (int d = 0; d < 4; ++d) {
                const int tt = tok - 3 + d;
                u32x4 v = (u32x4){0u, 0u, 0u, 0u};
                if (tt >= 0) v = *(const u32x4*)(proj + ((((size_t)chunkg >> 2) * 26 + (size_t)(col0u >> 8)) * 65536 + ((size_t)chunkg & 3) * 16384) + tt * 256 + (col & 255));
                else if (c > 0) v = *(const u32x4*)(halo + ((size_t)(chunkg - 1) * 3 + (tt + 3)) * 3072 + (col - 2048));
                xr[s][pass][d] = v;
            }
        }
#pragma unroll
    for (int k = 0; k < 3; ++k) cwS[k * 512 + tid] = wl[k];
    if (wid == 0) {
        const float beta = 1.0f / (1.0f + __expf(-braw));
        const float g = -__expf(p.gdn_A_log[layer * 4 + h]) * softplusf(araw + p.gdn_dt_bias[layer * 4 + h]);
        const float gc = wave_scan_incl(g, lane);
        gS[lane] = gc; gS[64 + lane] = beta;
        ((float*)(p.ws + WS_GCUM))[(t0 + lane) * 4 + h] = gc;
    }
    __syncthreads();
    u32x4 qpk[2];
#pragma unroll
    for (int s = 0; s < 3; ++s) {
#pragma unroll
        for (int pass = 0; pass < 2; ++pass) {
            const int tok = pass * 32 + (tid >> 4), seg = tid & 15;
            f32x2 v2[4];
#pragma unroll
            for (int k = 0; k < 4; ++k) v2[k] = (f32x2){0.f, 0.f};
#pragma unroll
            for (int d = 0; d < 4; ++d) {
                f32x2 x2[4]; unpack8(xr[s][pass][d], x2);
                const f32x4 w0 = *(const LAS f32x4*)(cwS + s * 512 + d * 128 + seg * 8), w1 = *(const LAS f32x4*)(cwS + s * 512 + d * 128 + seg * 8 + 4);
                v2[0] = __builtin_elementwise_fma((f32x2){w0[0], w0[1]}, x2[0], v2[0]); v2[1] = __builtin_elementwise_fma((f32x2){w0[2], w0[3]}, x2[1], v2[1]);
                v2[2] = __builtin_elementwise_fma((f32x2){w1[0], w1[1]}, x2[2], v2[2]); v2[3] = __builtin_elementwise_fma((f32x2){w1[2], w1[3]}, x2[3], v2[3]);
            }
            f32x2 ss2 = (f32x2){0.f, 0.f};
#pragma unroll
            for (int k = 0; k < 4; ++k) { v2[k] = silu2(v2[k]); ss2 = __builtin_elementwise_fma(v2[k], v2[k], ss2); }
            float ss = ss2[0] + ss2[1];
            if (s < 2) {
                ss += __shfl_xor(ss, 1); ss += __shfl_xor(ss, 2); ss += __shfl_xor(ss, 4); ss += __shfl_xor(ss, 8);
                const float rn = rsqrtf(ss + EPS) * (s == 0 ? 0.08838834764831845f : 1.0f);
#pragma unroll
                for (int k = 0; k < 4; ++k) v2[k] *= rn;
            }
            const float val[8] = {v2[0][0], v2[0][1], v2[1][0], v2[1][1], v2[2][0], v2[2][1], v2[3][0], v2[3][1]};
            if (s == 0) {
                u32x4 w; w.x = pk_bf16(val[0], val[1]); w.y = pk_bf16(val[2], val[3]); w.z = pk_bf16(val[4], val[5]); w.w = pk_bf16(val[6], val[7]);
                qpk[pass] = w;
            } else if (s == 1) {
                u32x4 w; w.x = pk_bf16(val[0], val[1]); w.y = pk_bf16(val[2], val[3]); w.z = pk_bf16(val[4], val[5]); w.w = pk_bf16(val[6], val[7]);
                *(LAS u32x4*)(kb + tok * 136 + seg * 8) = w;
                const float f = gS[64 + tok] * __expf(gS[tok]);
                *(LAS f32x4*)(rhs + tok * 256 + 128 + seg * 8) = (f32x4){f * val[0], f * val[1], f * val[2], f * val[3]};
                *(LAS f32x4*)(rhs + tok * 256 + 128 + seg * 8 + 4) = (f32x4){f * val[4], f * val[5], f * val[6], f * val[7]};
            } else {
                const float f = gS[64 + tok];
                *(LAS f32x4*)(rhs + tok * 256 + seg * 8) = (f32x4){f * val[0], f * val[1], f * val[2], f * val[3]};
                *(LAS f32x4*)(rhs + tok * 256 + seg * 8 + 4) = (f32x4){f * val[4], f * val[5], f * val[6], f * val[7]};
            }
        }
    }
    __syncthreads();
#pragma unroll
    for (int pass = 0; pass < 2; ++pass) {
        const int item = pass * 512 + tid, tok = item >> 4, seg = item & 15;
        *(u32x4*)(proj + pidx(t0 + tok, C_GQ + h * 128 + seg * 8)) = qpk[pass];
    }
#pragma unroll
    for (int tt = 0; tt < 2; ++tt) {
        const int id = wid * 2 + tt, mt = id >> 2, nt = id & 3;
        f32x4 acc = (f32x4){0.f, 0.f, 0.f, 0.f};
        acc = mma_tile<4>(acc, kb + mt * 16 * 136, 136, kb + nt * 16 * 136, 136, r, q);
        const int j = nt * 16 + r; const float gj = gS[j];
        f32x4 av;
#pragma unroll
        for (int jj = 0; jj < 4; ++jj) {
            const int i = mt * 16 + q * 4 + jj;
            av[jj] = (j < i) ? -(gS[64 + i] * acc[jj] * __expf(gS[i] - gj)) : 0.f;
        }
        *(LAS f32x4*)(Am + j * 64 + mt * 16 + q * 4) = av;
    }
    __syncthreads();
    if (tid < 256) {
        float xs[64];
        int zoff; asm volatile("v_mov_b32 %0, 0" : "=v"(zoff));
        const LAS float* Az = Am + zoff;
        {
            f32x2 x2[32];
#pragma unroll
            for (int k = 0; k < 32; ++k) x2[k] = (f32x2){rhs[(2 * k) * 256 + tid], rhs[(2 * k + 1) * 256 + tid]};
            f32x4 an[16], ac[16];
#pragma unroll
            for (int k = 0; k < 16; ++k) an[k] = *(const LAS f32x4*)(Az + 4 * k);
#pragma unroll
            for (int j = 0; j < 63; ++j) {
#pragma unroll
                for (int k = 0; k < 16; ++k) ac[k] = an[k];
                if (j + 1 < 63) {
#pragma unroll
                    for (int k = (j + 2) / 4; k < 16; ++k) an[k] = *(const LAS f32x4*)(Az + (j + 1) * 64 + 4 * k);
                }
                __builtin_amdgcn_sched_barrier(0);
                const float xj = x2[j >> 1][j & 1];
                const f32x2 xj2 = (f32x2){xj, xj};
#pragma unroll
                for (int k = (j + 1) >> 1; k < 32; ++k) {
                    const f32x2 a2 = (k & 1) ? (f32x2){ac[k >> 1][2], ac[k >> 1][3]} : (f32x2){ac[k >> 1][0], ac[k >> 1][1]};
                    x2[k] = __builtin_elementwise_fma(a2, xj2, x2[k]);
                }
                __builtin_amdgcn_sched_barrier(0);
            }
#pragma unroll
            for (int k = 0; k < 32; ++k) { xs[2 * k] = x2[k][0]; xs[2 * k + 1] = x2[k][1]; }
        }
        if (tid < 128) {
            const int e = tid >> 6, dvl = tid & 63;
            bf16_t* dst = proj + pidx(t0 + dvl, C_GV + h * 128 + e * 64);
#pragma unroll
            for (int k = 0; k < 8; ++k) {
                u32x4 w; w.x = pk_bf16(xs[8 * k], xs[8 * k + 1]); w.y = pk_bf16(xs[8 * k + 2], xs[8 * k + 3]); w.z = pk_bf16(xs[8 * k + 4], xs[8 * k + 5]); w.w = pk_bf16(xs[8 * k + 6], xs[8 * k + 7]);
                *(u32x4*)(dst + 8 * k) = w;
            }
        } else {
            bf16_t* wb = (bf16_t*)(p.ws + WS_WBUF) + t0 * 512 + h * 128 + (tid - 128);
#pragma unroll
            for (int i = 0; i < 64; ++i) wb[(size_t)i * 512] = (bf16_t)(pk_bf16(xs[i], 0.f) & 0xffffu);
        }
    }
#pragma unroll
    for (int pass = 0; pass < 2; ++pass) {
        const int item = pass * 512 + tid, tok = item >> 4, seg = item & 15;
        *(u32x4*)(proj + pidx(t0 + tok, C_GK + h * 128 + seg * 8)) = *(const LAS u32x4*)(kb + tok * 136 + seg * 8);
    }
    __syncthreads();
}
__device__ void phaseB_ssd(const P& p, int layer, int chunkg) {
    const int tid = opaque_tid(), lane = tid & 63, wid = tid >> 6;
    const int c = chunkg & 127;
    const size_t t0 = (size_t)chunkg * 64;
    bf16_t* proj = (bf16_t*)(p.ws + WS_PROJ); const bf16_t* halo = (const bf16_t*)(p.ws + WS_HALO);
    const float* small = (const float*)(p.ws + WS_SMALL);
#pragma unroll
    for (int k = 0; k < 2; ++k) {
        const int hd = wid * 2 + k;
        const float dt = softplusf(small[(t0 + lane) * 32 + 8 + hd] + p.ssd_dt_bias[layer * 16 + hd]);
        const float a = -__expf(p.ssd_A_log[layer * 16 + hd]) * dt;
        const float ac = wave_scan_incl(a, lane);
        { ((float*)(p.ws + WS_DT))[(t0 + lane) * 16 + hd] = dt;
        ((float*)(p.ws + WS_ACUM))[(t0 + lane) * 16 + hd] = ac; }
    }
    const int seg = tid % 192, half = tid / 192;
    const int col = C_SX + seg * 8, ch = seg * 8;
    const bool act = tid < 384;
    u32x4 win[3];
    win[0] = win[1] = win[2] = (u32x4){0u, 0u, 0u, 0u};
    u32x4 rows[32];
    f32x2 wg2[4][4], bias2[4];
    if (act) {
        if (half == 1) {
#pragma unroll
            for (int d = 0; d < 3; ++d) win[d] = *(const u32x4*)(proj + pidx(t0 + 29 + d, col));
        } else if (c > 0) {
#pragma unroll
            for (int d = 0; d < 3; ++d) win[d] = *(const u32x4*)(halo + ((size_t)(chunkg - 1) * 3 + d) * 3072 + (col - 2048));
        }
#pragma unroll
        for (int k = 0; k < 32; ++k) rows[k] = __builtin_nontemporal_load((const u32x4*)(proj + pidx(t0 + half * 32 + k, col)));
        const float* cw = p.ssd_conv + (size_t)layer * 4 * 1536; const float* cb = p.ssd_conv_b + (size_t)layer * 1536;
#pragma unroll
        for (int d = 0; d < 4; ++d) {
            const f32x4 a = *(const f32x4*)(cw + d * 1536 + ch), bq = *(const f32x4*)(cw + d * 1536 + ch + 4);
            wg2[d][0] = (f32x2){a[0], a[1]}; wg2[d][1] = (f32x2){a[2], a[3]}; wg2[d][2] = (f32x2){bq[0], bq[1]}; wg2[d][3] = (f32x2){bq[2], bq[3]};
        }
        { const f32x4 a = *(const f32x4*)(cb + ch), bq = *(const f32x4*)(cb + ch + 4);
          bias2[0] = (f32x2){a[0], a[1]}; bias2[1] = (f32x2){a[2], a[3]}; bias2[2] = (f32x2){bq[0], bq[1]}; bias2[3] = (f32x2){bq[2], bq[3]}; }
    }
    __syncthreads();
    if (act) {
        f32x2 w0[4], w1[4], w2[4];
        unpack8(win[0], w0); unpack8(win[1], w1); unpack8(win[2], w2);
#pragma unroll
        for (int k = 0; k < 32; ++k) {
            f32x2 x3[4]; unpack8(rows[k], x3);
            f32x2 v2[4];
#pragma unroll
            for (int e = 0; e < 4; ++e) {
                f32x2 a = __builtin_elementwise_fma(wg2[0][e], w0[e], bias2[e]);
                a = __builtin_elementwise_fma(wg2[1][e], w1[e], a);
                a = __builtin_elementwise_fma(wg2[2][e], w2[e], a);
                a = __builtin_elementwise_fma(wg2[3][e], x3[e], a);
                v2[e] = silu2(a);
                w0[e] = w1[e]; w1[e] = w2[e]; w2[e] = x3[e];
            }
            u32x4 w; w.x = pk_bf16(v2[0][0], v2[0][1]); w.y = pk_bf16(v2[1][0], v2[1][1]); w.z = pk_bf16(v2[2][0], v2[2][1]); w.w = pk_bf16(v2[3][0], v2[3][1]);
            *(u32x4*)(proj + pidx(t0 + half * 32 + k, col)) = w;
        }
    }
}
__device__ void phaseB_ret(const P& p, int chunkg) {
    const int tid = opaque_tid();
    const int c = chunkg & 127;
    const size_t t0 = (size_t)chunkg * 64;
    bf16_t* proj = (bf16_t*)(p.ws + WS_PROJ);
    const int tok = tid >> 3, pg = tid & 7;
    const float pos = (float)(c * 64 + tok);
    float cs[8], sn[8];
#pragma unroll
    for (int e = 0; e < 8; ++e) {
        const float inv = exp2f(-(float)(pg * 8 + e) * (13.287712379549449f / 64.0f));
        const float ang = pos * inv;
        const float n = rintf(ang * 0.15915494309189535f);
        float rr = fmaf(-n, 6.28125f, ang); rr = fmaf(-n, 0.0019353071795864769f, rr);
        cs[e] = __cosf(rr); sn[e] = __sinf(rr);
    }
    u32x4 ra[4][2], rb[4][2];
#pragma unroll
    for (int hh = 0; hh < 4; ++hh)
#pragma unroll
        for (int s = 0; s < 2; ++s) {
            const bf16_t* base = proj + pidx(t0 + tok, (s == 0 ? C_RQ : C_RK) + hh * 128 + pg * 8);
            ra[hh][s] = __builtin_nontemporal_load((const u32x4*)base); rb[hh][s] = __builtin_nontemporal_load((const u32x4*)(base + 64));
        }
#pragma unroll
    for (int hh = 0; hh < 4; ++hh)
#pragma unroll
        for (int s = 0; s < 2; ++s) {
            bf16_t* base = proj + pidx(t0 + tok, (s == 0 ? C_RQ : C_RK) + hh * 128 + pg * 8);
            const float sc = s == 0 ? 1.0f : 0.08838834764831845f;
            const u32x4 a = ra[hh][s], b = rb[hh][s];
            const float t1[8] = {bf_lo(a.x), bf_hi(a.x), bf_lo(a.y), bf_hi(a.y), bf_lo(a.z), bf_hi(a.z), bf_lo(a.w), bf_hi(a.w)};
            const float t2[8] = {bf_lo(b.x), bf_hi(b.x), bf_lo(b.y), bf_hi(b.y), bf_lo(b.z), bf_hi(b.z), bf_lo(b.w), bf_hi(b.w)};
            float o1[8], o2[8];
#pragma unroll
            for (int e = 0; e < 8; ++e) { o1[e] = (t1[e] * cs[e] - t2[e] * sn[e]) * sc; o2[e] = (t1[e] * sn[e] + t2[e] * cs[e]) * sc; }
            u32x4 w1, w2;
            w1.x = pk_bf16(o1[0], o1[1]); w1.y = pk_bf16(o1[2], o1[3]); w1.z = pk_bf16(o1[4], o1[5]); w1.w = pk_bf16(o1[6], o1[7]);
            w2.x = pk_bf16(o2[0], o2[1]); w2.y = pk_bf16(o2[2], o2[3]); w2.z = pk_bf16(o2[4], o2[5]); w2.w = pk_bf16(o2[6], o2[7]);
            { *(u32x4*)base = w1; *(u32x4*)(base + 64) = w2; }
        }
}

constexpr int L_QS = 0, L_KS = 17408, L_WS = 34816, L_ST = 52224, L_VT = 69632, L_VST = 78848, L_AT = 88064, L_UT = 97280, L_CUM = 106496, L_DT = 106752;
constexpr int L_ALT = 107008;
constexpr int D_KS = L_ALT - L_KS, D_ST = L_ALT + 17408 - L_ST, D_VT = L_ALT + 34816 - L_VT, D_VST = L_ALT + 44032 - L_VST, D_CUM = L_ALT + 53248 - L_CUM;
typedef short s16x4 __attribute__((ext_vector_type(4)));
DI bf16x8 ldfrag_tr(const LAS bf16_t* X, int ld, int k0, int m0, int r, int q) {
    const LAS bf16_t* a = X + (k0 + q * 8 + (r >> 2)) * ld + m0 + 4 * (r & 3);
    const s16x4 lo = __builtin_amdgcn_ds_read_tr16_b64_v4i16((LAS s16x4*)a);
    const s16x4 hi = __builtin_amdgcn_ds_read_tr16_b64_v4i16((LAS s16x4*)(a + 4 * ld));
    return __builtin_shufflevector(lo, hi, 0, 1, 2, 3, 4, 5, 6, 7);
}
template <int KIND>
__device__ void phaseC_item(LAS unsigned char* lds, const P& p, int layer, int sub) {
    const int tid = opaque_tid(), lane = tid & 63, wid = __builtin_amdgcn_readfirstlane(tid >> 6), r = lane & 15, q = lane >> 4;
    bf16_t* proj = (bf16_t*)(p.ws + WS_PROJ);
    int b, qcol, kcol, vcol, hidx; float Dval = 0.f, lg = 0.f;
    if (KIND == 0) { b = sub >> 3; const int h = (sub >> 1) & 3, e = sub & 1; hidx = h; qcol = C_GQ + h * 128; kcol = C_GK + h * 128; vcol = C_GV + h * 128 + e * 64; }
    else if (KIND == 1) { b = sub >> 4; const int hd = sub & 15, grp = hd >> 3; hidx = hd; qcol = C_SC + grp * 128; kcol = C_SB + grp * 128; vcol = C_SX + hd * 64; Dval = p.ssd_D[layer * 16 + hd]; }
    else { b = sub >> 3; const int h = (sub >> 1) & 3, e = sub & 1; hidx = h; qcol = C_RQ + h * 128; kcol = C_RK + h * 128; vcol = C_RV + h * 128 + e * 64; lg = logf(1.0f - exp2f(-5.0f - (float)h)); }
    LAS bf16_t* Qs = (LAS bf16_t*)(lds + L_QS); LAS bf16_t* Ws = (LAS bf16_t*)(lds + L_WS);
    LAS bf16_t* AT = (LAS bf16_t*)(lds + L_AT); LAS bf16_t* UT = (LAS bf16_t*)(lds + L_UT);
    const bf16_t* Wbuf = (const bf16_t*)(p.ws + WS_WBUF);
    const float* gate = KIND == 0 ? (const float*)(p.ws + WS_GCUM) : (const float*)(p.ws + WS_ACUM);
    const float* gdt = (const float*)(p.ws + WS_DT);
    const int gstride = KIND == 0 ? 4 : 16;
    for (int i = tid; i < 17408 / 16; i += 512) *(LAS u32x4*)(lds + L_ST + i * 16) = (u32x4){0u, 0u, 0u, 0u};
    f32x4 Sacc[4];
#pragma unroll
    for (int n = 0; n < 4; ++n) Sacc[n] = (f32x4){0.f, 0.f, 0.f, 0.f};
    u32x4 pq[2], pk[2], pw[2], pv; float pcum = 0.f, pcl = 0.f, pdt = 1.f, pcum2 = 0.f, pdt2 = 1.f;
    const int mt = wid >> 1, nt0 = (wid & 1) * 2;
    u32x2 pz0 = (u32x2){0u, 0u}, pz1 = pz0, cz0 = pz0, cz1 = pz0;
    const int zcol = C_SZ + (vcol - C_SX);
    const int mytok = tid & 63, vtok = tid >> 3, vseg = tid & 7;
    const int loQ0 = (tid >> 4) * 256 + (qcol & 255) + (tid & 15) * 8, loK0 = (tid >> 4) * 256 + (kcol & 255) + (tid & 15) * 8;
    const int loV = vtok * 256 + (vcol & 255) + vseg * 8;
    const int loO = (nt0 * 16 + r) * 256 + (vcol & 255) + mt * 16 + q * 4, loZ = (nt0 * 16 + r) * 256 + (zcol & 255) + mt * 16 + q * 4;
#define TBASE(cc, col) ((((((size_t)b * NCHUNK + (cc)) >> 2) * 26 + (size_t)((col) >> 8)) * 65536) + ((((size_t)b * NCHUNK + (cc)) & 3) * 16384))
#define PREFETCH(cc) do { const size_t t0_ = ((size_t)b * NCHUNK + (cc)) * 64; \
        const bf16_t* tq_ = proj + TBASE(cc, qcol); const bf16_t* tk_ = proj + TBASE(cc, kcol); const bf16_t* tv_ = proj + TBASE(cc, vcol); \
        _Pragma("unroll") for (int it = 0; it < 2; ++it) { const int pp = tid + 512 * it; \
            pq[it] = *(const u32x4*)(tq_ + loQ0 + it * 8192); \
            pk[it] = *(const u32x4*)(tk_ + loK0 + it * 8192); \
            if (KIND == 0) pw[it] = *(const u32x4*)(Wbuf + (t0_ + (pp >> 4)) * 512 + hidx * 128 + (pp & 15) * 8); } \
        pv = *(const u32x4*)(tv_ + loV); \
        if (KIND != 2) { pcum = gate[(t0_ + mytok) * gstride + hidx]; pcl = gate[(t0_ + 63) * gstride + hidx]; } \
        else { pcum = (float)(mytok + 1) * lg; pcl = 64.0f * lg; } \
        if (KIND == 1) { pdt = gdt[(t0_ + mytok) * 16 + hidx]; pdt2 = gdt[(t0_ + vtok) * 16 + hidx]; pcum2 = gate[(t0_ + vtok) * gstride + hidx]; } \
        if (KIND == 2) pcum2 = (float)(vtok + 1) * lg; \
        if (KIND == 1) { const bf16_t* tz_ = proj + TBASE(cc, zcol); pz0 = *(const u32x2*)(tz_ + loZ); pz1 = *(const u32x2*)(tz_ + loZ + 4096); } } while (0)
    PREFETCH(0);
    u32x2 ow0 = (u32x2){0u, 0u}, ow1 = ow0;
    for (int c = 0; c < NCHUNK; ++c) {
        const size_t t0 = ((size_t)b * NCHUNK + c) * 64;
        const int par = c & 1;
        LAS bf16_t* Ks = (LAS bf16_t*)(lds + L_KS + par * D_KS); LAS bf16_t* ST = (LAS bf16_t*)(lds + L_ST + par * D_ST); LAS bf16_t* STn = (LAS bf16_t*)(lds + L_ST + (par ^ 1) * D_ST);
        LAS bf16_t* VT = (LAS bf16_t*)(lds + L_VT + par * D_VT);
        LAS bf16_t* VST = (LAS bf16_t*)(lds + L_VST + par * D_VST);
        LAS float* cumS = (LAS float*)(lds + L_CUM + par * D_CUM); LAS float* dtS = cumS + 64;
#pragma unroll
        for (int it = 0; it < 2; ++it) {
            const int pp = tid + 512 * it;
            *(LAS u32x4*)(Qs + (pp >> 4) * 136 + (pp & 15) * 8) = pq[it];
            *(LAS u32x4*)(Ks + (pp >> 4) * 136 + (pp & 15) * 8) = pk[it];
            if (KIND == 0) *(LAS u32x4*)(Ws + (pp >> 4) * 136 + (pp & 15) * 8) = pw[it];
        }
        if (KIND == 0) {
            *(LAS u32x4*)(UT + vtok * 72 + vseg * 8) = pv;
        } else {
            const float sa = KIND == 1 ? pdt2 : 1.0f, sb = sa * __expf(pcl - pcum2);
            const float v0 = bf_lo(pv.x), v1 = bf_hi(pv.x), v2 = bf_lo(pv.y), v3 = bf_hi(pv.y), v4 = bf_lo(pv.z), v5 = bf_hi(pv.z), v6 = bf_lo(pv.w), v7 = bf_hi(pv.w);
            u32x4 wa = pv;
            if (KIND == 1) { wa.x = pk_bf16(v0 * sa, v1 * sa); wa.y = pk_bf16(v2 * sa, v3 * sa); wa.z = pk_bf16(v4 * sa, v5 * sa); wa.w = pk_bf16(v6 * sa, v7 * sa); }
            u32x4 wb; wb.x = pk_bf16(v0 * sb, v1 * sb); wb.y = pk_bf16(v2 * sb, v3 * sb); wb.z = pk_bf16(v4 * sb, v5 * sb); wb.w = pk_bf16(v6 * sb, v7 * sb);
            *(LAS u32x4*)(VT + vtok * 72 + vseg * 8) = wa;
            *(LAS u32x4*)(VST + vtok * 72 + vseg * 8) = wb;
        }
        if (tid < 64) { cumS[tid] = pcum; if (KIND == 1) dtS[tid] = pdt; }
        if (KIND == 1) { cz0 = pz0; cz1 = pz1; }
        if (c > 0) {
            bf16_t* to_ = proj + TBASE(c - 1, vcol);
            *(u32x2*)(to_ + loO) = ow0;
            *(u32x2*)(to_ + loO + 4096) = ow1;
        }
        __syncthreads();
        if (c + 1 < NCHUNK) PREFETCH(c + 1);
        const float cl = cumS[63];
        bf16x8 gb[2][4];
        {
            bf16x8 fa[4], fb[2][4], ga[4];
            if (KIND == 0) { ldfrag<4>(fa, Ws + mt * 16 * 136, 136, r, q); ldfrag<4>(fb[0], ST + nt0 * 16 * 136, 136, r, q); ldfrag<4>(fb[1], ST + (nt0 + 1) * 16 * 136, 136, r, q); }
            ldfrag<4>(ga, Ks + mt * 16 * 136, 136, r, q); ldfrag<4>(gb[0], Qs + nt0 * 16 * 136, 136, r, q); ldfrag<4>(gb[1], Qs + (nt0 + 1) * 16 * 136, 136, r, q);
            const f32x4 cj = *(const LAS f32x4*)(cumS + mt * 16 + q * 4);
            u32x2 uu[2]; float ci[2], dti[2];
#pragma unroll
            for (int tt = 0; tt < 2; ++tt) {
                if (KIND == 0) uu[tt] = *(const LAS u32x2*)(UT + ((nt0 + tt) * 16 + r) * 72 + mt * 16 + q * 4);
                ci[tt] = cumS[(nt0 + tt) * 16 + r];
                if (KIND == 1) dti[tt] = dtS[(nt0 + tt) * 16 + r];
            }
            __builtin_amdgcn_sched_barrier(0);
            if (KIND == 0) {
                f32x4 a0 = (f32x4){0.f, 0.f, 0.f, 0.f}, a1 = a0;
                a0 = mmafrag<4>(a0, fa, fb[0]); a1 = mmafrag<4>(a1, fa, fb[1]);
                const float e0 = __expf(cl - cj[0]), e1 = __expf(cl - cj[1]), e2 = __expf(cl - cj[2]), e3 = __expf(cl - cj[3]);
#pragma unroll
                for (int tt = 0; tt < 2; ++tt) {
                    const f32x4 acc = tt ? a1 : a0;
                    const float v0 = bf_lo(uu[tt].x) - acc[0], v1 = bf_hi(uu[tt].x) - acc[1], v2 = bf_lo(uu[tt].y) - acc[2], v3 = bf_hi(uu[tt].y) - acc[3];
                    u32x2 w; w.x = pk_bf16(v0, v1); w.y = pk_bf16(v2, v3);
                    *(LAS u32x2*)(VT + ((nt0 + tt) * 16 + r) * 72 + mt * 16 + q * 4) = w;
                    u32x2 ws; ws.x = pk_bf16(v0 * e0, v1 * e1); ws.y = pk_bf16(v2 * e2, v3 * e3);
                    *(LAS u32x2*)(VST + ((nt0 + tt) * 16 + r) * 72 + mt * 16 + q * 4) = ws;
                }
            }
            {
                f32x4 a0 = (f32x4){0.f, 0.f, 0.f, 0.f}, a1 = a0;
                a0 = mmafrag<4>(a0, ga, gb[0]); a1 = mmafrag<4>(a1, ga, gb[1]);
#pragma unroll
                for (int tt = 0; tt < 2; ++tt) {
                    const f32x4 acc = tt ? a1 : a0;
                    const int i = (nt0 + tt) * 16 + r;
                    float f[4];
#pragma unroll
                    for (int jj = 0; jj < 4; ++jj) {
                        const int j = mt * 16 + q * 4 + jj;
                        float v = (j <= i) ? acc[jj] * __expf(ci[tt] - cj[jj]) : 0.f;
                        if (KIND == 1 && j == i) v += Dval * __builtin_amdgcn_rcpf(dti[tt]);
                        f[jj] = v;
                    }
                    u32x2 w; w.x = pk_bf16(f[0], f[1]); w.y = pk_bf16(f[2], f[3]);
                    *(LAS u32x2*)(AT + i * 72 + mt * 16 + q * 4) = w;
                }
            }
        }
        __syncthreads();
        {
            bf16x8 sa[4], va[2], ab[2][2], ka[2], vb[4][2];
            ldfrag<4>(sa, ST + mt * 16 * 136, 136, r, q);
            ldfrag<2>(ab[0], AT + nt0 * 16 * 72, 72, r, q); ldfrag<2>(ab[1], AT + (nt0 + 1) * 16 * 72, 72, r, q);
            if (KIND == 0) {
                ldfrag<2>(va, VT + mt * 16 * 72, 72, r, q);
#pragma unroll
                for (int n = 0; n < 4; ++n) ldfrag<2>(vb[n], VST + n * 16 * 72, 72, r, q);
            } else {
#pragma unroll
                for (int ks = 0; ks < 2; ++ks) {
                    va[ks] = ldfrag_tr(VT, 72, ks * 32, mt * 16, r, q);
#pragma unroll
                    for (int n = 0; n < 4; ++n) vb[n][ks] = ldfrag_tr(VST, 72, ks * 32, n * 16, r, q);
                }
            }
#pragma unroll
            for (int ks = 0; ks < 2; ++ks) ka[ks] = ldfrag_tr(Ks, 136, ks * 32, wid * 16, r, q);
            const float ei0 = __expf(cumS[nt0 * 16 + r]), ei1 = __expf(cumS[(nt0 + 1) * 16 + r]);
            const float dl = __expf(cl);
            __builtin_amdgcn_sched_barrier(0);
            f32x4 o0 = (f32x4){0.f, 0.f, 0.f, 0.f}, o1 = o0;
            o0 = mmafrag<4>(o0, sa, gb[0]); o1 = mmafrag<4>(o1, sa, gb[1]);
            o0 *= ei0; o1 *= ei1;
            o0 = mmafrag<2>(o0, va, ab[0]); o1 = mmafrag<2>(o1, va, ab[1]);
#pragma unroll
            for (int n = 0; n < 4; ++n) { Sacc[n] *= dl; Sacc[n] = mmafrag<2>(Sacc[n], ka, vb[n]); }
            if (KIND == 1) {
                o0[0] *= siluf(bf_lo(cz0.x)); o0[1] *= siluf(bf_hi(cz0.x)); o0[2] *= siluf(bf_lo(cz0.y)); o0[3] *= siluf(bf_hi(cz0.y));
                o1[0] *= siluf(bf_lo(cz1.x)); o1[1] *= siluf(bf_hi(cz1.x)); o1[2] *= siluf(bf_lo(cz1.y)); o1[3] *= siluf(bf_hi(cz1.y));
            }
            ow0.x = pk_bf16(o0[0], o0[1]); ow0.y = pk_bf16(o0[2], o0[3]);
            ow1.x = pk_bf16(o1[0], o1[1]); ow1.y = pk_bf16(o1[2], o1[3]);
        }
#pragma unroll
        for (int n = 0; n < 4; ++n) {
            u32x2 w; w.x = pk_bf16(Sacc[n][0], Sacc[n][1]); w.y = pk_bf16(Sacc[n][2], Sacc[n][3]);
            *(LAS u32x2*)(STn + (n * 16 + r) * 136 + wid * 16 + q * 4) = w;
        }
    }
    {
        const size_t tl = ((size_t)b * NCHUNK + NCHUNK - 1) * 64;
        bf16_t* to_ = proj + TBASE(NCHUNK - 1, vcol);
        *(u32x2*)(to_ + loO) = ow0;
        *(u32x2*)(to_ + loO + 4096) = ow1;
    }
    __syncthreads();
#undef PREFETCH
#undef TBASE
}

__device__ void phaseD(const P& p, int layer) {
    const int tid_ = opaque_tid(); const int lane = tid_ & 63, wv = tid_ >> 6;
    bf16_t* proj = (bf16_t*)(p.ws + WS_PROJ);
    const float* gw = p.gdn_norm + layer * 128; const float* rw = p.ret_norm + layer * 128; const float* sw = p.ssd_norm + layer * 1024;
    const int stride = gridDim.x * 8;
    u32x4 cur[8], nxt[8];
#define D_LOAD(dst, rr) do { const size_t rr_ = (size_t)(rr); \
        dst[0] = __builtin_nontemporal_load((const u32x4*)(proj + pidx(rr_, C_GV + lane * 8))); dst[1] = __builtin_nontemporal_load((const u32x4*)(proj + pidx(rr_, C_GZ + lane * 8))); \
        dst[2] = __builtin_nontemporal_load((const u32x4*)(proj + pidx(rr_, C_RV + lane * 8))); dst[3] = __builtin_nontemporal_load((const u32x4*)(proj + pidx(rr_, C_RG + lane * 8))); \
        dst[4] = __builtin_nontemporal_load((const u32x4*)(proj + pidx(rr_, C_SX + lane * 16))); dst[5] = (u32x4){0u, 0u, 0u, 0u}; \
        dst[6] = __builtin_nontemporal_load((const u32x4*)(proj + pidx(rr_, C_SX + lane * 16 + 8))); dst[7] = (u32x4){0u, 0u, 0u, 0u}; } while (0)
    int row = blockIdx.x * 8 + wv;
    if (row < T_TOK) D_LOAD(nxt, row);
    for (; row < T_TOK; row += stride) {
#pragma unroll
        for (int k = 0; k < 8; ++k) cur[k] = nxt[k];
        if (row + stride < T_TOK) D_LOAD(nxt, row + stride);
#pragma unroll
        for (int s = 0; s < 2; ++s) {
            const int zc = (s == 0 ? C_GZ : C_RG) + lane * 8;
            const float* nw = (s == 0 ? gw : rw) + (lane & 15) * 8;
            const u32x4 o = cur[2 * s], z = cur[2 * s + 1];
            float ov[8] = {bf_lo(o.x), bf_hi(o.x), bf_lo(o.y), bf_hi(o.y), bf_lo(o.z), bf_hi(o.z), bf_lo(o.w), bf_hi(o.w)};
            const float zv[8] = {bf_lo(z.x), bf_hi(z.x), bf_lo(z.y), bf_hi(z.y), bf_lo(z.z), bf_hi(z.z), bf_lo(z.w), bf_hi(z.w)};
            float ss = 0.f;
#pragma unroll
            for (int e = 0; e < 8; ++e) ss += ov[e] * ov[e];
            ss += __shfl_xor(ss, 1); ss += __shfl_xor(ss, 2); ss += __shfl_xor(ss, 4); ss += __shfl_xor(ss, 8);
            const float rs = rsqrtf(ss * (1.0f / 128.0f) + EPS);
#pragma unroll
            for (int e = 0; e < 8; ++e) ov[e] = ov[e] * rs * nw[e] * siluf(zv[e]);
            u32x4 w; w.x = pk_bf16(ov[0], ov[1]); w.y = pk_bf16(ov[2], ov[3]); w.z = pk_bf16(ov[4], ov[5]); w.w = pk_bf16(ov[6], ov[7]);
            *(u32x4*)(proj + pidx((size_t)row, zc)) = w;
        }
        {
            float yv[16];
#pragma unroll
            for (int k = 0; k < 2; ++k) {
                const u32x4 o = cur[4 + 2 * k], z = cur[5 + 2 * k];
                const float ov[8] = {bf_lo(o.x), bf_hi(o.x), bf_lo(o.y), bf_hi(o.y), bf_lo(o.z), bf_hi(o.z), bf_lo(o.w), bf_hi(o.w)};
                const float zv[8] = {bf_lo(z.x), bf_hi(z.x), bf_lo(z.y), bf_hi(z.y), bf_lo(z.z), bf_hi(z.z), bf_lo(z.w), bf_hi(z.w)};
#pragma unroll
                for (int e = 0; e < 8; ++e) yv[k * 8 + e] = ov[e];
            }
            float ss = 0.f;
#pragma unroll
            for (int e = 0; e < 16; ++e) ss += yv[e] * yv[e];
            ss += __shfl_xor(ss, 1); ss += __shfl_xor(ss, 2); ss += __shfl_xor(ss, 4); ss += __shfl_xor(ss, 8); ss += __shfl_xor(ss, 16);
            const float rs = rsqrtf(ss * (1.0f / 512.0f) + EPS);
#pragma unroll
            for (int k = 0; k < 2; ++k) {
                const float* nw = sw + lane * 16 + k * 8;
                u32x4 w; w.x = pk_bf16(yv[k * 8] * rs * nw[0], yv[k * 8 + 1] * rs * nw[1]); w.y = pk_bf16(yv[k * 8 + 2] * rs * nw[2], yv[k * 8 + 3] * rs * nw[3]);
                w.z = pk_bf16(yv[k * 8 + 4] * rs * nw[4], yv[k * 8 + 5] * rs * nw[5]); w.w = pk_bf16(yv[k * 8 + 6] * rs * nw[6], yv[k * 8 + 7] * rs * nw[7]);
                *(u32x4*)(proj + pidx((size_t)row, C_SZ + lane * 16 + k * 8)) = w;
            }
        }
    }
#undef D_LOAD
}

__global__ void __launch_bounds__(512, 2) hybrid_fwd(P p) {
    extern __shared__ __attribute__((aligned(16))) unsigned char lds_raw[];
    LAS unsigned char* lds = (LAS unsigned char*)lds_raw;
    cg::grid_group grid = cg::this_grid();
    const int G = gridDim.x, bx = blockIdx.x;
    bf16_t* proj = (bf16_t*)(p.ws + WS_PROJ);
    bf16_t* hbuf = (bf16_t*)(p.ws + WS_H);
    if (threadIdx.x == 0) *(LAS u32x4*)(lds + LDS_BAR_OFF) = (u32x4){0u, 0u, 0u, 0u};
    __syncthreads();
    XcdBarrier xb = xcd_barrier_post((unsigned*)(p.ws + WS_BAR), (volatile LAS unsigned*)(lds + LDS_BAR_OFF));
    int nsync = 0;
    for (int ph = p.ph_lo; ph < p.ph_hi; ++ph) {
        if (ph > p.ph_lo) { if (nsync == 0) grid.sync(); else xcd_barrier(xb); ++nsync; }
        const int layer = ph >= 7 ? 1 : 0, sub = ph == 0 ? 0 : (ph - 1) % 6 + 1;
        if (sub == 0) {
            phase_convert(p);
            phase_rows(p.x, nullptr, 0, nullptr, nullptr, p.pre_norm, hbuf);
        } else if (sub == 1) {
            pg8::Gemm g; g.A = hbuf; g.Bt = (const bf16_t*)(p.ws + WS_WIN) + (size_t)layer * NPW * DM; g.M = T_TOK; g.N = NPW; g.K = DM; g.lda = DM; g.atiled = 0;
            pg8::StaticOrder S; S.init(g.M, g.N, G, bx);
            EpiProj E; E.proj = proj; E.small = (float*)(p.ws + WS_SMALL); E.halo = (bf16_t*)(p.ws + WS_HALO);
            pg8::gemm_phase<EpiProj>(lds, g, S, E);
        } else if (sub == 2) {
            for (int it = bx; it < 1024 * 6; it += G) {
                const int chunkg = it & 1023, kind = it >> 10;
                if (kind < 4) phaseB_gdn(lds, p, layer, chunkg, kind);
                else if (kind == 4) phaseB_ssd(p, layer, chunkg);
                else phaseB_ret(p, chunkg);
            }
        } else if (sub == 3) {
            for (int it = bx; it < 256; it += G) {
                int kind, sub;
                if (G == 256) {
                    const int xcd = it & 7, s = it >> 3;
                    if (s < 8) { kind = 0; sub = (xcd + 8 * (s >> 1)) * 2 + (s & 1); }
                    else if (s < 24) { const int s2 = s - 8, g = xcd + 8 * (s2 >> 3); kind = 1; sub = (g >> 1) * 16 + (g & 1) * 8 + (s2 & 7); }
                    else { const int s2 = s - 24; kind = 2; sub = (xcd + 8 * (s2 >> 1)) * 2 + (s2 & 1); }
                } else { kind = it < 64 ? 0 : (it < 192 ? 1 : 2); sub = it < 64 ? it : (it < 192 ? it - 64 : it - 192); }
                if (kind == 0) phaseC_item<0>(lds, p, layer, sub);
                else if (kind == 1) phaseC_item<1>(lds, p, layer, sub);
                else phaseC_item<2>(lds, p, layer, sub);
            }
        } else if (sub == 4) {
            phaseD(p, layer);
        } else if (sub == 5) {
            pg8::Gemm g; g.A = proj; g.Bt = (const bf16_t*)(p.ws + WS_WOUT) + (size_t)layer * 1024 * 2048; g.M = T_TOK; g.N = 1024; g.K = 2048; g.lda = 256; g.atiled = 1;
            pg8::StaticOrder S; S.init(g.M, g.N, G, bx);
            EpiOut E; E.O = proj;
            pg8::gemm_phase<EpiOut>(lds, g, S, E);
        } else {
            phase_rows(layer == 0 ? p.x : p.out, proj, NP, p.post_norm + layer * DM, p.out,
                       layer == 0 ? p.pre_norm + DM : nullptr, hbuf);
        }
    }
}

extern "C" void kernel_launch(void* const* d_in, const int* in_sizes, int n_in, void* d_out, int out_size, void* d_ws, size_t ws_size, hipStream_t stream) {
    static int grid_blocks = 0;
    if (grid_blocks == 0) {
        if (n_in != 16 || in_sizes[0] != T_TOK * DM || out_size != T_TOK * DM || ws_size < WS_TOTAL) {
            fprintf(stderr, "kernel_launch: unexpected shapes / workspace (%d inputs, in0 %d, out %d, ws %zu, need %zu)\n", n_in, n_in > 0 ? in_sizes[0] : -1, out_size, ws_size, (size_t)WS_TOTAL);
            grid_blocks = -1; return;
        }
        int dev = 0, cus = 0, per_cu = 0;
        hipGetDevice(&dev);
        hipDeviceGetAttribute(&cus, hipDeviceAttributeMultiprocessorCount, dev);
        if (hipFuncSetAttribute((const void*)hybrid_fwd, hipFuncAttributeMaxDynamicSharedMemorySize, LDS_BYTES) != hipSuccess) { fprintf(stderr, "hipFuncSetAttribute failed\n"); grid_blocks = -1; return; }
        hipOccupancyMaxActiveBlocksPerMultiprocessor(&per_cu, (const void*)hybrid_fwd, 512, LDS_BYTES);
        if (per_cu < 1) { fprintf(stderr, "occupancy query returned %d\n", per_cu); grid_blocks = -1; return; }
        grid_blocks = cus;
    }
    if (grid_blocks < 0) return;
    P p{};
    p.x = (const float*)d_in[0]; p.pre_norm = (const float*)d_in[1]; p.post_norm = (const float*)d_in[2]; p.w_in = (const float*)d_in[3];
    p.gdn_conv = (const float*)d_in[4]; p.gdn_A_log = (const float*)d_in[5]; p.gdn_dt_bias = (const float*)d_in[6]; p.gdn_norm = (const float*)d_in[7];
    p.ssd_conv = (const float*)d_in[8]; p.ssd_conv_b = (const float*)d_in[9]; p.ssd_A_log = (const float*)d_in[10]; p.ssd_dt_bias = (const float*)d_in[11];
    p.ssd_D = (const float*)d_in[12]; p.ssd_norm = (const float*)d_in[13]; p.ret_norm = (const float*)d_in[14]; p.w_out = (const float*)d_in[15];
    p.out = (float*)d_out; p.ws = (unsigned char*)d_ws;
    p.ph_lo = 0; p.ph_hi = 13;
    hipError_t me = hipMemsetAsync((unsigned char*)d_ws + WS_BAR, 0, XCD_BAR_WORDS * sizeof(unsigned), stream);
    if (me != hipSuccess) fprintf(stderr, "barrier memset failed: %s\n", hipGetErrorString(me));
    void* args[] = {&p};
    hipError_t e = hipLaunchCooperativeKernel((const void*)hybrid_fwd, dim3(grid_blocks), dim3(512), args, LDS_BYTES, stream);
    if (e != hipSuccess) fprintf(stderr, "cooperative launch failed: %s (grid %d)\n", hipGetErrorString(e), grid_blocks);
}
```
